# Optimizing an MI355X kernel written in HIP

```python
import math
import jax
import jax.numpy as jnp
from jax import lax
import numpy as np

D_MODEL = 4096
BATCH = 4
SEQ = 4096
DEPTH = 2

CTX_LEN = 256
GRID_W = 64
MIX_WIDTH = D_MODEL
BRANCH_W = MIX_WIDTH // 4
CHUNK = 64
EPS = 1e-6
F32 = jnp.float32

A_HEAD_DIM = 128
A_HEADS = BRANCH_W // A_HEAD_DIM
A_MIN_FORGET = 1e-6
B_HEADS = 4
B_KEY_W = BRANCH_W // 2
B_DK = B_KEY_W // B_HEADS
B_DV = BRANCH_W // B_HEADS
B_GATE_RANK = 16
B_GATE_NORM = 16.0
C_GROUP = 16
C_GROUPS = BRANCH_W // C_GROUP
C_STATE = 64
C_MAX_RE = -1e-4
DT_MIN = 1e-3
DT_MAX = 1e-1
D_HEADS = 4
D_KEY_W = BRANCH_W // 2
D_DK = D_KEY_W // D_HEADS
D_DV = BRANCH_W // D_HEADS
ROPE_BASE = 10000.0

IN_SPLITS = (
    BRANCH_W, BRANCH_W, BRANCH_W, BRANCH_W, BRANCH_W,
    B_KEY_W, B_KEY_W, BRANCH_W, B_GATE_RANK, B_GATE_RANK, BRANCH_W,
    BRANCH_W, BRANCH_W,
    D_KEY_W, D_KEY_W, BRANCH_W, BRANCH_W,
)
IN_WIDTH = sum(IN_SPLITS)

kernel_name = 'hybrid_hgrn2_gla_s5_retention_prefix_dit'


def rms_norm(x, g):
    xf = x.astype(F32)
    y = xf * lax.rsqrt(jnp.mean(xf * xf, axis=-1, keepdims=True) + EPS)
    return (y * g.astype(F32)).astype(x.dtype)


def head_layer_norm(x, g):
    xf = x.astype(F32)
    mu = jnp.mean(xf, axis=-1, keepdims=True)
    var = jnp.mean(jnp.square(xf - mu), axis=-1, keepdims=True)
    return ((xf - mu) * lax.rsqrt(var + EPS) * g.astype(F32)).astype(x.dtype)


def seg_flip(z, n_ctx):
    return jnp.concatenate([jnp.flip(z[:, :n_ctx], axis=1), jnp.flip(z[:, n_ctx:], axis=1)], axis=1)


def to_chunks(a):
    bsz, l = a.shape[:2]
    return jnp.moveaxis(a.reshape(bsz, l // CHUNK, CHUNK, *a.shape[2:]), 1, 0)


def from_chunks(a):
    a = jnp.moveaxis(a, 0, 1)
    return a.reshape(a.shape[0], -1, *a.shape[3:])


def split_columns(proj):
    offsets = np.cumsum(IN_SPLITS)[:-1].tolist()
    return jnp.split(proj, offsets, axis=-1)


def axial_rope(rows, n_ctx):
    quarter = D_DK // 4
    freqs = ROPE_BASE ** (-jnp.arange(quarter, dtype=F32) / quarter)
    t = jnp.arange(rows * GRID_W)
    r = (t // GRID_W).astype(F32)
    col = (t % GRID_W).astype(F32)
    ang = jnp.concatenate([r[:, None] * freqs, col[:, None] * freqs], axis=-1)
    ang = jnp.concatenate([jnp.zeros((n_ctx, D_DK // 2), F32), ang], axis=0)
    return jnp.cos(ang), jnp.sin(ang)


def apply_rope(x, cos, sin):
    half = x.shape[-1] // 2
    x1 = x[..., :half].astype(F32)
    x2 = x[..., half:].astype(F32)
    cs = cos[None, :, None, :]
    sn = sin[None, :, None, :]
    return jnp.concatenate([x1 * cs - x2 * sn, x1 * sn + x2 * cs], axis=-1).astype(x.dtype)


def gla_chunked(q, k, v, log_decay):
    bsz, _, h, dk = q.shape
    dv = v.shape[-1]
    lower = jnp.tril(jnp.ones((CHUNK, CHUNK), dtype=bool))[None, :, :, None, None]

    def step(state, inp):
        qi, ki, vi, gi = inp
        qi = qi.astype(F32)
        ki = ki.astype(F32)
        vi = vi.astype(F32)
        b = jnp.cumsum(gi, axis=1)
        diff = jnp.where(lower, b[:, :, None] - b[:, None, :], 0.0)
        rel = jnp.where(lower, jnp.exp(diff), 0.0)
        scores = jnp.einsum('bihd,bjhd,bijhd->bhij', qi, ki, rel)
        b_last = b[:, -1]
        o = (jnp.einsum('bhij,bjhe->bihe', scores, vi)
             + jnp.einsum('bihd,bhde->bihe', qi * jnp.exp(b), state))
        state = (state * jnp.exp(b_last)[..., None]
                 + jnp.einsum('bjhd,bjhe->bhde', ki * jnp.exp(b_last[:, None] - b), vi))
        return state, o

    s0 = jnp.zeros((bsz, h, dk, dv), F32)
    _, o = lax.scan(step, s0, (to_chunks(q), to_chunks(k), to_chunks(v), to_chunks(log_decay.astype(F32))))
    return from_chunks(o).astype(v.dtype)


def retention_chunked(q, k, v, log_gamma):
    bsz, _, h, dk = q.shape
    dv = v.shape[-1]
    pos = jnp.arange(CHUNK, dtype=F32)
    lg = log_gamma.astype(F32)
    rel = pos[:, None] - pos[None, :]
    dmat = jnp.where(rel[None] >= 0, jnp.exp(lg[:, None, None] * jnp.maximum(rel, 0.0)[None]), 0.0)
    xi = jnp.exp(lg[None, :] * (pos[:, None] + 1.0))[None, :, :, None]
    zeta = jnp.exp(lg[None, :] * (CHUNK - 1.0 - pos[:, None]))[None, :, :, None]
    chunk_decay = jnp.exp(lg * CHUNK)[None, :, None, None]

    def step(state, inp):
        qi, ki, vi = inp
        qi = qi.astype(F32)
        ki = ki.astype(F32)
        vi = vi.astype(F32)
        scores = jnp.einsum('bihd,bjhd->bhij', qi, ki) * dmat[None]
        o = (jnp.einsum('bhij,bjhe->bihe', scores, vi)
             + jnp.einsum('bihd,bhde->bihe', qi, state) * xi)
        state = state * chunk_decay + jnp.einsum('bjhd,bjhe->bhde', ki * zeta, vi)
        return state, o

    s0 = jnp.zeros((bsz, h, dk, dv), F32)
    _, o = lax.scan(step, s0, (to_chunks(q), to_chunks(k), to_chunks(v)))
    return from_chunks(o).astype(v.dtype)


def s5_scan(u, lam_re, lam_im, log_dt, b_re, b_im, c_re, c_im):
    lam = lax.complex(jnp.minimum(lam_re.astype(F32), C_MAX_RE), lam_im.astype(F32))
    dt = jnp.exp(log_dt.astype(F32))[:, None]
    lam_bar = jnp.exp(lam * dt)
    b_bar = ((lam_bar - 1.0) / lam)[..., None] * lax.complex(b_re.astype(F32), b_im.astype(F32))
    bu = jnp.einsum('gph,blgh->blgp', b_bar, u.astype(F32).astype(jnp.complex64))
    a = jnp.broadcast_to(lam_bar, bu.shape)

    def combine(e1, e2):
        a1, b1 = e1
        a2, b2 = e2
        return a1 * a2, a2 * b1 + b2

    _, states = lax.associative_scan(combine, (a, bu), axis=1)
    c_mat = lax.complex(c_re.astype(F32), c_im.astype(F32))
    return jnp.einsum('ghp,blgp->blgh', c_mat, states).real


def hgrn2_branch(q, f_fwd, f_bwd, i, gate, lower_bound, norm_g, n_ctx):
    bsz, l, _ = q.shape

    def heads(a):
        return a.reshape(bsz, l, A_HEADS, A_HEAD_DIM)

    qh, ih = heads(q), heads(i)

    def direction(qd, zd, idd, lb):
        lb = lb.reshape(A_HEADS, A_HEAD_DIM).astype(F32)
        z = heads(zd).astype(F32)
        f = lb + (1.0 - lb) * jax.nn.sigmoid(z)
        log_f = jnp.log(jnp.maximum(f, A_MIN_FORGET))
        key = (1.0 - lb) * jax.nn.sigmoid(-z)
        return gla_chunked(qd, key.astype(qd.dtype), idd, log_f)

    o_f = direction(qh, f_fwd, ih, lower_bound[0])
    o_b = seg_flip(direction(seg_flip(qh, n_ctx), seg_flip(f_bwd, n_ctx), seg_flip(ih, n_ctx), lower_bound[1]), n_ctx)
    o = rms_norm(o_f + o_b, norm_g).reshape(bsz, l, BRANCH_W)
    return o * jax.nn.silu(gate)


def gla_branch(q, k, v, lr_fwd, lr_bwd, gate, w_gk, b_gk, norm_g, n_ctx):
    bsz, l, _ = q.shape
    qh = q.reshape(bsz, l, B_HEADS, B_DK) * (B_DK ** -0.5)
    kh = k.reshape(bsz, l, B_HEADS, B_DK)
    vh = v.reshape(bsz, l, B_HEADS, B_DV)

    def log_decay(lr, w, b):
        g = jax.nn.log_sigmoid((lr @ w + b).astype(F32)) / B_GATE_NORM
        return g.reshape(bsz, l, B_HEADS, B_DK)

    o_f = gla_chunked(qh, kh, vh, log_decay(lr_fwd, w_gk[0], b_gk[0]))
    o_b = seg_flip(gla_chunked(seg_flip(qh, n_ctx), seg_flip(kh, n_ctx), seg_flip(vh, n_ctx),
                               log_decay(seg_flip(lr_bwd, n_ctx), w_gk[1], b_gk[1])), n_ctx)
    o = rms_norm(o_f + o_b, norm_g).reshape(bsz, l, BRANCH_W)
    return o * jax.nn.silu(gate)


def s5_branch(u, gate, lam_re, lam_im, log_dt, b_re, b_im, c_re, c_im, d, w_glu, b_glu, n_ctx):
    bsz, l, _ = u.shape
    ug = u.reshape(bsz, l, C_GROUPS, C_GROUP)
    y_f = s5_scan(ug, lam_re[0], lam_im[0], log_dt[0], b_re[0], b_im[0], c_re[0], c_im[0])
    y_b = seg_flip(s5_scan(seg_flip(ug, n_ctx), lam_re[1], lam_im[1], log_dt[1],
                           b_re[1], b_im[1], c_re[1], c_im[1]), n_ctx)
    y = (y_f + y_b + d.astype(F32) * ug.astype(F32)).reshape(bsz, l, BRANCH_W).astype(u.dtype)
    z = jax.nn.gelu(y)
    out = z * jax.nn.sigmoid(z @ w_glu + b_glu)
    return out * jax.nn.silu(gate)


def retention_branch(q, k, v, gate, log_gamma, norm_g, cos, sin, n_ctx):
    bsz, l, _ = q.shape
    qh = apply_rope(q.reshape(bsz, l, D_HEADS, D_DK), cos, sin) * (D_DK ** -0.5)
    kh = apply_rope(k.reshape(bsz, l, D_HEADS, D_DK), cos, sin)
    vh = v.reshape(bsz, l, D_HEADS, D_DV)
    o_f = retention_chunked(qh, kh, vh, log_gamma[0])
    o_b = seg_flip(retention_chunked(seg_flip(qh, n_ctx), seg_flip(kh, n_ctx), seg_flip(vh, n_ctx), log_gamma[1]), n_ctx)
    o = head_layer_norm(o_f + o_b, norm_g).reshape(bsz, l, BRANCH_W)
    return o * jax.nn.silu(gate)


def setup_inputs(seed: int = 0) -> dict:
    key = jax.random.key(seed)
    ks = jax.random.split(key, 27)

    def nrm(k, shape, scale):
        return jax.random.normal(k, shape, F32) * scale

    n_idx = jnp.arange(C_STATE, dtype=F32)
    gammas = 1.0 - 2.0 ** (-5.0 - jnp.arange(D_HEADS, dtype=F32))
    gamma_logit = jnp.log(gammas) - jnp.log1p(-gammas)
    return {
        'x': nrm(ks[0], (BATCH, SEQ, D_MODEL), 1.0),
        'c': nrm(ks[1], (BATCH, D_MODEL), 1.0),
        'ctx': nrm(ks[2], (BATCH, CTX_LEN, D_MODEL), 1.0),
        'c_ctx': nrm(ks[3], (D_MODEL,), 1.0),
        'norm_g': 1.0 + nrm(ks[4], (DEPTH, D_MODEL), 0.02),
        'w_ada': nrm(ks[5], (DEPTH, D_MODEL, 3 * D_MODEL), 0.5 * D_MODEL ** -0.5),
        'b_ada': nrm(ks[6], (DEPTH, 3 * D_MODEL), 0.02),
        'w_in': nrm(ks[7], (DEPTH, D_MODEL, IN_WIDTH), D_MODEL ** -0.5),
        'hgrn_lb_logits': nrm(ks[8], (DEPTH, 2, BRANCH_W), 0.1),
        'hgrn_norm_g': 1.0 + nrm(ks[9], (DEPTH, A_HEAD_DIM), 0.02),
        'gla_w_gk': nrm(ks[10], (DEPTH, 2, B_GATE_RANK, B_KEY_W), B_GATE_RANK ** -0.5),
        'gla_b_gk': nrm(ks[11], (DEPTH, 2, B_KEY_W), 0.1),
        'gla_norm_g': 1.0 + nrm(ks[12], (DEPTH, B_DV), 0.02),
        's5_lam_re': -0.5 + nrm(ks[13], (DEPTH, 2, C_GROUPS, C_STATE), 0.01),
        's5_lam_im': math.pi * n_idx + nrm(ks[14], (DEPTH, 2, C_GROUPS, C_STATE), 0.01),
        's5_log_dt': jax.random.uniform(ks[15], (DEPTH, 2, C_GROUPS), F32, math.log(DT_MIN), math.log(DT_MAX)),
        's5_b_re': nrm(ks[16], (DEPTH, 2, C_GROUPS, C_STATE, C_GROUP), (2 * C_GROUP) ** -0.5),
        's5_b_im': nrm(ks[17], (DEPTH, 2, C_GROUPS, C_STATE, C_GROUP), (2 * C_GROUP) ** -0.5),
        's5_c_re': nrm(ks[18], (DEPTH, 2, C_GROUPS, C_GROUP, C_STATE), (2 * C_STATE) ** -0.5),
        's5_c_im': nrm(ks[19], (DEPTH, 2, C_GROUPS, C_GROUP, C_STATE), (2 * C_STATE) ** -0.5),
        's5_d': nrm(ks[20], (DEPTH, C_GROUPS, C_GROUP), 0.5),
        's5_w_glu': nrm(ks[21], (DEPTH, BRANCH_W, BRANCH_W), BRANCH_W ** -0.5),
        's5_b_glu': nrm(ks[22], (DEPTH, BRANCH_W), 0.02),
        'ret_decay_logit': gamma_logit + nrm(ks[23], (DEPTH, 2, D_HEADS), 0.01),
        'ret_norm_g': 1.0 + nrm(ks[24], (DEPTH, D_DV), 0.02),
        'w_out': nrm(ks[25], (DEPTH, MIX_WIDTH, D_MODEL), MIX_WIDTH ** -0.5),
        'final_norm_g': 1.0 + nrm(ks[26], (D_MODEL,), 0.02),
    }


def reference(x, c, ctx, c_ctx, norm_g, w_ada, b_ada, w_in, hgrn_lb_logits, hgrn_norm_g,
              gla_w_gk, gla_b_gk, gla_norm_g, s5_lam_re, s5_lam_im, s5_log_dt, s5_b_re, s5_b_im,
              s5_c_re, s5_c_im, s5_d, s5_w_glu, s5_b_glu, ret_decay_logit, ret_norm_g, w_out,
              final_norm_g):
    n_ctx = ctx.shape[1]
    rows = x.shape[1] // GRID_W
    cos, sin = axial_rope(rows, n_ctx)
    lb_p = jax.nn.softmax(hgrn_lb_logits.astype(F32), axis=0)
    lower_bounds = jnp.cumsum(lb_p, axis=0) - lb_p[0:1]

    h_ctx, h_lat = ctx, x
    for layer in range(DEPTH):
        last = layer == DEPTH - 1
        mod_lat = jax.nn.silu(c) @ w_ada[layer] + b_ada[layer]
        mod_ctx = jax.nn.silu(c_ctx) @ w_ada[layer] + b_ada[layer]
        sh_l, sc_l, gt_l = jnp.split(mod_lat, 3, axis=-1)
        sh_c, sc_c, gt_c = jnp.split(mod_ctx, 3, axis=-1)
        hn = jnp.concatenate([
            rms_norm(h_ctx, norm_g[layer]) * (1.0 + sc_c) + sh_c,
            rms_norm(h_lat, norm_g[layer]) * (1.0 + sc_l[:, None]) + sh_l[:, None],
        ], axis=1)
        (a_q, a_ff, a_fb, a_i, a_g,
         b_q, b_k, b_v, b_lf, b_lb, b_g,
         c_u, c_g,
         d_q, d_k, d_v, d_g) = split_columns(hn @ w_in[layer])
        o_a = hgrn2_branch(a_q, a_ff, a_fb, a_i, a_g, lower_bounds[layer], hgrn_norm_g[layer], n_ctx)
        o_b = gla_branch(b_q, b_k, b_v, b_lf, b_lb, b_g, gla_w_gk[layer], gla_b_gk[layer], gla_norm_g[layer], n_ctx)
        o_c = s5_branch(c_u, c_g, s5_lam_re[layer], s5_lam_im[layer], s5_log_dt[layer], s5_b_re[layer],
                        s5_b_im[layer], s5_c_re[layer], s5_c_im[layer], s5_d[layer], s5_w_glu[layer],
                        s5_b_glu[layer], n_ctx)
        log_gamma = jax.nn.log_sigmoid(ret_decay_logit[layer].astype(F32))
        o_d = retention_branch(d_q, d_k, d_v, d_g, log_gamma, ret_norm_g[layer], cos, sin, n_ctx)
        o = jnp.concatenate([o_a, o_b, o_c, o_d], axis=-1)
        if last:
            h_lat = h_lat + gt_l[:, None] * (o[:, n_ctx:] @ w_out[layer])
        else:
            y = o @ w_out[layer]
            h_ctx = h_ctx + gt_c * y[:, :n_ctx]
            h_lat = h_lat + gt_l[:, None] * y[:, n_ctx:]
    return rms_norm(h_lat, final_norm_g)
```

```cpp
#include <hip/hip_runtime.h>
#include <cstdio>
#include <cstdint>
namespace pg8 {
#define PG8_LAS __attribute__((address_space(3)))
typedef unsigned short bf16_t;
typedef short bf16x8 __attribute__((ext_vector_type(8)));
typedef float f32x4 __attribute__((ext_vector_type(4)));
typedef unsigned u32x4 __attribute__((ext_vector_type(4)));
constexpr int BM = 256, BK = 64, HALF = 128, HTB = HALF * BK * 2  , STAGE_BYTES = 8 * HTB, NXCD = 8, WGM = 8;

__host__ __device__ __forceinline__ int lds_byte(int r, int c) { const int st = (r >> 4) * 2 + (c >> 5), rr = r & 15, cc = c & 31, ob = rr * 64 + cc * 2; return st * 1024 + (ob ^ (((ob >> 9) & 1) << 5)); }
__host__ __device__ __forceinline__ void stage_rc(int b, int& R, int& C) { const int st = b / 1024, sb = b % 1024, swz = sb ^ (((sb >> 9) & 1) << 5); R = (st >> 1) * 16 + swz / 64; C = (st & 1) * 32 + (swz % 64) / 2; }
__host__ __device__ __forceinline__ int perm32(int rho) { const int n = rho >> 4, i = rho & 15; return 8 * (i >> 2) + 4 * n + (i & 3); }

struct Unit { int pm, pn; };
struct Gemm { const bf16_t* A; const bf16_t* Bt; int M, N, K; };

struct StaticOrder {
    int nM, nN, nwg, G, c;
    __host__ __device__ void init(int M, int N, int G_, int c_) { nM = M / BM; nN = N / BM; nwg = nM * nN; G = G_; c = c_; }
    __host__ __device__ bool next(int i, Unit& u) const {
        const long L = (long)i * G + c; if (L >= nwg) return false;
        int wgid = (int)L; { const int q = nwg / NXCD, r = nwg % NXCD, xcd = wgid % NXCD, off = wgid / NXCD; wgid = (xcd < r ? xcd * (q + 1) : r * (q + 1) + (xcd - r) * q) + off; }
        const int nig = WGM * nN, gid = wgid / nig, fm = gid * WGM, gsz = (nM - fm) < WGM ? (nM - fm) : WGM;
        u.pm = fm + ((wgid % nig) % gsz); u.pn = (wgid % nig) / gsz; return true;
    }
    __device__ __forceinline__ void a_ready(const Unit&) const {}
    __device__ __forceinline__ void done(const Unit&) const {}
};

__device__ __forceinline__ unsigned cvt_pk_bf16(float lo, float hi) { unsigned r; asm volatile("v_cvt_pk_bf16_f32 %0, %1, %2" : "=v"(r) : "v"(lo), "v"(hi)); return r; }
typedef float f32x2 __attribute__((ext_vector_type(2)));
__device__ __forceinline__ f32x2 gelu_pk(f32x2 v) {
    const f32x2 av = __builtin_elementwise_abs(v), d = av * 0.2316418882f + 1.0f;
    f32x2 t; t.x = __builtin_amdgcn_rcpf(d.x); t.y = __builtin_amdgcn_rcpf(d.y);
    f32x2 q = t * 0.5307027145f + (-0.7265760135f); q = q * t + 0.7107068705f; q = q * t + (-0.142248368f); q = q * t + 0.127414796f; q = q * t;
    const f32x2 s = (v * v) * (-0.72134752044f);
    f32x2 e; e.x = __builtin_amdgcn_exp2f(s.x); e.y = __builtin_amdgcn_exp2f(s.y);
    const f32x2 m = v * (q * e), r = v - m;
    f32x2 o; o.x = v.x < 0.f ? m.x : r.x; o.y = v.y < 0.f ? m.y : r.y; return o;
}

template <class Epi, class Sched, bool ALIGN_EPI = false, bool SP2 = false>
__device__ __forceinline__ void gemm_phase(PG8_LAS unsigned char* lds, const Gemm g, const Sched& S, const Epi& E) {
    int tid_l = threadIdx.x; asm volatile("" : "+v"(tid_l));
    const int tid = tid_l, wid = __builtin_amdgcn_readfirstlane(tid >> 6), lane = tid & 63, wr = wid >> 2, wc = wid & 3, fr = lane & 15, fq = lane >> 4;
    const int K = g.K, nt = K / BK;
    unsigned voffA[2], voffB[2];
#pragma unroll
    for (int i = 0; i < 2; ++i) { int R, C; stage_rc(tid * 16 + i * 8192, R, C); const int Rb = Epi::PERM ? ((R & ~31) + perm32(R & 31)) : R;
        voffA[i] = (unsigned)(R * K + C) * 2u; voffB[i] = (unsigned)(Rb * K + C) * 2u; }
    const size_t kstep = (size_t)(BK * 2);
    const size_t hstep = (size_t)HALF * K * 2;
    const size_t tstep = 2 * hstep;
    const unsigned ldsw = (unsigned)wid * 1024u;
    const int aoff = lds_byte(wr * 64 + fr, fq * 8), boff = lds_byte(wc * 32 + fr, fq * 8);
#define PG8_SA(b, h) (((b) * 2 + (h)) * HTB)
#define PG8_SB(b, h) ((4 + (b) * 2 + (h)) * HTB)
#define PG8_STAGE(bufoff, gbase, voff) do { _Pragma("unroll") for (int _i = 0; _i < 2; ++_i) \
        __builtin_amdgcn_global_load_lds((const unsigned*)((const char*)(gbase) + (voff)[_i]), (PG8_LAS unsigned*)(lds + (bufoff) + ldsw + _i * 8192), 16, 0, 0); } while (0)
#define PG8_LDA(dst, b, h) do { _Pragma("unroll") for (int m = 0; m < 4; ++m) _Pragma("unroll") for (int k = 0; k < 2; ++k) dst[m][k] = *(const PG8_LAS bf16x8*)(lds + PG8_SA(b, h) + aoff + m * 2048 + k * 1024); } while (0)
#define PG8_LDB(dst, b, h) do { _Pragma("unroll") for (int n = 0; n < 2; ++n) _Pragma("unroll") for (int k = 0; k < 2; ++k) dst[n][k] = *(const PG8_LAS bf16x8*)(lds + PG8_SB(b, h) + boff + n * 2048 + k * 1024); } while (0)
#define PG8_MMA(ai, bj, At, Bt) do { __builtin_amdgcn_s_setprio(1); _Pragma("unroll") for (int m = 0; m < 4; ++m) _Pragma("unroll") for (int n = 0; n < 2; ++n) _Pragma("unroll") for (int k = 0; k < 2; ++k) \
        acc[ai][bj][m][n] = __builtin_amdgcn_mfma_f32_16x16x32_bf16(Bt[n][k], At[m][k], acc[ai][bj][m][n], 0, 0, 0); __builtin_amdgcn_s_setprio(0); } while (0)
#define PG8_WAIT_V(n) asm volatile("s_waitcnt vmcnt(" #n ")" ::: "memory")
#define PG8_WAIT_L(n) asm volatile("s_waitcnt lgkmcnt(" #n ")" ::: "memory")
#define PG8_BAR __builtin_amdgcn_s_barrier()
#define PG8_SCHED __builtin_amdgcn_sched_barrier(0)
    Unit cur, nxt; int ui = 0;
    if (!S.next(0, cur)) return;
    f32x4 acc[2][2][4][2];
#pragma unroll
    for (int a = 0; a < 2; ++a)
#pragma unroll
        for (int b = 0; b < 2; ++b)
#pragma unroll
            for (int m = 0; m < 4; ++m)
#pragma unroll
                for (int n = 0; n < 2; ++n) acc[a][b][m][n] = (f32x4){0.f, 0.f, 0.f, 0.f};
    bf16x8 At[4][2], B0[2][2], B1[2][2];
    const char* cA = (const char*)g.A + (size_t)cur.pm * tstep; const char* cB = (const char*)g.Bt + (size_t)cur.pn * tstep;
    S.a_ready(cur);
    if constexpr (SP2) {
        PG8_STAGE(PG8_SB(0, 0), cB, voffB); PG8_STAGE(PG8_SB(0, 1), cB + hstep, voffB); PG8_STAGE(PG8_SA(0, 0), cA, voffA); PG8_STAGE(PG8_SA(0, 1), cA + hstep, voffA);
        if (wr == 1) PG8_BAR;
        PG8_WAIT_V(2); PG8_BAR;
        PG8_STAGE(PG8_SB(1, 0), cB + kstep, voffB); PG8_STAGE(PG8_SA(1, 0), cA + kstep, voffA); PG8_STAGE(PG8_SB(1, 1), cB + hstep + kstep, voffB);
        PG8_WAIT_V(6); PG8_BAR;
    } else {
        PG8_STAGE(PG8_SB(0, 0), cB, voffB); PG8_STAGE(PG8_SA(0, 0), cA, voffA); PG8_STAGE(PG8_SB(0, 1), cB + hstep, voffB); PG8_STAGE(PG8_SA(0, 1), cA + hstep, voffA);
        if (wr == 1) PG8_BAR;
        PG8_WAIT_V(4); PG8_BAR;
        PG8_STAGE(PG8_SB(1, 0), cB + kstep, voffB); PG8_STAGE(PG8_SA(1, 0), cA + kstep, voffA); PG8_STAGE(PG8_SB(1, 1), cB + hstep + kstep, voffB);
        PG8_WAIT_V(6); PG8_BAR;
    }
    for (;;) {
        const bool has_next = S.next(ui + 1, nxt);
        const char* nA = has_next ? (const char*)g.A + (size_t)nxt.pm * tstep : cA; const char* nB = has_next ? (const char*)g.Bt + (size_t)nxt.pn * tstep : cB;
        for (int t = 0; t < nt; t += 2) {
            const bool last = (t == nt - 2);
            const char* a1 = cA + (size_t)(t + 1) * kstep;
            const char* a2 = last ? nA : cA + (size_t)(t + 2) * kstep; const char* b2 = last ? nB : cB + (size_t)(t + 2) * kstep;
            const char* a3 = a2 + kstep; const char* b3 = b2 + kstep;
            if (last && has_next) S.a_ready(nxt);
            if constexpr (SP2) {
            PG8_LDB(B0, 0, 0); PG8_LDB(B1, 0, 1); PG8_SCHED; PG8_LDA(At, 0, 0); PG8_STAGE(PG8_SA(1, 1), a1 + hstep, voffA);
            PG8_WAIT_V(8); PG8_WAIT_L(0); PG8_BAR; PG8_MMA(0, 0, At, B0); PG8_MMA(0, 1, At, B1); PG8_BAR; PG8_SCHED;
            PG8_LDA(At, 0, 1); PG8_STAGE(PG8_SB(0, 0), b2, voffB); PG8_STAGE(PG8_SB(0, 1), b2 + hstep, voffB); PG8_STAGE(PG8_SA(0, 0), a2, voffA);
            PG8_WAIT_V(8); PG8_WAIT_L(0); PG8_BAR; PG8_MMA(1, 0, At, B0); PG8_MMA(1, 1, At, B1); PG8_BAR; PG8_SCHED;
            PG8_LDB(B0, 1, 0); PG8_LDB(B1, 1, 1); PG8_SCHED; PG8_LDA(At, 1, 0); PG8_STAGE(PG8_SA(0, 1), a2 + hstep, voffA);
            PG8_WAIT_V(8); PG8_WAIT_L(0); PG8_BAR; PG8_MMA(0, 0, At, B0); PG8_MMA(0, 1, At, B1); PG8_BAR; PG8_SCHED;
            PG8_LDA(At, 1, 1); PG8_STAGE(PG8_SB(1, 0), b3, voffB); PG8_STAGE(PG8_SB(1, 1), b3 + hstep, voffB); PG8_STAGE(PG8_SA(1, 0), a3, voffA);
            PG8_WAIT_V(8); PG8_WAIT_L(0); PG8_BAR; PG8_MMA(1, 0, At, B0); PG8_MMA(1, 1, At, B1); PG8_BAR; PG8_SCHED;
            } else {
            PG8_LDB(B0, 0, 0); PG8_SCHED; PG8_LDA(At, 0, 0); PG8_STAGE(PG8_SA(1, 1), a1 + hstep, voffA);
            PG8_WAIT_L(8); PG8_BAR; PG8_WAIT_L(0); PG8_MMA(0, 0, At, B0); PG8_BAR; PG8_SCHED;
            PG8_LDB(B1, 0, 1); PG8_STAGE(PG8_SB(0, 0), b2, voffB);
            PG8_BAR; PG8_WAIT_L(0); PG8_MMA(0, 1, At, B1); PG8_BAR;
            PG8_LDA(At, 0, 1); PG8_STAGE(PG8_SA(0, 0), a2, voffA);
            PG8_BAR; PG8_WAIT_L(0); PG8_MMA(1, 0, At, B0); PG8_BAR; PG8_SCHED;
            PG8_STAGE(PG8_SB(0, 1), b2 + hstep, voffB);
            PG8_WAIT_V(6); PG8_BAR; PG8_MMA(1, 1, At, B1); PG8_BAR;
            PG8_LDB(B0, 1, 0); PG8_SCHED; PG8_LDA(At, 1, 0); PG8_STAGE(PG8_SA(0, 1), a2 + hstep, voffA);
            PG8_WAIT_L(8); PG8_BAR; PG8_WAIT_L(0); PG8_MMA(0, 0, At, B0); PG8_BAR; PG8_SCHED;
            PG8_LDB(B1, 1, 1); PG8_STAGE(PG8_SB(1, 0), b3, voffB);
            PG8_BAR; PG8_WAIT_L(0); PG8_MMA(0, 1, At, B1); PG8_BAR;
            PG8_LDA(At, 1, 1); PG8_STAGE(PG8_SA(1, 0), a3, voffA);
            PG8_BAR; PG8_WAIT_L(0); PG8_MMA(1, 0, At, B0); PG8_BAR; PG8_SCHED;
            PG8_STAGE(PG8_SB(1, 1), b3 + hstep, voffB);
            PG8_WAIT_V(6); PG8_BAR; PG8_MMA(1, 1, At, B1); PG8_BAR;
            }
        }
        if constexpr (ALIGN_EPI) { if (wr == 0) PG8_BAR; }
        if constexpr (!Epi::AFTER_DRAIN) { E(acc, cur, wr, wc, fr, fq); S.done(cur); }
        if (!has_next) break;
#pragma unroll
        for (int a = 0; a < 2; ++a)
#pragma unroll
            for (int b = 0; b < 2; ++b)
#pragma unroll
                for (int m = 0; m < 4; ++m)
#pragma unroll
                    for (int n = 0; n < 2; ++n) acc[a][b][m][n] = (f32x4){0.f, 0.f, 0.f, 0.f};
        cur = nxt; cA = nA; cB = nB; ++ui;
        if constexpr (ALIGN_EPI) { if (wr == 1) PG8_BAR; }
    }
    PG8_WAIT_V(0);
    if constexpr (!ALIGN_EPI) { if (wr == 0) PG8_BAR; }
    PG8_BAR;
    if constexpr (Epi::AFTER_DRAIN) { E.fused(acc, cur, wr, wc, fr, fq, lds, wid, lane); S.done(cur); }
#undef PG8_SA
#undef PG8_SB
#undef PG8_STAGE
#undef PG8_LDA
#undef PG8_LDB
#undef PG8_MMA
#undef PG8_WAIT_V
#undef PG8_WAIT_L
#undef PG8_BAR
#undef PG8_SCHED
}
}
#define XB_TMO      128
#define XB_XCNT(j)  (256  + 64 * (j))
#define XB_XSUB(j)  (1280 + 64 * (j))
#define XB_XGEN(j)  (2304 + 64 * (j))
#define XB_TOP      3328
#define XB_TOPGEN   3392
#define XCD_BAR_WORDS 3456
#define XB_SPIN_CAP (1u << 18)
#define LAS __attribute__((address_space(3)))

__device__ __forceinline__ unsigned xb_ld(unsigned* p)              { return __hip_atomic_load(p, __ATOMIC_RELAXED, __HIP_MEMORY_SCOPE_AGENT); }
__device__ __forceinline__ unsigned xb_add(unsigned* p, unsigned v) { return __hip_atomic_fetch_add(p, v, __ATOMIC_RELAXED, __HIP_MEMORY_SCOPE_AGENT); }
__device__ __forceinline__ unsigned xb_xcc_id() { return (unsigned)__builtin_amdgcn_s_getreg((3 << 11) | 20) & 0xFu; }
#define XB_SPIN(cond, bar) do { unsigned _sp = 0; while (cond) { __builtin_amdgcn_s_sleep(1); \
    if ((++_sp & 255u) == 0u) { if (xb_ld(&(bar)[XB_TMO])) break; if (_sp > XB_SPIN_CAP) { atomicAdd(&(bar)[XB_TMO], 1u); break; } } } } while (0)

struct XcdBarrier {
    unsigned* bar; unsigned x;
    volatile LAS unsigned* st;
};

__device__ __forceinline__ XcdBarrier xcd_barrier_post(unsigned* bar, volatile LAS unsigned* st) {
    XcdBarrier b; b.bar = bar; b.x = xb_xcc_id(); b.st = st;
    if (threadIdx.x == 0) (void)xb_add(&bar[XB_XCNT(b.x)], 1u);
    return b;
}
__device__ __forceinline__ void xcd_barrier_complete(unsigned* bar, unsigned x, unsigned& nloc, unsigned& nx) {
    const unsigned G = gridDim.x * gridDim.y * gridDim.z;
    unsigned sum, cnt, mine, sp = 0u;
    for (;;) {
        sum = 0u; cnt = 0u; mine = 0u;
#pragma unroll
        for (unsigned j = 0; j < 16; ++j) { const unsigned c = xb_ld(&bar[XB_XCNT(j)]); sum += c; cnt += (c > 0u) ? 1u : 0u; mine = (j == x) ? c : mine; }
        if (sum == G) break;
        __builtin_amdgcn_s_sleep(1);
        if ((++sp & 255u) == 0u) { if (xb_ld(&bar[XB_TMO])) break; if (sp > XB_SPIN_CAP) { atomicAdd(&bar[XB_TMO], 1u); break; } }
    }
    nloc = mine > 0u ? mine : 1u; nx = cnt > 0u ? cnt : 1u;
}

__device__ __forceinline__ void xcd_barrier(const XcdBarrier& b) {
    asm volatile("s_waitcnt vmcnt(0)" ::: "memory");
    __syncthreads();
    if (threadIdx.x == 0) {
        unsigned* bar = b.bar;
        __builtin_amdgcn_s_waitcnt(0);
        unsigned nloc = b.st[0], nx = b.st[1];
        if (nloc == 0u) { xcd_barrier_complete(bar, b.x, nloc, nx); b.st[0] = nloc; b.st[1] = nx; }
        const unsigned old = xb_add(&bar[XB_XSUB(b.x)], 1u);
        const unsigned gen = old / nloc;
        if (old + 1u == (gen + 1u) * nloc) {
            __builtin_amdgcn_fence(__ATOMIC_RELEASE, "agent");
            asm volatile("s_waitcnt vmcnt(0)" ::: "memory");
            const unsigned og = xb_add(&bar[XB_TOP], 1u);
            const unsigned tg = og / nx;
            if (og + 1u == (tg + 1u) * nx) xb_add(&bar[XB_TOPGEN], 1u);
            else XB_SPIN(xb_ld(&bar[XB_TOPGEN]) == tg, bar);
            __builtin_amdgcn_fence(__ATOMIC_ACQUIRE, "agent");
            xb_add(&bar[XB_XGEN(b.x)], 1u);
            asm volatile("s_waitcnt vmcnt(0)" ::: "memory");
        } else {
            XB_SPIN(xb_ld(&bar[XB_XGEN(b.x)]) == gen, bar);
            __builtin_amdgcn_fence(__ATOMIC_ACQUIRE, "agent");
            asm volatile("s_waitcnt vmcnt(0)" ::: "memory");
        }
    }
    __syncthreads();
}

#define GAS __attribute__((address_space(1)))
typedef unsigned short bf16;
typedef unsigned v4u __attribute__((ext_vector_type(4)));
typedef unsigned v2u __attribute__((ext_vector_type(2)));
typedef float f32x4 __attribute__((ext_vector_type(4)));
#define LDS_WAIT() asm volatile("s_waitcnt lgkmcnt(0)" ::: "memory")

constexpr int DM = 4096, NBATCH = 4, SEQ = 4096, NCTX = 256, LTOT = NCTX + SEQ, MROWS = NBATCH * LTOT;
constexpr int NIN = 13344, NP = 13568;
constexpr int CA_Q = 0, CA_FF = 1024, CA_FB = 2048, CA_I = 3072, CA_G = 4096;
constexpr int CB_Q = 5120, CB_K = 5632, CB_V = 6144, CB_G = 7168;
constexpr int CC_U = 8192, CC_G = 9216;
constexpr int CD_Q = 10240, CD_K = 10752, CD_V = 11264, CD_G = 12288;
constexpr int CB_LF = 13312, CB_LB = 13328;
constexpr float EPSN = 1e-6f;

constexpr size_t WS_CTL = 0, CTL_BYTES = 1u << 20;
constexpr size_t WS_WIN = WS_CTL + CTL_BYTES;
constexpr size_t WS_WOUT = WS_WIN + (size_t)NP * DM * 2;
constexpr size_t WS_WGLU = WS_WOUT + (size_t)DM * DM * 2;
constexpr size_t WS_MOD = WS_WGLU + (size_t)1024 * 1024 * 2;
constexpr size_t WS_HN = WS_MOD + (size_t)2 * 5 * 12288 * 4;
constexpr size_t WS_P = WS_HN + (size_t)MROWS * DM * 2;
constexpr size_t WS_HC = WS_P + (size_t)MROWS * NP * 2;
constexpr size_t WS_HL = WS_HC + (size_t)NBATCH * NCTX * DM * 4;
constexpr size_t WS_O = WS_HL + (size_t)NBATCH * SEQ * DM * 4;
constexpr size_t WS_Z = WS_O + (size_t)MROWS * DM * 2;
constexpr size_t WS_RAW = WS_Z + (size_t)MROWS * 1024 * 2;
constexpr size_t WS_END = WS_RAW + (size_t)2 * MROWS * DM * 2;

constexpr int RING_BYTES = 131072, LDSCTL_OFF = RING_BYTES, MISC_OFF = LDSCTL_OFF + 320, LDS_BYTES = 147456;
constexpr int CW_BAR = 1024;

struct Args { const float* in[27]; float* out; unsigned char* ws; int ph_lo, ph_hi; };
typedef const __attribute__((address_space(4))) Args* KP;
#define KARGS() ({ KP _p = (KP)__builtin_amdgcn_kernarg_segment_ptr(); asm volatile("" : "+s"(_p)); _p; })

__device__ __forceinline__ float bf2f(bf16 v) { return __builtin_bit_cast(float, (unsigned)v << 16); }
__device__ __forceinline__ unsigned f2bf(float f) { unsigned u = __builtin_bit_cast(unsigned, f); return (u + 0x7fffu + ((u >> 16) & 1u)) >> 16; }
__device__ __forceinline__ unsigned pk2(float lo, float hi) { return f2bf(lo) | (f2bf(hi) << 16); }
__device__ __forceinline__ float lo_bf(unsigned w) { return __builtin_bit_cast(float, w << 16); }
__device__ __forceinline__ float hi_bf(unsigned w) { return __builtin_bit_cast(float, w & 0xffff0000u); }
__device__ __forceinline__ float wave_sum(float v) {
#pragma unroll
    for (int o = 1; o < 64; o <<= 1) v += __shfl_xor(v, o);
    return v;
}
__device__ __forceinline__ float sigmoidf_(float x) { return 1.0f / (1.0f + __expf(-x)); }
__device__ __forceinline__ float siluf_(float x) { return x / (1.0f + __expf(-x)); }
__device__ __forceinline__ float log_sigmoidf_(float x) { return fminf(x, 0.f) - log1pf(__expf(-fabsf(x))); }
__device__ __forceinline__ float gelu_tanhf_(float y) { const float t = 0.7978845608028654f * (y + 0.044715f * y * y * y); const float e = __expf(2.f * t); return 0.5f * y * (1.f + (1.f - 2.f / (e + 1.f))); }
__device__ __forceinline__ void sincos_acc(float x, float& s, float& c) {
    const float k = rintf(x * 0.63661977236758134f);
    float r = fmaf(-k, 1.57079637050628662109375f, x);
    r = fmaf(-k, -4.37113882867379e-8f, r);
    const int q = ((int)k) & 3;
    const float r2 = r * r;
    const float sp = r + r * r2 * (-1.6666654611e-1f + r2 * (8.3321608736e-3f + r2 * (-1.9515295891e-4f)));
    const float cp = 1.0f - 0.5f * r2 + r2 * r2 * (4.166664568298827e-2f + r2 * (-1.388731625493765e-3f + r2 * 2.443315711809948e-5f));
    s = (q == 0) ? sp : (q == 1) ? cp : (q == 2) ? -sp : -cp;
    c = (q == 0) ? cp : (q == 1) ? -sp : (q == 2) ? -cp : sp;
}
__device__ __forceinline__ int flip_pos(int p) { return p < NCTX ? (NCTX - 1 - p) : (LTOT + NCTX - 1 - p); }

struct EpiStoreBf16 {
    static constexpr bool PERM = true, AFTER_DRAIN = false;
    bf16* O; int ldc;
    __device__ __forceinline__ void operator()(const pg8::f32x4 (&acc)[2][2][4][2], const pg8::Unit& u, int wr, int wc, int fr, int fq) const {
        const int row0 = u.pm * 256 + wr * 64 + fr, col0 = u.pn * 256 + wc * 32 + 8 * fq;
#pragma unroll
        for (int ai = 0; ai < 2; ++ai)
#pragma unroll
            for (int m = 0; m < 4; ++m) { bf16* rowp = O + (size_t)(row0 + ai * 128 + m * 16) * ldc + col0;
#pragma unroll
                for (int bj = 0; bj < 2; ++bj) { const pg8::f32x4 v0 = acc[ai][bj][m][0], v1 = acc[ai][bj][m][1];
                    pg8::u32x4 w; w.x = pg8::cvt_pk_bf16(v0[0], v0[1]); w.y = pg8::cvt_pk_bf16(v0[2], v0[3]); w.z = pg8::cvt_pk_bf16(v1[0], v1[1]); w.w = pg8::cvt_pk_bf16(v1[2], v1[3]);
                    *(pg8::u32x4*)(rowp + bj * 128) = w; } }
    }
};
struct EpiGlu {
    static constexpr bool PERM = true, AFTER_DRAIN = false;
    const bf16* Z; const bf16* P; bf16* O; const float* bias;
    __device__ __forceinline__ void operator()(const pg8::f32x4 (&acc)[2][2][4][2], const pg8::Unit& u, int wr, int wc, int fr, int fq) const {
        const int row0 = u.pm * 256 + wr * 64 + fr, col0 = u.pn * 256 + wc * 32 + 8 * fq;
#pragma unroll
        for (int ai = 0; ai < 2; ++ai)
#pragma unroll
            for (int m = 0; m < 4; ++m) { const size_t row = (size_t)(row0 + ai * 128 + m * 16);
#pragma unroll
                for (int bj = 0; bj < 2; ++bj) { const int col = col0 + bj * 128;
                    const pg8::u32x4 z8 = *(const pg8::u32x4*)(Z + row * 1024 + col), g8 = *(const pg8::u32x4*)(P + row * NP + CC_G + col);
                    const pg8::f32x4 b0 = *(const pg8::f32x4*)(bias + col), b1 = *(const pg8::f32x4*)(bias + col + 4);
                    const pg8::f32x4 v0 = acc[ai][bj][m][0] + b0, v1 = acc[ai][bj][m][1] + b1;
                    float o[8];
                    o[0] = lo_bf(z8.x) * sigmoidf_(v0[0]) * siluf_(lo_bf(g8.x)); o[1] = hi_bf(z8.x) * sigmoidf_(v0[1]) * siluf_(hi_bf(g8.x));
                    o[2] = lo_bf(z8.y) * sigmoidf_(v0[2]) * siluf_(lo_bf(g8.y)); o[3] = hi_bf(z8.y) * sigmoidf_(v0[3]) * siluf_(hi_bf(g8.y));
                    o[4] = lo_bf(z8.z) * sigmoidf_(v1[0]) * siluf_(lo_bf(g8.z)); o[5] = hi_bf(z8.z) * sigmoidf_(v1[1]) * siluf_(hi_bf(g8.z));
                    o[6] = lo_bf(z8.w) * sigmoidf_(v1[2]) * siluf_(lo_bf(g8.w)); o[7] = hi_bf(z8.w) * sigmoidf_(v1[3]) * siluf_(hi_bf(g8.w));
                    pg8::u32x4 w; w.x = pg8::cvt_pk_bf16(o[0], o[1]); w.y = pg8::cvt_pk_bf16(o[2], o[3]); w.z = pg8::cvt_pk_bf16(o[4], o[5]); w.w = pg8::cvt_pk_bf16(o[6], o[7]);
                    *(pg8::u32x4*)(O + row * DM + 2048 + col) = w; } }
    }
};
struct EpiOut {
    static constexpr bool PERM = false, AFTER_DRAIN = false;
    const float* src_ctx; const float* src_lat; float* dst_ctx; float* dst_lat; const float* modl;
    __device__ __forceinline__ void operator()(const pg8::f32x4 (&acc)[2][2][4][2], const pg8::Unit& u, int wr, int wc, int fr, int fq) const {
        const int b = u.pm / 17, t = u.pm % 17;
        const float* gt = modl + (size_t)(t == 0 ? 4 : b) * 12288 + 8192;
        const size_t rbase = (t == 0) ? (size_t)b * NCTX : (size_t)b * SEQ + (size_t)(t - 1) * 256;
        const float* src = (t == 0) ? src_ctx : src_lat; float* dst = (t == 0) ? dst_ctx : dst_lat;
        const int rr0 = wr * 64 + fr, col0 = u.pn * 256 + wc * 32 + 4 * fq;
        pg8::f32x4 gv[2][2];
#pragma unroll
        for (int bj = 0; bj < 2; ++bj)
#pragma unroll
            for (int n = 0; n < 2; ++n) gv[bj][n] = *(const pg8::f32x4*)(gt + col0 + bj * 128 + n * 16);
#pragma unroll
        for (int ai = 0; ai < 2; ++ai)
#pragma unroll
            for (int m = 0; m < 4; ++m) { const size_t off = (rbase + rr0 + ai * 128 + m * 16) * DM + col0;
#pragma unroll
                for (int bj = 0; bj < 2; ++bj)
#pragma unroll
                    for (int n = 0; n < 2; ++n) { const pg8::f32x4 s = *(const pg8::f32x4*)(src + off + bj * 128 + n * 16);
                        *(pg8::f32x4*)(dst + off + bj * 128 + n * 16) = s + gv[bj][n] * acc[ai][bj][m][n]; } }
    }
};
struct RowOrder {
    pg8::StaticOrder S; int lat;
    __device__ __forceinline__ void init(int N, int G, int c, int lat_) { lat = lat_; S.init(lat_ ? 64 * 256 : MROWS, N, G, c); }
    __device__ __forceinline__ bool next(int i, pg8::Unit& u) const { if (!S.next(i, u)) return false; if (lat) u.pm = (u.pm >> 4) * 17 + 1 + (u.pm & 15); return true; }
    __device__ __forceinline__ void a_ready(const pg8::Unit&) const {}
    __device__ __forceinline__ void done(const pg8::Unit&) const {}
};

__device__ __forceinline__ void transpose_item(const float* W, int K, int Nsrc, int nsrc0, int k0, bf16* WT, int ndst0, LAS float* scr, int lane) {
    if (nsrc0 >= 0) {
#pragma unroll 8
        for (int i = 0; i < 32; ++i) { const int kk = 2 * i + (lane >> 5); scr[kk * 33 + (lane & 31)] = W[(size_t)(k0 + kk) * Nsrc + nsrc0 + (lane & 31)]; }
    } else {
#pragma unroll 8
        for (int i = 0; i < 32; ++i) { const int kk = 2 * i + (lane >> 5); scr[kk * 33 + (lane & 31)] = 0.f; }
    }
    LDS_WAIT(); asm volatile("" ::: "memory");
    const int c = lane & 7;
#pragma unroll
    for (int j = 0; j < 4; ++j) { const int n = (lane >> 3) + 8 * j; const LAS float* s = scr + (8 * c) * 33 + n;
        v4u o; o.x = pk2(s[0 * 33], s[1 * 33]); o.y = pk2(s[2 * 33], s[3 * 33]); o.z = pk2(s[4 * 33], s[5 * 33]); o.w = pk2(s[6 * 33], s[7 * 33]);
        *(v4u*)(WT + (size_t)(ndst0 + n) * K + k0 + 8 * c) = o; }
    LDS_WAIT(); asm volatile("" ::: "memory");
}

__device__ __forceinline__ void phase_a(KP kp, int layer, LAS unsigned char* lds, int tid, int lane, int wave, int bid, int G) {
    unsigned char* ws = kp->ws;
    float* mod = (float*)(ws + WS_MOD);
    {
        LAS float* sc = (LAS float*)lds;
        LAS float* red = (LAS float*)(lds + 81920);
        const float* cin = kp->in[1]; const float* cctx = kp->in[3]; const float* wada = kp->in[5] + (size_t)layer * DM * 12288; const float* bada = kp->in[6] + (size_t)layer * 12288;
        bool have = false;
        for (int u = bid; u < 192; u += G) {
            if (!have) {
                for (int i = tid; i < 5 * DM; i += 512) { const int bi = i / DM, k = i % DM; const float v = bi < 4 ? cin[bi * DM + k] : cctx[k]; sc[i] = v / (1.0f + expf(-v)); }
                __syncthreads(); have = true;
            }
            const float* W = wada + u * 64 + lane;
            float acc0 = 0.f, acc1 = 0.f, acc2 = 0.f, acc3 = 0.f, acc4 = 0.f;
            const int k0 = wave * 512;
#pragma unroll 8
            for (int k = 0; k < 512; ++k) { const float w = W[(size_t)(k0 + k) * 12288];
                acc0 += sc[0 * DM + k0 + k] * w; acc1 += sc[1 * DM + k0 + k] * w; acc2 += sc[2 * DM + k0 + k] * w; acc3 += sc[3 * DM + k0 + k] * w; acc4 += sc[4 * DM + k0 + k] * w; }
            red[(wave * 5 + 0) * 64 + lane] = acc0; red[(wave * 5 + 1) * 64 + lane] = acc1; red[(wave * 5 + 2) * 64 + lane] = acc2; red[(wave * 5 + 3) * 64 + lane] = acc3; red[(wave * 5 + 4) * 64 + lane] = acc4;
            __syncthreads();
            if (tid < 320) { const int bi = tid / 64, cl = tid % 64; float s = 0.f;
#pragma unroll
                for (int w = 0; w < 8; ++w) s += red[(w * 5 + bi) * 64 + cl];
                mod[(size_t)(layer * 5 + bi) * 12288 + u * 64 + cl] = s + bada[u * 64 + cl]; }
            __syncthreads();
        }
        __syncthreads();
    }
    {
        LAS float* scr = (LAS float*)(lds + wave * 16384);
        const int gw = bid * 8 + wave, NGW = G * 8;
        const float* win = kp->in[7] + (size_t)layer * DM * NIN; const float* wout = kp->in[25] + (size_t)layer * DM * DM; const float* wglu = kp->in[21] + (size_t)layer * 1024 * 1024;
        bf16* WIN = (bf16*)(ws + WS_WIN); bf16* WOUT = (bf16*)(ws + WS_WOUT); bf16* WGLU = (bf16*)(ws + WS_WGLU);
        constexpr int I_IN = 64 * (NP / 32), I_OUT = 64 * (DM / 32), I_GLU = 16 * 32;
        for (int it = gw; it < I_IN + I_OUT + I_GLU; it += NGW) {
            int r = it;
            if (r < I_IN) { const int kb = r / (NP / 32), nb = r % (NP / 32), nd = nb * 32;
                const int ns = nd < 7168 ? nd : (nd < 13312 ? nd + 32 : (nd < NIN ? 7168 + (nd - 13312) : -1));
                transpose_item(win, DM, NIN, ns, kb * 64, WIN, nd, scr, lane); continue; }
            r -= I_IN;
            if (r < I_OUT) { const int kb = r / (DM / 32), nb = r % (DM / 32); transpose_item(wout, DM, DM, nb * 32, kb * 64, WOUT, nb * 32, scr, lane); continue; }
            r -= I_OUT;
            { const int kb = r / 32, nb = r % 32; transpose_item(wglu, 1024, 1024, nb * 32, kb * 64, WGLU, nb * 32, scr, lane); }
        }
    }
}

__device__ __forceinline__ void phase_b(KP kp, int layer, int lane, int wave, int bid, int G) {
    unsigned char* ws = kp->ws;
    const float* src_ctx = layer == 0 ? kp->in[2] : (const float*)(ws + WS_HC);
    const float* src_lat = layer == 0 ? kp->in[0] : (const float*)(ws + WS_HL);
    const float* mod = (const float*)(ws + WS_MOD) + (size_t)layer * 5 * 12288;
    const float* ng = kp->in[4] + (size_t)layer * DM;
    bf16* HN = (bf16*)(ws + WS_HN);
    const int gw = bid * 8 + wave, NGW = G * 8;
    for (int row = gw; row < MROWS; row += NGW) {
        const int b = row / LTOT, l = row % LTOT;
        const float* hrow = l < NCTX ? src_ctx + ((size_t)b * NCTX + l) * DM : src_lat + ((size_t)b * SEQ + (l - NCTX)) * DM;
        const float* md = mod + (size_t)(l < NCTX ? 4 : b) * 12288;
        f32x4 v[16]; float s = 0.f;
#pragma unroll
        for (int j = 0; j < 16; ++j) { v[j] = *(const f32x4*)(hrow + 4 * (lane + 64 * j)); s += (v[j].x * v[j].x + v[j].y * v[j].y) + (v[j].z * v[j].z + v[j].w * v[j].w); }
        s = wave_sum(s);
        const float rstd = 1.0f / sqrtf(s * (1.0f / DM) + EPSN);
#pragma unroll
        for (int j = 0; j < 16; ++j) { const int col = 4 * (lane + 64 * j);
            const f32x4 g4 = *(const f32x4*)(ng + col), sh = *(const f32x4*)(md + col), sc = *(const f32x4*)(md + DM + col);
            const f32x4 y = v[j] * rstd * g4 * (sc + 1.0f) + sh;
            v2u o; o.x = pk2(y.x, y.y); o.y = pk2(y.z, y.w);
            *(v2u*)(HN + (size_t)row * DM + col) = o; }
    }
}

template <int MODE>
__device__ __forceinline__ void naive_lin_unit(KP kp, int layer, int b, int hd, int dir, LAS unsigned char* lds, int tid) {
    constexpr int DV = MODE == 0 ? 128 : 256, NPART = 512 / DV, ND = 128 / NPART;
    LAS float* qs = (LAS float*)lds; LAS float* ks = qs + 256; LAS float* dsv = ks + 256; LAS float* po = dsv + 256;
    const int e = tid % DV, part = tid / DV, d0 = part * ND;
    const bf16* P = (const bf16*)(kp->ws + WS_P); bf16* RAW = (bf16*)(kp->ws + WS_RAW) + (size_t)dir * MROWS * DM;
    float s[ND];
#pragma unroll
    for (int i = 0; i < ND; ++i) s[i] = 0.f;
    const int qcol = (MODE == 0 ? CA_Q : MODE == 1 ? CB_Q : CD_Q) + hd * 128;
    const int kcol = (MODE == 0 ? (dir ? CA_FB : CA_FF) : MODE == 1 ? CB_K : CD_K) + hd * 128;
    const int vcol = (MODE == 0 ? CA_I : MODE == 1 ? CB_V : CD_V) + hd * DV;
    const int ocol = (MODE == 0 ? 0 : MODE == 1 ? 1024 : 3072) + hd * DV;
    const int d = tid & 127;
    float lbv = 0.f, bias = 0.f, gam = 0.f, frq = 0.f, wg[16];
#pragma unroll
    for (int r = 0; r < 16; ++r) wg[r] = 0.f;
    if (tid < 128) {
        if (MODE == 0) { if (layer == 1) { const float* lbl = kp->in[8]; lbv = 1.0f / (1.0f + expf(-(lbl[(2 + dir) * 1024 + hd * 128 + d] - lbl[dir * 1024 + hd * 128 + d]))); } }
        if (MODE == 1) { const float* w = kp->in[10] + (size_t)(layer * 2 + dir) * 16 * 512 + hd * 128 + d;
#pragma unroll
            for (int r = 0; r < 16; ++r) wg[r] = w[r * 512];
            bias = kp->in[11][(layer * 2 + dir) * 512 + hd * 128 + d]; }
        if (MODE == 2) { gam = 1.0f / (1.0f + expf(-kp->in[23][(layer * 2 + dir) * 4 + hd])); frq = exp2f(-(float)(d & 31) * (13.287712379549449f / 32.0f)); }
    }
    for (int p = 0; p < LTOT; ++p) {
        const int l = dir ? flip_pos(p) : p; const size_t row = (size_t)b * LTOT + l; const bf16* pr = P + row * NP; const int buf = (p & 1) * 128;
        if (tid < 128) {
            float q, key, dec;
            if (MODE == 0) { q = bf2f(pr[qcol + d]); const float z = bf2f(pr[kcol + d]); const float sg = 1.0f / (1.0f + __expf(-z)), sgn = 1.0f / (1.0f + __expf(z));
                dec = fmaxf(lbv + (1.0f - lbv) * sg, 1e-6f); key = (1.0f - lbv) * sgn; }
            if (MODE == 1) { q = bf2f(pr[qcol + d]) * 0.08838834764831845f; key = bf2f(pr[kcol + d]); float x = bias;
#pragma unroll
                for (int r = 0; r < 16; ++r) x += bf2f(pr[CB_LF + dir * 16 + r]) * wg[r];
                dec = __expf(log_sigmoidf_(x) * (1.0f / 16.0f)); }
            if (MODE == 2) { const int j = d & 63; const float q1 = bf2f(pr[qcol + j]), q2 = bf2f(pr[qcol + j + 64]), k1 = bf2f(pr[kcol + j]), k2 = bf2f(pr[kcol + j + 64]);
                float cs = 1.f, sn = 0.f;
                if (l >= NCTX) { const int t = l - NCTX; const float pos = (float)((j < 32) ? (t >> 6) : (t & 63)); sincos_acc(pos * frq, sn, cs); }
                q = ((d < 64) ? (q1 * cs - q2 * sn) : (q1 * sn + q2 * cs)) * 0.08838834764831845f; key = (d < 64) ? (k1 * cs - k2 * sn) : (k1 * sn + k2 * cs); dec = gam; }
            qs[buf + d] = q; ks[buf + d] = key; dsv[buf + d] = dec;
        }
        const float v = bf2f(pr[vcol + e]);
        __syncthreads();
        float acc = 0.f;
#pragma unroll
        for (int i = 0; i < ND; ++i) { s[i] = dsv[buf + d0 + i] * s[i] + ks[buf + d0 + i] * v; acc += s[i] * qs[buf + d0 + i]; }
        po[part * 256 + e] = acc;
        __syncthreads();
        if (part == 0) { float tot = 0.f;
#pragma unroll
            for (int pp = 0; pp < NPART; ++pp) tot += po[pp * 256 + e];
            RAW[row * DM + ocol + e] = (bf16)f2bf(tot); }
    }
    __syncthreads();
}
__device__ __forceinline__ void naive_s5_unit(KP kp, int layer, int b, int g, int dir, int lane) {
    const int ld = layer * 2 + dir; const int p = lane;
    const float lre = fminf(kp->in[13][(ld * 64 + g) * 64 + p], -1e-4f), lim = kp->in[14][(ld * 64 + g) * 64 + p];
    const float dt = expf(kp->in[15][ld * 64 + g]);
    const float xr_ = lre * dt, ang = lim * dt;
    float sn, cs, snh, csh; sincos_acc(ang, sn, cs); sincos_acc(0.5f * ang, snh, csh);
    const float mag = expf(xr_), em1 = expm1f(xr_);
    const float lbr = mag * cs, lbi = mag * sn;
    const float nr = em1 * cs - 2.0f * snh * snh, ni = mag * sn;
    const float den = lre * lre + lim * lim;
    const float cr = (nr * lre + ni * lim) / den, ci = (ni * lre - nr * lim) / den;
    float bbr[16], bbi[16], cre[16], cim[16];
    const float* bre = kp->in[16] + ((size_t)(ld * 64 + g) * 64 + p) * 16; const float* bim = kp->in[17] + ((size_t)(ld * 64 + g) * 64 + p) * 16;
    const float* cre_p = kp->in[18] + (size_t)(ld * 64 + g) * 16 * 64 + p; const float* cim_p = kp->in[19] + (size_t)(ld * 64 + g) * 16 * 64 + p;
#pragma unroll
    for (int h = 0; h < 16; ++h) { const float br = bre[h], bi = bim[h]; bbr[h] = cr * br - ci * bi; bbi[h] = cr * bi + ci * br; cre[h] = cre_p[h * 64]; cim[h] = cim_p[h * 64]; }
    const bf16* P = (const bf16*)(kp->ws + WS_P); bf16* RAW = (bf16*)(kp->ws + WS_RAW) + (size_t)dir * MROWS * DM;
    float xr = 0.f, xi = 0.f;
    for (int ps = 0; ps < LTOT; ++ps) {
        const int l = dir ? flip_pos(ps) : ps; const size_t row = (size_t)b * LTOT + l;
        const v4u u0 = *(const v4u*)(P + row * NP + CC_U + g * 16), u1 = *(const v4u*)(P + row * NP + CC_U + g * 16 + 8);
        float u[16];
        u[0] = lo_bf(u0.x); u[1] = hi_bf(u0.x); u[2] = lo_bf(u0.y); u[3] = hi_bf(u0.y); u[4] = lo_bf(u0.z); u[5] = hi_bf(u0.z); u[6] = lo_bf(u0.w); u[7] = hi_bf(u0.w);
        u[8] = lo_bf(u1.x); u[9] = hi_bf(u1.x); u[10] = lo_bf(u1.y); u[11] = hi_bf(u1.y); u[12] = lo_bf(u1.z); u[13] = hi_bf(u1.z); u[14] = lo_bf(u1.w); u[15] = hi_bf(u1.w);
        float bur = 0.f, bui = 0.f;
#pragma unroll
        for (int h = 0; h < 16; ++h) { bur += bbr[h] * u[h]; bui += bbi[h] * u[h]; }
        const float nxr = lbr * xr - lbi * xi + bur, nxi = lbr * xi + lbi * xr + bui;
        xr = nxr; xi = nxi;
        float outv = 0.f;
#pragma unroll
        for (int h = 0; h < 16; ++h) { const float y = wave_sum(cre[h] * xr - cim[h] * xi); outv = (lane == h) ? y : outv; }
        if (lane < 16) RAW[row * DM + 2048 + g * 16 + lane] = (bf16)f2bf(outv);
    }
}
__device__ __forceinline__ void phase_d_naive(KP kp, int layer, LAS unsigned char* lds, int tid, int lane, int wave, int bid, int G) {
    for (int u = bid; u < 192; u += G) {
        if (u < 64) naive_lin_unit<0>(kp, layer, u >> 4, (u >> 1) & 7, u & 1, lds, tid);
        else if (u < 96) { const int v = u - 64; naive_lin_unit<1>(kp, layer, v >> 3, (v >> 1) & 3, v & 1, lds, tid); }
        else if (u < 128) { const int v = u - 96; naive_lin_unit<2>(kp, layer, v >> 3, (v >> 1) & 3, v & 1, lds, tid); }
        else { const int wu = (u - 128) * 8 + wave; naive_s5_unit(kp, layer, wu >> 7, (wu >> 1) & 63, wu & 1, lane); }
    }
}

__device__ __forceinline__ void phase_e(KP kp, int layer, int lane, int wave, int bid, int G) {
    unsigned char* ws = kp->ws;
    const bf16* P = (const bf16*)(ws + WS_P); const bf16* RF = (const bf16*)(ws + WS_RAW); const bf16* RB = RF + (size_t)MROWS * DM;
    bf16* O = (bf16*)(ws + WS_O); bf16* Z = (bf16*)(ws + WS_Z);
    const float* ga = kp->in[9] + layer * 128; const float* gb = kp->in[12] + layer * 256; const float* gd = kp->in[24] + layer * 256; const float* sd = kp->in[20] + layer * 1024;
    const int gw = bid * 8 + wave, NGW = G * 8;
    for (int row = gw; row < MROWS; row += NGW) {
        const bf16* pr = P + (size_t)row * NP; const bf16* rf = RF + (size_t)row * DM; const bf16* rb = RB + (size_t)row * DM; bf16* orow = O + (size_t)row * DM;
#pragma unroll 2
        for (int hd = 0; hd < 8; ++hd) { const int c = hd * 128 + 2 * lane;
            const unsigned wf = *(const unsigned*)(rf + c), wb = *(const unsigned*)(rb + c), wgt = *(const unsigned*)(pr + CA_G + c);
            const float v0 = lo_bf(wf) + lo_bf(wb), v1 = hi_bf(wf) + hi_bf(wb);
            const float ss = wave_sum(v0 * v0 + v1 * v1); const float r = 1.0f / sqrtf(ss * (1.0f / 128.0f) + EPSN);
            *(unsigned*)(orow + c) = pk2(v0 * r * ga[2 * lane] * siluf_(lo_bf(wgt)), v1 * r * ga[2 * lane + 1] * siluf_(hi_bf(wgt))); }
#pragma unroll 2
        for (int hd = 0; hd < 4; ++hd) { const int c = hd * 256 + 4 * lane;
            const v2u wf = *(const v2u*)(rf + 1024 + c), wb = *(const v2u*)(rb + 1024 + c), wgt = *(const v2u*)(pr + CB_G + c);
            const float v0 = lo_bf(wf.x) + lo_bf(wb.x), v1 = hi_bf(wf.x) + hi_bf(wb.x), v2 = lo_bf(wf.y) + lo_bf(wb.y), v3 = hi_bf(wf.y) + hi_bf(wb.y);
            const float ss = wave_sum((v0 * v0 + v1 * v1) + (v2 * v2 + v3 * v3)); const float r = 1.0f / sqrtf(ss * (1.0f / 256.0f) + EPSN);
            const f32x4 g4 = *(const f32x4*)(gb + 4 * lane);
            v2u o; o.x = pk2(v0 * r * g4.x * siluf_(lo_bf(wgt.x)), v1 * r * g4.y * siluf_(hi_bf(wgt.x))); o.y = pk2(v2 * r * g4.z * siluf_(lo_bf(wgt.y)), v3 * r * g4.w * siluf_(hi_bf(wgt.y)));
            *(v2u*)(orow + 1024 + c) = o; }
#pragma unroll 2
        for (int hd = 0; hd < 4; ++hd) { const int c = hd * 256 + 4 * lane;
            const v2u wf = *(const v2u*)(rf + 3072 + c), wb = *(const v2u*)(rb + 3072 + c), wgt = *(const v2u*)(pr + CD_G + c);
            float v0 = lo_bf(wf.x) + lo_bf(wb.x), v1 = hi_bf(wf.x) + hi_bf(wb.x), v2 = lo_bf(wf.y) + lo_bf(wb.y), v3 = hi_bf(wf.y) + hi_bf(wb.y);
            const float mu = wave_sum((v0 + v1) + (v2 + v3)) * (1.0f / 256.0f);
            v0 -= mu; v1 -= mu; v2 -= mu; v3 -= mu;
            const float ss = wave_sum((v0 * v0 + v1 * v1) + (v2 * v2 + v3 * v3)); const float r = 1.0f / sqrtf(ss * (1.0f / 256.0f) + EPSN);
            const f32x4 g4 = *(const f32x4*)(gd + 4 * lane);
            v2u o; o.x = pk2(v0 * r * g4.x * siluf_(lo_bf(wgt.x)), v1 * r * g4.y * siluf_(hi_bf(wgt.x))); o.y = pk2(v2 * r * g4.z * siluf_(lo_bf(wgt.y)), v3 * r * g4.w * siluf_(hi_bf(wgt.y)));
            *(v2u*)(orow + 3072 + c) = o; }
#pragma unroll
        for (int j = 0; j < 4; ++j) { const int c = 4 * lane + 256 * j;
            const v2u wf = *(const v2u*)(rf + 2048 + c), wb = *(const v2u*)(rb + 2048 + c), wu = *(const v2u*)(pr + CC_U + c);
            const f32x4 d4 = *(const f32x4*)(sd + c);
            const float y0 = lo_bf(wf.x) + lo_bf(wb.x) + d4.x * lo_bf(wu.x), y1 = hi_bf(wf.x) + hi_bf(wb.x) + d4.y * hi_bf(wu.x);
            const float y2 = lo_bf(wf.y) + lo_bf(wb.y) + d4.z * lo_bf(wu.y), y3 = hi_bf(wf.y) + hi_bf(wb.y) + d4.w * hi_bf(wu.y);
            v2u o; o.x = pk2(gelu_tanhf_(y0), gelu_tanhf_(y1)); o.y = pk2(gelu_tanhf_(y2), gelu_tanhf_(y3));
            *(v2u*)(Z + (size_t)row * 1024 + c) = o; }
    }
}

__device__ __forceinline__ void phase_h(KP kp, int lane, int wave, int bid, int G) {
    const float* fg = kp->in[26]; float* out = kp->out;
    const int gw = bid * 8 + wave, NGW = G * 8;
    for (int row = gw; row < NBATCH * SEQ; row += NGW) {
        float* hrow = out + (size_t)row * DM;
        f32x4 v[16]; float s = 0.f;
#pragma unroll
        for (int j = 0; j < 16; ++j) { v[j] = *(const f32x4*)(hrow + 4 * (lane + 64 * j)); s += (v[j].x * v[j].x + v[j].y * v[j].y) + (v[j].z * v[j].z + v[j].w * v[j].w); }
        s = wave_sum(s);
        const float rstd = 1.0f / sqrtf(s * (1.0f / DM) + EPSN);
#pragma unroll
        for (int j = 0; j < 16; ++j) { const int col = 4 * (lane + 64 * j); const f32x4 g4 = *(const f32x4*)(fg + col); *(f32x4*)(hrow + col) = v[j] * rstd * g4; }
    }
}

constexpr int N_PHASES = 15;
__global__ void __launch_bounds__(512, 2) fwd(Args a) {
    extern __shared__ __attribute__((aligned(16))) unsigned char lds_raw[];
    LAS unsigned char* lds = (LAS unsigned char*)lds_raw;
    const int bid = blockIdx.x, G = gridDim.x;
#define TIDS() int tid = threadIdx.x; asm volatile("" : "+v"(tid)); const int lane = tid & 63, wave = __builtin_amdgcn_readfirstlane(tid >> 6); (void)lane; (void)wave
    volatile LAS unsigned* MISC = (volatile LAS unsigned*)(lds + MISC_OFF);
    for (int u = threadIdx.x; u < (LDS_BYTES - LDSCTL_OFF) / 4; u += 512) ((LAS unsigned*)(lds + LDSCTL_OFF))[u] = 0u;
    __syncthreads();
    unsigned* ctl = (unsigned*)(a.ws + WS_CTL);
    const int lo = a.ph_lo, hi = a.ph_hi;
    XcdBarrier bar; bar.bar = ctl + CW_BAR; bar.x = 0; bar.st = nullptr;
    if (hi - lo > 1) bar = xcd_barrier_post(ctl + CW_BAR, MISC + 8);
#define IN(k) (lo <= (k) && (k) < hi)
#define SEAM(k) do { if (IN(k) && IN((k) + 1)) xcd_barrier(bar); } while (0)
    for (int layer = 0; layer < 2; ++layer) {
        const int pb = layer * 7;
        if (IN(pb + 0)) { TIDS(); phase_a(KARGS(), layer, lds, tid, lane, wave, bid, G); }
        SEAM(pb + 0);
        if (IN(pb + 1)) { TIDS(); phase_b(KARGS(), layer, lane, wave, bid, G); }
        SEAM(pb + 1);
        if (IN(pb + 2)) { KP kp = KARGS(); unsigned char* ws = kp->ws;
            pg8::Gemm g{(const bf16*)(ws + WS_HN), (const bf16*)(ws + WS_WIN), MROWS, NP, DM};
            RowOrder S; S.init(NP, G, bid, 0);
            EpiStoreBf16 E{(bf16*)(ws + WS_P), NP};
            pg8::gemm_phase<EpiStoreBf16, RowOrder, true, true>(lds, g, S, E);
        }
        SEAM(pb + 2);
        if (IN(pb + 3)) { TIDS(); phase_d_naive(KARGS(), layer, lds, tid, lane, wave, bid, G); }
        SEAM(pb + 3);
        if (IN(pb + 4)) { TIDS(); phase_e(KARGS(), layer, lane, wave, bid, G); }
        SEAM(pb + 4);
        if (IN(pb + 5)) { KP kp = KARGS(); unsigned char* ws = kp->ws;
            pg8::Gemm g{(const bf16*)(ws + WS_Z), (const bf16*)(ws + WS_WGLU), MROWS, 1024, 1024};
            RowOrder S; S.init(1024, G, bid, 0);
            EpiGlu E{(const bf16*)(ws + WS_Z), (const bf16*)(ws + WS_P), (bf16*)(ws + WS_O), kp->in[22] + layer * 1024};
            pg8::gemm_phase<EpiGlu, RowOrder, true, true>(lds, g, S, E);
        }
        SEAM(pb + 5);
        if (IN(pb + 6)) { KP kp = KARGS(); unsigned char* ws = kp->ws;
            pg8::Gemm g{(const bf16*)(ws + WS_O), (const bf16*)(ws + WS_WOUT), MROWS, DM, DM};
            RowOrder S; S.init(DM, G, bid, layer == 1 ? 1 : 0);
            EpiOut E{layer == 0 ? kp->in[2] : (const float*)(ws + WS_HC), layer == 0 ? kp->in[0] : (const float*)(ws + WS_HL),
                     (float*)(ws + WS_HC), layer == 0 ? (float*)(ws + WS_HL) : kp->out, (const float*)(ws + WS_MOD) + (size_t)layer * 5 * 12288};
            pg8::gemm_phase<EpiOut, RowOrder, true, true>(lds, g, S, E);
        }
        SEAM(pb + 6);
    }
    if (IN(14)) { TIDS(); phase_h(KARGS(), lane, wave, bid, G); }
#undef IN
#undef SEAM
#undef TIDS
}

extern "C" void kernel_launch(void* const* d_in, const int* in_sizes, int n_in, void* d_out, int out_size, void* d_ws, size_t ws_size, hipStream_t stream) {
    static int grid = 0;
    if (grid == 0) {
        if (n_in != 27 || out_size != NBATCH * SEQ * DM || ws_size < WS_END) { fprintf(stderr, "kernel_launch: unexpected problem (n_in %d out %d ws %zu need %zu); nothing launched\n", n_in, out_size, ws_size, (size_t)WS_END); grid = -1; return; }
        int dev = 0, cus = 0;
        if (hipGetDevice(&dev) != hipSuccess || hipDeviceGetAttribute(&cus, hipDeviceAttributeMultiprocessorCount, dev) != hipSuccess) { grid = -1; return; }
        if (hipFuncSetAttribute((const void*)fwd, hipFuncAttributeMaxDynamicSharedMemorySize, LDS_BYTES) != hipSuccess) { fprintf(stderr, "kernel_launch: hipFuncSetAttribute failed\n"); grid = -1; return; }
        (void)hipGetLastError();
        grid = cus;
    }
    if (grid < 0) return;
    (void)hipMemsetAsync((char*)d_ws + WS_CTL, 0, CTL_BYTES, stream);
    Args a{};
    for (int i = 0; i < 27; ++i) a.in[i] = (const float*)d_in[i];
    a.out = (float*)d_out; a.ws = (unsigned char*)d_ws;
#ifndef ONE_LAUNCH
    for (int ph = 0; ph < N_PHASES; ++ph) { a.ph_lo = ph; a.ph_hi = ph + 1; hipLaunchKernelGGL(fwd, dim3(grid), dim3(512), LDS_BYTES, stream, a); }
#else
    a.ph_lo = 0; a.ph_hi = N_PHASES; hipLaunchKernelGGL(fwd, dim3(grid), dim3(512), LDS_BYTES, stream, a);
#endif
}
```

```cpp
#include <hip/hip_runtime.h>
#include <cstdio>
#include <cstdint>
#define ONE_LAUNCH 1
namespace pg8 {
#define PG8_LAS __attribute__((address_space(3)))
typedef unsigned short bf16_t;
typedef short bf16x8 __attribute__((ext_vector_type(8)));
typedef float f32x4 __attribute__((ext_vector_type(4)));
typedef unsigned u32x4 __attribute__((ext_vector_type(4)));
constexpr int BM = 256, BK = 64, HALF = 128, HTB = HALF * BK * 2  , STAGE_BYTES = 8 * HTB, NXCD = 8, WGM = 8;

__host__ __device__ __forceinline__ int lds_byte(int r, int c) { const int st = (r >> 4) * 2 + (c >> 5), rr = r & 15, cc = c & 31, ob = rr * 64 + cc * 2; return st * 1024 + (ob ^ (((ob >> 9) & 1) << 5)); }
__host__ __device__ __forceinline__ void stage_rc(int b, int& R, int& C) { const int st = b / 1024, sb = b % 1024, swz = sb ^ (((sb >> 9) & 1) << 5); R = (st >> 1) * 16 + swz / 64; C = (st & 1) * 32 + (swz % 64) / 2; }
__host__ __device__ __forceinline__ int perm32(int rho) { const int n = rho >> 4, i = rho & 15; return 8 * (i >> 2) + 4 * n + (i & 3); }

struct Unit { int pm, pn; };
struct Gemm { const bf16_t* A; const bf16_t* Bt; int ld, N, K; };

struct StaticOrder {
    int nM, nN, nwg, G, c;
    __host__ __device__ void init(int M, int N, int G_, int c_) { nM = M / BM; nN = N / BM; nwg = nM * nN; G = G_; c = c_; }
    __host__ __device__ bool next(int i, Unit& u) const {
        const long L = (long)i * G + c; if (L >= nwg) return false;
        int wgid = (int)L; { const int q = nwg / NXCD, r = nwg % NXCD, xcd = wgid % NXCD, off = wgid / NXCD; wgid = (xcd < r ? xcd * (q + 1) : r * (q + 1) + (xcd - r) * q) + off; }
        const int nig = WGM * nN, gid = wgid / nig, fm = gid * WGM, gsz = (nM - fm) < WGM ? (nM - fm) : WGM;
        u.pm = fm + ((wgid % nig) % gsz); u.pn = (wgid % nig) / gsz; return true;
    }
    __device__ __forceinline__ void a_ready(const Unit&) const {}
    __device__ __forceinline__ void done(const Unit&) const {}
};

__device__ __forceinline__ unsigned cvt_pk_bf16(float lo, float hi) { unsigned r; asm volatile("v_cvt_pk_bf16_f32 %0, %1, %2" : "=v"(r) : "v"(lo), "v"(hi)); return r; }
typedef float f32x2 __attribute__((ext_vector_type(2)));
__device__ __forceinline__ f32x2 gelu_pk(f32x2 v) {
    const f32x2 av = __builtin_elementwise_abs(v), d = av * 0.2316418882f + 1.0f;
    f32x2 t; t.x = __builtin_amdgcn_rcpf(d.x); t.y = __builtin_amdgcn_rcpf(d.y);
    f32x2 q = t * 0.5307027145f + (-0.7265760135f); q = q * t + 0.7107068705f; q = q * t + (-0.142248368f); q = q * t + 0.127414796f; q = q * t;
    const f32x2 s = (v * v) * (-0.72134752044f);
    f32x2 e; e.x = __builtin_amdgcn_exp2f(s.x); e.y = __builtin_amdgcn_exp2f(s.y);
    const f32x2 m = v * (q * e), r = v - m;
    f32x2 o; o.x = v.x < 0.f ? m.x : r.x; o.y = v.y < 0.f ? m.y : r.y; return o;
}

template <class Epi, class Sched, bool ALIGN_EPI = false, bool SP2 = false>
__device__ __forceinline__ void gemm_phase(PG8_LAS unsigned char* lds, const Gemm g, const Sched& S, const Epi& E) {
    int tid_l = threadIdx.x; asm volatile("" : "+v"(tid_l));
    const int tid = tid_l, wid = __builtin_amdgcn_readfirstlane(tid >> 6), lane = tid & 63, wr = wid >> 2, wc = wid & 3, fr = lane & 15, fq = lane >> 4;
    const int K = g.K, LD = g.ld, nt = K / BK;
    unsigned voffA[2], voffB[2];
#pragma unroll
    for (int i = 0; i < 2; ++i) { int R, C; stage_rc(tid * 16 + i * 8192, R, C); const int Rb = Epi::PERM ? ((R & ~31) + perm32(R & 31)) : R;
        voffA[i] = (unsigned)(R * LD + C) * 2u; voffB[i] = (unsigned)(Rb * LD + C) * 2u; }
    const size_t kstep = (size_t)(BK * 2);
    const size_t hstep = (size_t)HALF * LD * 2;
    const size_t tstep = 2 * hstep;
    const unsigned ldsw = (unsigned)wid * 1024u;
    const int aoff = lds_byte(wr * 64 + fr, fq * 8), boff = lds_byte(wc * 32 + fr, fq * 8);
#define PG8_SA(b, h) (((b) * 2 + (h)) * HTB)
#define PG8_SB(b, h) ((4 + (b) * 2 + (h)) * HTB)
#define PG8_STAGE(bufoff, gbase, voff) do { _Pragma("unroll") for (int _i = 0; _i < 2; ++_i) \
        __builtin_amdgcn_global_load_lds((const unsigned*)((const char*)(gbase) + (voff)[_i]), (PG8_LAS unsigned*)(lds + (bufoff) + ldsw + _i * 8192), 16, 0, 0); } while (0)
#define PG8_LDA(dst, b, h) do { _Pragma("unroll") for (int m = 0; m < 4; ++m) _Pragma("unroll") for (int k = 0; k < 2; ++k) dst[m][k] = *(const PG8_LAS bf16x8*)(lds + PG8_SA(b, h) + aoff + m * 2048 + k * 1024); } while (0)
#define PG8_LDB(dst, b, h) do { _Pragma("unroll") for (int n = 0; n < 2; ++n) _Pragma("unroll") for (int k = 0; k < 2; ++k) dst[n][k] = *(const PG8_LAS bf16x8*)(lds + PG8_SB(b, h) + boff + n * 2048 + k * 1024); } while (0)
#define PG8_MMA(ai, bj, At, Bt) do { __builtin_amdgcn_s_setprio(1); _Pragma("unroll") for (int m = 0; m < 4; ++m) _Pragma("unroll") for (int n = 0; n < 2; ++n) _Pragma("unroll") for (int k = 0; k < 2; ++k) \
        acc[ai][bj][m][n] = __builtin_amdgcn_mfma_f32_16x16x32_bf16(Bt[n][k], At[m][k], acc[ai][bj][m][n], 0, 0, 0); __builtin_amdgcn_s_setprio(0); } while (0)
#define PG8_WAIT_V(n) asm volatile("s_waitcnt vmcnt(" #n ")" ::: "memory")
#define PG8_WAIT_L(n) asm volatile("s_waitcnt lgkmcnt(" #n ")" ::: "memory")
#define PG8_BAR __builtin_amdgcn_s_barrier()
#define PG8_SCHED __builtin_amdgcn_sched_barrier(0)
    Unit cur, nxt; int ui = 0;
    if (!S.next(0, cur)) return;
    f32x4 acc[2][2][4][2];
#pragma unroll
    for (int a = 0; a < 2; ++a)
#pragma unroll
        for (int b = 0; b < 2; ++b)
#pragma unroll
            for (int m = 0; m < 4; ++m)
#pragma unroll
                for (int n = 0; n < 2; ++n) acc[a][b][m][n] = (f32x4){0.f, 0.f, 0.f, 0.f};
    bf16x8 At[4][2], B0[2][2], B1[2][2];
    const char* cA = (const char*)g.A + (size_t)cur.pm * tstep; const char* cB = (const char*)g.Bt + (size_t)cur.pn * tstep;
    S.a_ready(cur);
    if constexpr (SP2) {
        PG8_STAGE(PG8_SB(0, 0), cB, voffB); PG8_STAGE(PG8_SB(0, 1), cB + hstep, voffB); PG8_STAGE(PG8_SA(0, 0), cA, voffA); PG8_STAGE(PG8_SA(0, 1), cA + hstep, voffA);
        if (wr == 1) PG8_BAR;
        PG8_WAIT_V(2); PG8_BAR;
        PG8_STAGE(PG8_SB(1, 0), cB + kstep, voffB); PG8_STAGE(PG8_SA(1, 0), cA + kstep, voffA); PG8_STAGE(PG8_SB(1, 1), cB + hstep + kstep, voffB);
        PG8_WAIT_V(6); PG8_BAR;
    } else {
        PG8_STAGE(PG8_SB(0, 0), cB, voffB); PG8_STAGE(PG8_SA(0, 0), cA, voffA); PG8_STAGE(PG8_SB(0, 1), cB + hstep, voffB); PG8_STAGE(PG8_SA(0, 1), cA + hstep, voffA);
        if (wr == 1) PG8_BAR;
        PG8_WAIT_V(4); PG8_BAR;
        PG8_STAGE(PG8_SB(1, 0), cB + kstep, voffB); PG8_STAGE(PG8_SA(1, 0), cA + kstep, voffA); PG8_STAGE(PG8_SB(1, 1), cB + hstep + kstep, voffB);
        PG8_WAIT_V(6); PG8_BAR;
    }
    for (;;) {
        const bool has_next = S.next(ui + 1, nxt);
        const char* nA = has_next ? (const char*)g.A + (size_t)nxt.pm * tstep : cA; const char* nB = has_next ? (const char*)g.Bt + (size_t)nxt.pn * tstep : cB;
        for (int t = 0; t < nt; t += 2) {
            const bool last = (t == nt - 2);
            const char* a1 = cA + (size_t)(t + 1) * kstep;
            const char* a2 = last ? nA : cA + (size_t)(t + 2) * kstep; const char* b2 = last ? nB : cB + (size_t)(t + 2) * kstep;
            const char* a3 = a2 + kstep; const char* b3 = b2 + kstep;
            if (last && has_next) S.a_ready(nxt);
            if constexpr (SP2) {
            PG8_LDB(B0, 0, 0); PG8_LDB(B1, 0, 1); PG8_SCHED; PG8_LDA(At, 0, 0); PG8_STAGE(PG8_SA(1, 1), a1 + hstep, voffA);
            PG8_WAIT_V(8); PG8_WAIT_L(0); PG8_BAR; PG8_MMA(0, 0, At, B0); PG8_MMA(0, 1, At, B1); PG8_BAR; PG8_SCHED;
            PG8_LDA(At, 0, 1); PG8_STAGE(PG8_SB(0, 0), b2, voffB); PG8_STAGE(PG8_SB(0, 1), b2 + hstep, voffB); PG8_STAGE(PG8_SA(0, 0), a2, voffA);
            PG8_WAIT_V(8); PG8_WAIT_L(0); PG8_BAR; PG8_MMA(1, 0, At, B0); PG8_MMA(1, 1, At, B1); PG8_BAR; PG8_SCHED;
            PG8_LDB(B0, 1, 0); PG8_LDB(B1, 1, 1); PG8_SCHED; PG8_LDA(At, 1, 0); PG8_STAGE(PG8_SA(0, 1), a2 + hstep, voffA);
            PG8_WAIT_V(8); PG8_WAIT_L(0); PG8_BAR; PG8_MMA(0, 0, At, B0); PG8_MMA(0, 1, At, B1); PG8_BAR; PG8_SCHED;
            PG8_LDA(At, 1, 1); PG8_STAGE(PG8_SB(1, 0), b3, voffB); PG8_STAGE(PG8_SB(1, 1), b3 + hstep, voffB); PG8_STAGE(PG8_SA(1, 0), a3, voffA);
            PG8_WAIT_V(8); PG8_WAIT_L(0); PG8_BAR; PG8_MMA(1, 0, At, B0); PG8_MMA(1, 1, At, B1); PG8_BAR; PG8_SCHED;
            } else {
            PG8_LDB(B0, 0, 0); PG8_SCHED; PG8_LDA(At, 0, 0); PG8_STAGE(PG8_SA(1, 1), a1 + hstep, voffA);
            PG8_WAIT_L(8); PG8_BAR; PG8_WAIT_L(0); PG8_MMA(0, 0, At, B0); PG8_BAR; PG8_SCHED;
            PG8_LDB(B1, 0, 1); PG8_STAGE(PG8_SB(0, 0), b2, voffB);
            PG8_BAR; PG8_WAIT_L(0); PG8_MMA(0, 1, At, B1); PG8_BAR;
            PG8_LDA(At, 0, 1); PG8_STAGE(PG8_SA(0, 0), a2, voffA);
            PG8_BAR; PG8_WAIT_L(0); PG8_MMA(1, 0, At, B0); PG8_BAR; PG8_SCHED;
            PG8_STAGE(PG8_SB(0, 1), b2 + hstep, voffB);
            PG8_WAIT_V(6); PG8_BAR; PG8_MMA(1, 1, At, B1); PG8_BAR;
            PG8_LDB(B0, 1, 0); PG8_SCHED; PG8_LDA(At, 1, 0); PG8_STAGE(PG8_SA(0, 1), a2 + hstep, voffA);
            PG8_WAIT_L(8); PG8_BAR; PG8_WAIT_L(0); PG8_MMA(0, 0, At, B0); PG8_BAR; PG8_SCHED;
            PG8_LDB(B1, 1, 1); PG8_STAGE(PG8_SB(1, 0), b3, voffB);
            PG8_BAR; PG8_WAIT_L(0); PG8_MMA(0, 1, At, B1); PG8_BAR;
            PG8_LDA(At, 1, 1); PG8_STAGE(PG8_SA(1, 0), a3, voffA);
            PG8_BAR; PG8_WAIT_L(0); PG8_MMA(1, 0, At, B0); PG8_BAR; PG8_SCHED;
            PG8_STAGE(PG8_SB(1, 1), b3 + hstep, voffB);
            PG8_WAIT_V(6); PG8_BAR; PG8_MMA(1, 1, At, B1); PG8_BAR;
            }
        }
        if constexpr (ALIGN_EPI) { if (wr == 0) PG8_BAR; }
        if constexpr (!Epi::AFTER_DRAIN) { E(acc, cur, wr, wc, fr, fq); S.done(cur); }
        if (!has_next) break;
#pragma unroll
        for (int a = 0; a < 2; ++a)
#pragma unroll
            for (int b = 0; b < 2; ++b)
#pragma unroll
                for (int m = 0; m < 4; ++m)
#pragma unroll
                    for (int n = 0; n < 2; ++n) acc[a][b][m][n] = (f32x4){0.f, 0.f, 0.f, 0.f};
        cur = nxt; cA = nA; cB = nB; ++ui;
        if constexpr (ALIGN_EPI) { if (wr == 1) PG8_BAR; }
    }
    PG8_WAIT_V(0);
    if constexpr (!ALIGN_EPI) { if (wr == 0) PG8_BAR; }
    PG8_BAR;
    if constexpr (Epi::AFTER_DRAIN) { E.fused(acc, cur, wr, wc, fr, fq, lds, wid, lane); S.done(cur); }
#undef PG8_SA
#undef PG8_SB
#undef PG8_STAGE
#undef PG8_LDA
#undef PG8_LDB
#undef PG8_MMA
#undef PG8_WAIT_V
#undef PG8_WAIT_L
#undef PG8_BAR
#undef PG8_SCHED
}
}
#define XB_TMO      128
#define XB_XCNT(j)  (256  + 64 * (j))
#define XB_XSUB(j)  (1280 + 64 * (j))
#define XB_XGEN(j)  (2304 + 64 * (j))
#define XB_TOP      3328
#define XB_TOPGEN   3392
#define XCD_BAR_WORDS 3456
#define XB_SPIN_CAP (1u << 18)
#define LAS __attribute__((address_space(3)))

__device__ __forceinline__ unsigned xb_ld(unsigned* p)              { return __hip_atomic_load(p, __ATOMIC_RELAXED, __HIP_MEMORY_SCOPE_AGENT); }
__device__ __forceinline__ unsigned xb_add(unsigned* p, unsigned v) { return __hip_atomic_fetch_add(p, v, __ATOMIC_RELAXED, __HIP_MEMORY_SCOPE_AGENT); }
__device__ __forceinline__ unsigned xb_xcc_id() { return (unsigned)__builtin_amdgcn_s_getreg((3 << 11) | 20) & 0xFu; }
#define XB_SPIN(cond, bar) do { unsigned _sp = 0; while (cond) { __builtin_amdgcn_s_sleep(1); \
    if ((++_sp & 255u) == 0u) { if (xb_ld(&(bar)[XB_TMO])) break; if (_sp > XB_SPIN_CAP) { atomicAdd(&(bar)[XB_TMO], 1u); break; } } } } while (0)

struct XcdBarrier {
    unsigned* bar; unsigned x;
    volatile LAS unsigned* st;
};

__device__ __forceinline__ XcdBarrier xcd_barrier_post(unsigned* bar, volatile LAS unsigned* st) {
    XcdBarrier b; b.bar = bar; b.x = xb_xcc_id(); b.st = st;
    if (threadIdx.x == 0) (void)xb_add(&bar[XB_XCNT(b.x)], 1u);
    return b;
}
__device__ __forceinline__ void xcd_barrier_complete(unsigned* bar, unsigned x, unsigned& nloc, unsigned& nx) {
    const unsigned G = gridDim.x * gridDim.y * gridDim.z;
    unsigned sum, cnt, mine, sp = 0u;
    for (;;) {
        sum = 0u; cnt = 0u; mine = 0u;
#pragma unroll
        for (unsigned j = 0; j < 16; ++j) { const unsigned c = xb_ld(&bar[XB_XCNT(j)]); sum += c; cnt += (c > 0u) ? 1u : 0u; mine = (j == x) ? c : mine; }
        if (sum == G) break;
        __builtin_amdgcn_s_sleep(1);
        if ((++sp & 255u) == 0u) { if (xb_ld(&bar[XB_TMO])) break; if (sp > XB_SPIN_CAP) { atomicAdd(&bar[XB_TMO], 1u); break; } }
    }
    nloc = mine > 0u ? mine : 1u; nx = cnt > 0u ? cnt : 1u;
}

__device__ __forceinline__ void xcd_barrier(const XcdBarrier& b) {
    asm volatile("s_waitcnt vmcnt(0)" ::: "memory");
    __syncthreads();
    if (threadIdx.x == 0) {
        unsigned* bar = b.bar;
        __builtin_amdgcn_s_waitcnt(0);
        unsigned nloc = b.st[0], nx = b.st[1];
        if (nloc == 0u) { xcd_barrier_complete(bar, b.x, nloc, nx); b.st[0] = nloc; b.st[1] = nx; }
        const unsigned old = xb_add(&bar[XB_XSUB(b.x)], 1u);
        const unsigned gen = old / nloc;
        if (old + 1u == (gen + 1u) * nloc) {
            __builtin_amdgcn_fence(__ATOMIC_RELEASE, "agent");
            asm volatile("s_waitcnt vmcnt(0)" ::: "memory");
            const unsigned og = xb_add(&bar[XB_TOP], 1u);
            const unsigned tg = og / nx;
            if (og + 1u == (tg + 1u) * nx) xb_add(&bar[XB_TOPGEN], 1u);
            else XB_SPIN(xb_ld(&bar[XB_TOPGEN]) == tg, bar);
            __builtin_amdgcn_fence(__ATOMIC_ACQUIRE, "agent");
            xb_add(&bar[XB_XGEN(b.x)], 1u);
            asm volatile("s_waitcnt vmcnt(0)" ::: "memory");
        } else {
            XB_SPIN(xb_ld(&bar[XB_XGEN(b.x)]) == gen, bar);
            __builtin_amdgcn_fence(__ATOMIC_ACQUIRE, "agent");
            asm volatile("s_waitcnt vmcnt(0)" ::: "memory");
        }
    }
    __syncthreads();
}

#define GAS __attribute__((address_space(1)))
typedef unsigned short bf16;
typedef unsigned v4u __attribute__((ext_vector_type(4)));
typedef unsigned v2u __attribute__((ext_vector_type(2)));
typedef float f32x4 __attribute__((ext_vector_type(4)));
#define LDS_WAIT() asm volatile("s_waitcnt lgkmcnt(0)" ::: "memory")

constexpr int DM = 4096, NBATCH = 4, SEQ = 4096, NCTX = 256, LTOT = NCTX + SEQ, MROWS = NBATCH * LTOT;
constexpr int NIN = 13344, NP = 13568, NPG = 13312;
constexpr int CA_Q = 0, CA_FF = 1024, CA_FB = 2048, CA_I = 3072, CA_G = 4096;
constexpr int CB_Q = 5120, CB_K = 5632, CB_V = 6144, CB_G = 7168;
constexpr int CC_U = 8192, CC_G = 9216;
constexpr int CD_Q = 10240, CD_K = 10752, CD_V = 11264, CD_G = 12288;
constexpr int CB_LF = 13312, CB_LB = 13328;
constexpr float EPSN = 1e-6f;

constexpr size_t WS_CTL = 0, CTL_BYTES = 1u << 20;
constexpr size_t WS_WIN = WS_CTL + CTL_BYTES;
constexpr size_t WS_WOUT = WS_WIN + (size_t)NP * DM * 2;
constexpr size_t WS_WGLU = WS_WOUT + (size_t)2 * DM * DM * 2;
constexpr size_t WS_WLR = WS_WGLU + (size_t)2 * 1024 * 1024 * 2;
constexpr size_t WS_MOD = WS_WLR + (size_t)32 * DM * 2;
constexpr size_t WS_HN = WS_MOD + (size_t)2 * 5 * 12288 * 4;
constexpr size_t WS_P = WS_HN + (size_t)MROWS * DM * 2;
constexpr size_t WS_HC = WS_P + (size_t)MROWS * NP * 2;
constexpr size_t WS_HL = WS_HC + (size_t)NBATCH * NCTX * DM * 4;
constexpr size_t WS_O = WS_HL + (size_t)NBATCH * SEQ * DM * 4;
constexpr size_t WS_Z = WS_O + (size_t)MROWS * DM * 2;
constexpr size_t WS_RAW = WS_Z + (size_t)MROWS * 1024 * 2;
constexpr size_t WS_CPART = WS_RAW + (size_t)2 * MROWS * DM * 2;
constexpr size_t WS_END = WS_CPART + (size_t)4 * NBATCH * NCTX * DM * 4;

constexpr int RING_BYTES = 131072, LDSCTL_OFF = 146944, MISC_OFF = LDSCTL_OFF + 320, LDS_BYTES = 147456;
constexpr int CW_BAR = 1024;

struct Args { const float* in[27]; float* out; unsigned char* ws; int ph_lo, ph_hi; };
typedef const __attribute__((address_space(4))) Args* KP;
#define KARGS() ({ KP _p = (KP)__builtin_amdgcn_kernarg_segment_ptr(); asm volatile("" : "+s"(_p)); _p; })

__device__ __forceinline__ float bf2f(bf16 v) { return __builtin_bit_cast(float, (unsigned)v << 16); }
__device__ __forceinline__ unsigned f2bf(float f) { unsigned u = __builtin_bit_cast(unsigned, f); return (u + 0x7fffu + ((u >> 16) & 1u)) >> 16; }
__device__ __forceinline__ unsigned pk2(float lo, float hi) { return f2bf(lo) | (f2bf(hi) << 16); }
typedef float f32x2_ __attribute__((ext_vector_type(2)));
typedef __bf16 bf16x2_ __attribute__((ext_vector_type(2)));
__device__ __forceinline__ unsigned cvtpk(float lo, float hi) { const f32x2_ v = {lo, hi}; return __builtin_bit_cast(unsigned, __builtin_convertvector(v, bf16x2_)); }
template <int CTRL, int ROW_MASK> __device__ __forceinline__ float dpp_f(float x) {
    return __builtin_bit_cast(float, __builtin_amdgcn_update_dpp(0, __builtin_bit_cast(int, x), CTRL, ROW_MASK, 0xf, true));
}
__device__ __forceinline__ float lane_scan(float x, int lane) {
    (void)lane;
    x += dpp_f<0x111, 0xf>(x);
    x += dpp_f<0x112, 0xf>(x);
    x += dpp_f<0x114, 0xf>(x);
    x += dpp_f<0x118, 0xf>(x);
    x += dpp_f<0x142, 0xa>(x);
    x += dpp_f<0x143, 0xc>(x);
    return x;
}

__device__ __forceinline__ float lo_bf(unsigned w) { return __builtin_bit_cast(float, w << 16); }
__device__ __forceinline__ float hi_bf(unsigned w) { return __builtin_bit_cast(float, w & 0xffff0000u); }
__device__ __forceinline__ void unpack8(const v4u w, float* f) {
    f[0] = lo_bf(w.x); f[1] = hi_bf(w.x); f[2] = lo_bf(w.y); f[3] = hi_bf(w.y); f[4] = lo_bf(w.z); f[5] = hi_bf(w.z); f[6] = lo_bf(w.w); f[7] = hi_bf(w.w);
}
__device__ __forceinline__ v4u pack8(const float* f) { v4u w; w.x = pk2(f[0], f[1]); w.y = pk2(f[2], f[3]); w.z = pk2(f[4], f[5]); w.w = pk2(f[6], f[7]); return w; }
__device__ __forceinline__ v4u pack8c(const float* f) { v4u w; w.x = cvtpk(f[0], f[1]); w.y = cvtpk(f[2], f[3]); w.z = cvtpk(f[4], f[5]); w.w = cvtpk(f[6], f[7]); return w; }
__device__ __forceinline__ float wave_sum(float v) {
    const float s = lane_scan(v, 0);
    return __builtin_bit_cast(float, __builtin_amdgcn_readlane(__builtin_bit_cast(int, s), 63));
}
__device__ __forceinline__ float sigmoidf_(float x) { return __builtin_amdgcn_rcpf(1.0f + __builtin_amdgcn_exp2f(-1.4426950408889634f * x)); }
__device__ __forceinline__ float siluf_(float x) { return x * __builtin_amdgcn_rcpf(1.0f + __builtin_amdgcn_exp2f(-1.4426950408889634f * x)); }
__device__ __forceinline__ float log_sigmoidf_(float x) { return fminf(x, 0.f) - log1pf(__expf(-fabsf(x))); }
__device__ __forceinline__ float gelu_tanhf_(float y) { const float t = 0.7978845608028654f * (y + 0.044715f * y * y * y); const float e = __expf(2.f * t); return 0.5f * y * (1.f + (1.f - 2.f / (e + 1.f))); }
__device__ __forceinline__ void sincos_acc(float x, float& s, float& c) {
    const float k = rintf(x * 0.63661977236758134f);
    float r = fmaf(-k, 1.57079637050628662109375f, x);
    r = fmaf(-k, -4.37113882867379e-8f, r);
    const int q = ((int)k) & 3;
    const float r2 = r * r;
    const float sp = r + r * r2 * (-1.6666654611e-1f + r2 * (8.3321608736e-3f + r2 * (-1.9515295891e-4f)));
    const float cp = 1.0f - 0.5f * r2 + r2 * r2 * (4.166664568298827e-2f + r2 * (-1.388731625493765e-3f + r2 * 2.443315711809948e-5f));
    s = (q == 0) ? sp : (q == 1) ? cp : (q == 2) ? -sp : -cp;
    c = (q == 0) ? cp : (q == 1) ? -sp : (q == 2) ? -cp : sp;
}
__device__ __forceinline__ int flip_pos(int p) { return p < NCTX ? (NCTX - 1 - p) : (LTOT + NCTX - 1 - p); }

struct EpiStoreBf16 {
    static constexpr bool PERM = true, AFTER_DRAIN = false;
    bf16* O; int ldc;
    __device__ __forceinline__ void operator()(const pg8::f32x4 (&acc)[2][2][4][2], const pg8::Unit& u, int wr, int wc, int fr, int fq) const {
        const int row0 = u.pm * 256 + wr * 64 + fr, col0 = u.pn * 256 + wc * 32 + 8 * fq;
#pragma unroll
        for (int ai = 0; ai < 2; ++ai)
#pragma unroll
            for (int m = 0; m < 4; ++m) { bf16* rowp = O + (size_t)(row0 + ai * 128 + m * 16) * ldc + col0;
#pragma unroll
                for (int bj = 0; bj < 2; ++bj) { const pg8::f32x4 v0 = acc[ai][bj][m][0], v1 = acc[ai][bj][m][1];
                    pg8::u32x4 w; w.x = pg8::cvt_pk_bf16(v0[0], v0[1]); w.y = pg8::cvt_pk_bf16(v0[2], v0[3]); w.z = pg8::cvt_pk_bf16(v1[0], v1[1]); w.w = pg8::cvt_pk_bf16(v1[2], v1[3]);
                    __builtin_nontemporal_store(w, (pg8::u32x4*)(rowp + bj * 128)); } }
    }
};
struct EpiGlu {
    static constexpr bool PERM = true, AFTER_DRAIN = false;
    const bf16* Z; const bf16* P; bf16* O; const float* bias;
    __device__ __forceinline__ void operator()(const pg8::f32x4 (&acc)[2][2][4][2], const pg8::Unit& u, int wr, int wc, int fr, int fq) const {
        const int row0 = u.pm * 256 + wr * 64 + fr, col0 = u.pn * 256 + wc * 32 + 8 * fq;
#pragma unroll
        for (int ai = 0; ai < 2; ++ai)
#pragma unroll
            for (int m = 0; m < 4; ++m) { const size_t row = (size_t)(row0 + ai * 128 + m * 16);
#pragma unroll
                for (int bj = 0; bj < 2; ++bj) { const int col = col0 + bj * 128;
                    const pg8::u32x4 z8 = *(const pg8::u32x4*)(Z + row * 1024 + col), g8 = *(const pg8::u32x4*)(P + row * NP + CC_G + col);
                    const pg8::f32x4 b0 = *(const pg8::f32x4*)(bias + col), b1 = *(const pg8::f32x4*)(bias + col + 4);
                    const pg8::f32x4 v0 = acc[ai][bj][m][0] + b0, v1 = acc[ai][bj][m][1] + b1;
                    float o[8];
                    o[0] = lo_bf(z8.x) * sigmoidf_(v0[0]) * siluf_(lo_bf(g8.x)); o[1] = hi_bf(z8.x) * sigmoidf_(v0[1]) * siluf_(hi_bf(g8.x));
                    o[2] = lo_bf(z8.y) * sigmoidf_(v0[2]) * siluf_(lo_bf(g8.y)); o[3] = hi_bf(z8.y) * sigmoidf_(v0[3]) * siluf_(hi_bf(g8.y));
                    o[4] = lo_bf(z8.z) * sigmoidf_(v1[0]) * siluf_(lo_bf(g8.z)); o[5] = hi_bf(z8.z) * sigmoidf_(v1[1]) * siluf_(hi_bf(g8.z));
                    o[6] = lo_bf(z8.w) * sigmoidf_(v1[2]) * siluf_(lo_bf(g8.w)); o[7] = hi_bf(z8.w) * sigmoidf_(v1[3]) * siluf_(hi_bf(g8.w));
                    pg8::u32x4 w; w.x = pg8::cvt_pk_bf16(o[0], o[1]); w.y = pg8::cvt_pk_bf16(o[2], o[3]); w.z = pg8::cvt_pk_bf16(o[4], o[5]); w.w = pg8::cvt_pk_bf16(o[6], o[7]);
                    *(pg8::u32x4*)(O + row * DM + 2048 + col) = w; } }
    }
};
struct EpiOut {
    static constexpr bool PERM = false, AFTER_DRAIN = false;
    const float* src_ctx; const float* src_lat; float* dst_ctx; float* dst_lat; const float* modl;
    __device__ __forceinline__ void operator()(const pg8::f32x4 (&acc)[2][2][4][2], const pg8::Unit& u, int wr, int wc, int fr, int fq) const {
        const int b = u.pm / 17, t = u.pm % 17;
        const float* gt = modl + (size_t)(t == 0 ? 4 : b) * 12288 + 8192;
        const size_t rbase = (t == 0) ? (size_t)b * NCTX : (size_t)b * SEQ + (size_t)(t - 1) * 256;
        const float* src = (t == 0) ? src_ctx : src_lat; float* dst = (t == 0) ? dst_ctx : dst_lat;
        const int rr0 = wr * 64 + fr, col0 = u.pn * 256 + wc * 32 + 4 * fq;
        pg8::f32x4 gv[2][2];
#pragma unroll
        for (int bj = 0; bj < 2; ++bj)
#pragma unroll
            for (int n = 0; n < 2; ++n) gv[bj][n] = *(const pg8::f32x4*)(gt + col0 + bj * 128 + n * 16);
#pragma unroll
        for (int ai = 0; ai < 2; ++ai)
#pragma unroll
            for (int m = 0; m < 4; ++m) { const size_t off = (rbase + rr0 + ai * 128 + m * 16) * DM + col0;
#pragma unroll
                for (int bj = 0; bj < 2; ++bj)
#pragma unroll
                    for (int n = 0; n < 2; ++n) { const pg8::f32x4 s = *(const pg8::f32x4*)(src + off + bj * 128 + n * 16);
                        *(pg8::f32x4*)(dst + off + bj * 128 + n * 16) = s + gv[bj][n] * acc[ai][bj][m][n]; } }
    }
};
struct EpiDelta {
    static constexpr bool PERM = true, AFTER_DRAIN = false;
    bf16* dlat; bf16* dctx; const float* modl;
    __device__ __forceinline__ void operator()(const pg8::f32x4 (&acc)[2][2][4][2], const pg8::Unit& u, int wr, int wc, int fr, int fq) const {
        const int b = u.pm / 17, t = u.pm % 17;
        const float* gt = modl + (size_t)(t == 0 ? 4 : b) * 12288 + 8192;
        bf16* dst = (t == 0) ? dctx + (size_t)b * NCTX * DM : dlat + ((size_t)b * SEQ + (size_t)(t - 1) * 256) * DM;
        const int rr0 = wr * 64 + fr, col0 = u.pn * 256 + wc * 32 + 8 * fq;
        pg8::f32x4 gv[2][2];
#pragma unroll
        for (int bj = 0; bj < 2; ++bj)
#pragma unroll
            for (int n = 0; n < 2; ++n) gv[bj][n] = *(const pg8::f32x4*)(gt + col0 + bj * 128 + 4 * n);
#pragma unroll
        for (int ai = 0; ai < 2; ++ai)
#pragma unroll
            for (int m = 0; m < 4; ++m) { bf16* rowp = dst + (size_t)(rr0 + ai * 128 + m * 16) * DM + col0;
#pragma unroll
                for (int bj = 0; bj < 2; ++bj) { const pg8::f32x4 v0 = gv[bj][0] * acc[ai][bj][m][0], v1 = gv[bj][1] * acc[ai][bj][m][1];
                    pg8::u32x4 w; w.x = cvtpk(v0[0], v0[1]); w.y = cvtpk(v0[2], v0[3]); w.z = cvtpk(v1[0], v1[1]); w.w = cvtpk(v1[2], v1[3]);
                    *(pg8::u32x4*)(rowp + bj * 128) = w; } }
    }
};
struct EpiCtxPart {
    static constexpr bool PERM = false, AFTER_DRAIN = false;
    float* part;
    __device__ __forceinline__ void operator()(const pg8::f32x4 (&acc)[2][2][4][2], const pg8::Unit& u, int wr, int wc, int fr, int fq) const {
        const int b = u.pm / 17; const size_t rbase = (size_t)b * NCTX; const int rr0 = wr * 64 + fr, col0 = u.pn * 256 + wc * 32 + 4 * fq;
#pragma unroll
        for (int ai = 0; ai < 2; ++ai)
#pragma unroll
            for (int m = 0; m < 4; ++m) { float* rowp = part + (rbase + rr0 + ai * 128 + m * 16) * DM + col0;
#pragma unroll
                for (int bj = 0; bj < 2; ++bj)
#pragma unroll
                    for (int n = 0; n < 2; ++n) *(pg8::f32x4*)(rowp + bj * 128 + n * 16) = acc[ai][bj][m][n]; }
    }
};
struct CtxSplitOrder {
    int c;
    __device__ __forceinline__ bool next(int i, pg8::Unit& u) const { if (i > 0 || c >= 256) return false; u.pm = (c >> 6) * 17; u.pn = (c >> 2) & 15; return true; }
    __device__ __forceinline__ void a_ready(const pg8::Unit&) const {}
    __device__ __forceinline__ void done(const pg8::Unit&) const {}
};
struct RowOrder {
    pg8::StaticOrder S; int lat;
    __device__ __forceinline__ void init(int N, int G, int c, int lat_) { lat = lat_; S.init(lat_ ? 64 * 256 : MROWS, N, G, c); }
    __device__ __forceinline__ bool next(int i, pg8::Unit& u) const { if (!S.next(i, u)) return false; if (lat) u.pm = (u.pm >> 4) * 17 + 1 + (u.pm & 15); return true; }
    __device__ __forceinline__ void a_ready(const pg8::Unit&) const {}
    __device__ __forceinline__ void done(const pg8::Unit&) const {}
};

__device__ __forceinline__ void transpose_item(const float* W, int K, int Nsrc, int nsrc0, int k0, bf16* WT, int ndst0, LAS float* scr, int lane) {
    if (nsrc0 >= 0) {
#pragma unroll 8
        for (int i = 0; i < 32; ++i) { const int kk = 2 * i + (lane >> 5); scr[kk * 33 + (lane & 31)] = W[(size_t)(k0 + kk) * Nsrc + nsrc0 + (lane & 31)]; }
    } else {
#pragma unroll 8
        for (int i = 0; i < 32; ++i) { const int kk = 2 * i + (lane >> 5); scr[kk * 33 + (lane & 31)] = 0.f; }
    }
    LDS_WAIT(); asm volatile("" ::: "memory");
    const int c = lane & 7;
#pragma unroll
    for (int j = 0; j < 4; ++j) { const int n = (lane >> 3) + 8 * j; const LAS float* s = scr + (8 * c) * 33 + n;
        v4u o; o.x = pk2(s[0 * 33], s[1 * 33]); o.y = pk2(s[2 * 33], s[3 * 33]); o.z = pk2(s[4 * 33], s[5 * 33]); o.w = pk2(s[6 * 33], s[7 * 33]);
        *(v4u*)(WT + (size_t)(ndst0 + n) * K + k0 + 8 * c) = o; }
    LDS_WAIT(); asm volatile("" ::: "memory");
}

__device__ __forceinline__ void phase_a(KP kp, int layer, LAS unsigned char* lds, int tid, int lane, int wave, int bid, int G) {
    unsigned char* ws = kp->ws;
    float* mod = (float*)(ws + WS_MOD);
    {
        LAS float* sc = (LAS float*)lds;
        LAS float* red = (LAS float*)(lds + 81920);
        const float* cin = kp->in[1]; const float* cctx = kp->in[3]; const float* wada = kp->in[5] + (size_t)layer * DM * 12288; const float* bada = kp->in[6] + (size_t)layer * 12288;
        bool have = false;
        for (int u = bid; u < 192; u += G) {
            if (!have) {
                for (int i = tid; i < 5 * DM; i += 512) { const int bi = i / DM, k = i % DM; const float v = bi < 4 ? cin[bi * DM + k] : cctx[k]; sc[i] = v / (1.0f + expf(-v)); }
                __syncthreads(); have = true;
            }
            const float* W = wada + u * 64 + lane;
            float acc0 = 0.f, acc1 = 0.f, acc2 = 0.f, acc3 = 0.f, acc4 = 0.f;
            const int k0 = wave * 512;
#pragma unroll 8
            for (int k = 0; k < 512; ++k) { const float w = W[(size_t)(k0 + k) * 12288];
                acc0 += sc[0 * DM + k0 + k] * w; acc1 += sc[1 * DM + k0 + k] * w; acc2 += sc[2 * DM + k0 + k] * w; acc3 += sc[3 * DM + k0 + k] * w; acc4 += sc[4 * DM + k0 + k] * w; }
            red[(wave * 5 + 0) * 64 + lane] = acc0; red[(wave * 5 + 1) * 64 + lane] = acc1; red[(wave * 5 + 2) * 64 + lane] = acc2; red[(wave * 5 + 3) * 64 + lane] = acc3; red[(wave * 5 + 4) * 64 + lane] = acc4;
            __syncthreads();
            if (tid < 320) { const int bi = tid / 64, cl = tid % 64; float s = 0.f;
#pragma unroll
                for (int w = 0; w < 8; ++w) s += red[(w * 5 + bi) * 64 + cl];
                mod[(size_t)(layer * 5 + bi) * 12288 + u * 64 + cl] = s + bada[u * 64 + cl]; }
            __syncthreads();
        }
        __syncthreads();
    }
    {
        LAS float* scr = (LAS float*)(lds + wave * 16384);
        const int gw = bid * 8 + wave, NGW = G * 8;
        const float* win = kp->in[7] + (size_t)layer * DM * NIN; const float* wout = kp->in[25] + (size_t)layer * DM * DM; const float* wglu = kp->in[21] + (size_t)layer * 1024 * 1024;
        bf16* WIN = (bf16*)(ws + WS_WIN); bf16* WOUT = (bf16*)(ws + WS_WOUT) + (size_t)layer * DM * DM; bf16* WGLU = (bf16*)(ws + WS_WGLU) + (size_t)layer * 1024 * 1024;
        constexpr int I_IN = 64 * (NIN / 32), I_OUT = 64 * (DM / 32), I_GLU = 16 * 32;
        for (int it = gw; it < I_IN + I_OUT + I_GLU; it += NGW) {
            int r = it;
            if (r < I_IN) { const int kb = r / (NIN / 32), nb = r % (NIN / 32), nd = nb * 32;
                if (nd < NPG) { const int ns = nd < 7168 ? nd : nd + 32; transpose_item(win, DM, NIN, ns, kb * 64, WIN, nd, scr, lane); }
                else transpose_item(win, DM, NIN, 7168, kb * 64, (bf16*)(ws + WS_WLR), 0, scr, lane);
                continue; }
            r -= I_IN;
            if (r < I_OUT) { const int kb = r / (DM / 32), nb = r % (DM / 32); transpose_item(wout, DM, DM, nb * 32, kb * 64, WOUT, nb * 32, scr, lane); continue; }
            r -= I_OUT;
            { const int kb = r / 32, nb = r % 32; transpose_item(wglu, 1024, 1024, nb * 32, kb * 64, WGLU, nb * 32, scr, lane); }
        }
    }
}

__device__ __forceinline__ void phase_b(KP kp, int layer, LAS unsigned char* lds, int lane, int wave, int bid, int G) {
    typedef short bf16x8_ __attribute__((ext_vector_type(8)));
    unsigned char* ws = kp->ws;
    const float* src_ctx = kp->in[2];
    const float* src_lat = kp->in[0];
    const float* mod = (const float*)(ws + WS_MOD) + (size_t)layer * 5 * 12288;
    const float* ng = kp->in[4] + (size_t)layer * DM;
    bf16* HN = (bf16*)(ws + WS_HN); bf16* P = (bf16*)(ws + WS_P); const bf16* WLR = (const bf16*)(ws + WS_WLR);
    LAS unsigned char* T = lds;
    LAS f32x4* red = (LAS f32x4*)(lds + 131072);
    const int q = lane >> 4, ii = lane & 15;
    for (int grp = bid; grp < MROWS / 16; grp += G) {
#pragma unroll
        for (int rr = 0; rr < 2; ++rr) {
            const int rl = 2 * wave + rr, row = grp * 16 + rl;
            const int b = row / LTOT, l = row % LTOT;
            const float* hrow = l < NCTX ? src_ctx + ((size_t)b * NCTX + l) * DM : src_lat + ((size_t)b * SEQ + (l - NCTX)) * DM;
            const float* md = mod + (size_t)(l < NCTX ? 4 : b) * 12288;
            f32x4 v[16]; float s = 0.f;
            const bool asm_ctx = (layer == 1 && G == 256 && l < NCTX);
            if (asm_ctx) { const float* crow = kp->in[2] + ((size_t)b * NCTX + l) * DM; const float* prow = (const float*)(ws + WS_CPART) + ((size_t)b * NCTX + l) * DM;
                const float* gt0 = (const float*)(ws + WS_MOD) + (size_t)4 * 12288 + 8192; const size_t qs = (size_t)NBATCH * NCTX * DM;
#pragma unroll
                for (int j = 0; j < 16; ++j) { const int col = 4 * (lane + 64 * j);
                    const f32x4 p4 = (*(const f32x4*)(prow + col) + *(const f32x4*)(prow + qs + col)) + (*(const f32x4*)(prow + 2 * qs + col) + *(const f32x4*)(prow + 3 * qs + col));
                    v[j] = *(const f32x4*)(crow + col) + *(const f32x4*)(gt0 + col) * p4; s += (v[j].x * v[j].x + v[j].y * v[j].y) + (v[j].z * v[j].z + v[j].w * v[j].w); }
            } else if (layer == 1) {
                const bf16* drow = l < NCTX ? (const bf16*)(ws + WS_HC) + ((size_t)b * NCTX + l) * DM : (const bf16*)(ws + WS_HL) + ((size_t)b * SEQ + (l - NCTX)) * DM;
#pragma unroll
                for (int j = 0; j < 16; ++j) { const int col = 4 * (lane + 64 * j); const v2u d2 = *(const v2u*)(drow + col);
                    v[j] = *(const f32x4*)(hrow + col) + (f32x4){lo_bf(d2.x), hi_bf(d2.x), lo_bf(d2.y), hi_bf(d2.y)}; s += (v[j].x * v[j].x + v[j].y * v[j].y) + (v[j].z * v[j].z + v[j].w * v[j].w); }
            } else {
#pragma unroll
                for (int j = 0; j < 16; ++j) { v[j] = *(const f32x4*)(hrow + 4 * (lane + 64 * j)); s += (v[j].x * v[j].x + v[j].y * v[j].y) + (v[j].z * v[j].z + v[j].w * v[j].w); }
            }
            s = wave_sum(s);
            const float rstd = 1.0f / sqrtf(s * (1.0f / DM) + EPSN);
#pragma unroll
            for (int j = 0; j < 16; ++j) { const int col = 4 * (lane + 64 * j);
                const f32x4 g4 = *(const f32x4*)(ng + col), sh = *(const f32x4*)(md + col), sc = *(const f32x4*)(md + DM + col);
                const f32x4 y = v[j] * rstd * g4 * (sc + 1.0f) + sh;
                v2u o; o.x = cvtpk(y.x, y.y); o.y = cvtpk(y.z, y.w);
                *(v2u*)(HN + (size_t)row * DM + col) = o;
                *(LAS v2u*)(T + rl * 8192 + ((((col >> 3) ^ rl) & 511) << 4) + ((col & 7) << 1)) = o; }
        }
        __syncthreads();
        f32x4 acc0 = (f32x4){0.f, 0.f, 0.f, 0.f}, acc1 = (f32x4){0.f, 0.f, 0.f, 0.f};
#pragma unroll 8
        for (int ks = 0; ks < 16; ++ks) { const int k0 = 512 * wave + 32 * ks + 8 * q;
            const bf16x8_ a = *(const LAS bf16x8_*)(T + ii * 8192 + ((((k0 >> 3) ^ ii) & 511) << 4));
            const bf16x8_ b0 = *(const bf16x8_*)(WLR + (size_t)ii * DM + k0), b1 = *(const bf16x8_*)(WLR + (size_t)(16 + ii) * DM + k0);
            acc0 = __builtin_amdgcn_mfma_f32_16x16x32_bf16(a, b0, acc0, 0, 0, 0); acc1 = __builtin_amdgcn_mfma_f32_16x16x32_bf16(a, b1, acc1, 0, 0, 0); }
        if (wave > 0) { red[((wave - 1) * 2 + 0) * 64 + lane] = acc0; red[((wave - 1) * 2 + 1) * 64 + lane] = acc1; }
        __syncthreads();
        if (wave == 0) {
#pragma unroll
            for (int w2 = 0; w2 < 7; ++w2) { acc0 = acc0 + red[(w2 * 2 + 0) * 64 + lane]; acc1 = acc1 + red[(w2 * 2 + 1) * 64 + lane]; }
            bf16* pr = P + (size_t)(grp * 16 + 4 * q) * NP + CB_LF + ii;
            pr[0] = (bf16)f2bf(acc0.x); pr[NP] = (bf16)f2bf(acc0.y); pr[2 * NP] = (bf16)f2bf(acc0.z); pr[3 * NP] = (bf16)f2bf(acc0.w);
            pr[16] = (bf16)f2bf(acc1.x); pr[NP + 16] = (bf16)f2bf(acc1.y); pr[2 * NP + 16] = (bf16)f2bf(acc1.z); pr[3 * NP + 16] = (bf16)f2bf(acc1.w);
        }
    }
    __syncthreads();
}

template <int MODE>
__device__ __forceinline__ void naive_lin_unit(KP kp, int layer, int b, int hd, int dir, LAS unsigned char* lds, int tid) {
    constexpr int DV = MODE == 0 ? 128 : 256, NPART = 512 / DV, ND = 128 / NPART;
    LAS float* qs = (LAS float*)lds; LAS float* ks = qs + 256; LAS float* dsv = ks + 256; LAS float* po = dsv + 256;
    const int e = tid % DV, part = tid / DV, d0 = part * ND;
    const bf16* P = (const bf16*)(kp->ws + WS_P); bf16* RAW = (bf16*)(kp->ws + WS_RAW) + (size_t)dir * MROWS * DM;
    float s[ND];
#pragma unroll
    for (int i = 0; i < ND; ++i) s[i] = 0.f;
    const int qcol = (MODE == 0 ? CA_Q : MODE == 1 ? CB_Q : CD_Q) + hd * 128;
    const int kcol = (MODE == 0 ? (dir ? CA_FB : CA_FF) : MODE == 1 ? CB_K : CD_K) + hd * 128;
    const int vcol = (MODE == 0 ? CA_I : MODE == 1 ? CB_V : CD_V) + hd * DV;
    const int ocol = (MODE == 0 ? 0 : MODE == 1 ? 1024 : 3072) + hd * DV;
    const int d = tid & 127;
    float lbv = 0.f, bias = 0.f, gam = 0.f, frq = 0.f, wg[16];
#pragma unroll
    for (int r = 0; r < 16; ++r) wg[r] = 0.f;
    if (tid < 128) {
        if (MODE == 0) { if (layer == 1) { const float* lbl = kp->in[8]; lbv = 1.0f / (1.0f + expf(-(lbl[(2 + dir) * 1024 + hd * 128 + d] - lbl[dir * 1024 + hd * 128 + d]))); } }
        if (MODE == 1) { const float* w = kp->in[10] + (size_t)(layer * 2 + dir) * 16 * 512 + hd * 128 + d;
#pragma unroll
            for (int r = 0; r < 16; ++r) wg[r] = w[r * 512];
            bias = kp->in[11][(layer * 2 + dir) * 512 + hd * 128 + d]; }
        if (MODE == 2) { gam = 1.0f / (1.0f + expf(-kp->in[23][(layer * 2 + dir) * 4 + hd])); frq = exp2f(-(float)(d & 31) * (13.287712379549449f / 32.0f)); }
    }
    for (int p = 0; p < LTOT; ++p) {
        const int l = dir ? flip_pos(p) : p; const size_t row = (size_t)b * LTOT + l; const bf16* pr = P + row * NP; const int buf = (p & 1) * 128;
        if (tid < 128) {
            float q, key, dec;
            if (MODE == 0) { q = bf2f(pr[qcol + d]); const float z = bf2f(pr[kcol + d]); const float sg = 1.0f / (1.0f + __expf(-z)), sgn = 1.0f / (1.0f + __expf(z));
                dec = fmaxf(lbv + (1.0f - lbv) * sg, 1e-6f); key = (1.0f - lbv) * sgn; }
            if (MODE == 1) { q = bf2f(pr[qcol + d]) * 0.08838834764831845f; key = bf2f(pr[kcol + d]); float x = bias;
#pragma unroll
                for (int r = 0; r < 16; ++r) x += bf2f(pr[CB_LF + dir * 16 + r]) * wg[r];
                dec = __expf(log_sigmoidf_(x) * (1.0f / 16.0f)); }
            if (MODE == 2) { const int j = d & 63; const float q1 = bf2f(pr[qcol + j]), q2 = bf2f(pr[qcol + j + 64]), k1 = bf2f(pr[kcol + j]), k2 = bf2f(pr[kcol + j + 64]);
                float cs = 1.f, sn = 0.f;
                if (l >= NCTX) { const int t = l - NCTX; const float pos = (float)((j < 32) ? (t >> 6) : (t & 63)); sincos_acc(pos * frq, sn, cs); }
                q = ((d < 64) ? (q1 * cs - q2 * sn) : (q1 * sn + q2 * cs)) * 0.08838834764831845f; key = (d < 64) ? (k1 * cs - k2 * sn) : (k1 * sn + k2 * cs); dec = gam; }
            qs[buf + d] = q; ks[buf + d] = key; dsv[buf + d] = dec;
        }
        const float v = bf2f(pr[vcol + e]);
        __syncthreads();
        float acc = 0.f;
#pragma unroll
        for (int i = 0; i < ND; ++i) { s[i] = dsv[buf + d0 + i] * s[i] + ks[buf + d0 + i] * v; acc += s[i] * qs[buf + d0 + i]; }
        po[part * 256 + e] = acc;
        __syncthreads();
        if (part == 0) { float tot = 0.f;
#pragma unroll
            for (int pp = 0; pp < NPART; ++pp) tot += po[pp * 256 + e];
            RAW[row * DM + ocol + e] = (bf16)f2bf(tot); }
    }
    __syncthreads();
}
constexpr int S5_BUS = 132, S5_XS = 136, S5_WAVE_BYTES = 16 * S5_BUS * 4 + 16 * S5_XS * 2;
__device__ __forceinline__ void s5_coef(KP kp, int ld, int g, int p, float& lbr, float& lbi, float& cr, float& ci) {
    const float lre = fminf(kp->in[13][(ld * 64 + g) * 64 + p], -1e-4f), lim = kp->in[14][(ld * 64 + g) * 64 + p];
    const float dt = expf(kp->in[15][ld * 64 + g]);
    const float xr_ = lre * dt, ang = lim * dt;
    float sn, cs, snh, csh; sincos_acc(ang, sn, cs); sincos_acc(0.5f * ang, snh, csh);
    const float mag = expf(xr_), em1 = expm1f(xr_);
    lbr = mag * cs; lbi = mag * sn;
    const float nr = em1 * cs - 2.0f * snh * snh, ni = mag * sn;
    const float den = lre * lre + lim * lim;
    cr = (nr * lre + ni * lim) / den; ci = (ni * lre - nr * lim) / den;
}
__device__ __forceinline__ void s5_unit(KP kp, int layer, int b, int g, int dir, LAS unsigned char* wlds, int lane) {
    typedef short bf16x8_ __attribute__((ext_vector_type(8)));
    typedef float f32x2s __attribute__((ext_vector_type(2)));
    const int ld = layer * 2 + dir; const int ii = lane & 15, q = lane >> 4;
    LAS float* BU = (LAS float*)wlds; LAS bf16* X = (LAS bf16*)(wlds + 16 * S5_BUS * 4);
    float lbr, lbi;
    { float cr_, ci_; s5_coef(kp, ld, g, lane, lbr, lbi, cr_, ci_); }
    bf16x8_ bA[8];
    {
        const float* bre = kp->in[16] + (size_t)(ld * 64 + g) * 64 * 16; const float* bim = kp->in[17] + (size_t)(ld * 64 + g) * 64 * 16;
#pragma unroll
        for (int mt = 0; mt < 8; ++mt) { const int p = 8 * mt + (ii >> 1); float l0, l1, cr, ci; s5_coef(kp, ld, g, p, l0, l1, cr, ci);
#pragma unroll
            for (int j = 0; j < 8; ++j) { const int h = 8 * (q & 1) + j; const float br = bre[p * 16 + h], bi = bim[p * 16 + h];
                const float v = (ii & 1) ? (cr * bi + ci * br) : (cr * br - ci * bi);
                const unsigned hv = f2bf(v); const unsigned lv = f2bf(v - __builtin_bit_cast(float, hv << 16));
                bA[mt][j] = (short)(q < 2 ? hv : lv); } }
    }
    bf16x8_ cA[4];
    {
        const float* cre = kp->in[18] + (size_t)(ld * 64 + g) * 16 * 64 + ii * 64; const float* cim = kp->in[19] + (size_t)(ld * 64 + g) * 16 * 64 + ii * 64;
#pragma unroll
        for (int ks = 0; ks < 4; ++ks)
#pragma unroll
            for (int j = 0; j < 8; ++j) { const int p = 16 * ks + 4 * q + (j >> 1); const float v = (j & 1) ? -cim[p] : cre[p]; cA[ks][j] = (short)f2bf(v); }
    }
    const bf16* P = (const bf16*)(kp->ws + WS_P); bf16* RAW = (bf16*)(kp->ws + WS_RAW) + (size_t)dir * MROWS * DM;
    float xr = 0.f, xi = 0.f;
    v4u ua, un;
#define S5_LOADA(dst, ti_) do { const int ps_ = 16 * (ti_) + ii; const int l_ = dir ? flip_pos(ps_) : ps_; dst = *(const v4u*)(P + ((size_t)b * LTOT + l_) * NP + CC_U + g * 16 + 8 * (q & 1)); } while (0)
    v4u un2;
    S5_LOADA(ua, 0); S5_LOADA(un, 1); un2 = un;
    for (int ti = 0; ti < LTOT / 16; ++ti) {
        if (ti + 2 < LTOT / 16) S5_LOADA(un2, ti + 2);
        const bf16x8_ uf = __builtin_bit_cast(bf16x8_, ua);
#pragma unroll
        for (int mt = 0; mt < 8; ++mt) { const f32x4 c4 = __builtin_amdgcn_mfma_f32_16x16x32_bf16(bA[mt], uf, ((f32x4){0.f, 0.f, 0.f, 0.f}), 0, 0, 0);
            *(LAS f32x4*)(BU + ii * S5_BUS + 16 * mt + 4 * q) = c4; }
        asm volatile("s_waitcnt lgkmcnt(0)" ::: "memory");
        f32x2s bu[16];
#pragma unroll
        for (int t = 0; t < 16; ++t) bu[t] = *(const LAS f32x2s*)(BU + t * S5_BUS + 2 * lane);
#pragma unroll
        for (int t = 0; t < 16; ++t) { const float nxr = lbr * xr - lbi * xi + bu[t].x, nxi = lbr * xi + lbi * xr + bu[t].y; xr = nxr; xi = nxi;
            *(LAS unsigned*)(X + t * S5_XS + 2 * lane) = cvtpk(xr, xi); }
        asm volatile("s_waitcnt lgkmcnt(0)" ::: "memory");
        f32x4 y = (f32x4){0.f, 0.f, 0.f, 0.f};
#pragma unroll
        for (int ks = 0; ks < 4; ++ks) { const bf16x8_ xb_ = *(const LAS bf16x8_*)(X + ii * S5_XS + 32 * ks + 8 * q); y = __builtin_amdgcn_mfma_f32_16x16x32_bf16(cA[ks], xb_, y, 0, 0, 0); }
        {
            const int ps_ = 16 * ti + ii; const int l_ = dir ? flip_pos(ps_) : ps_;
            v2u ov; ov.x = cvtpk(y.x, y.y); ov.y = cvtpk(y.z, y.w);
            *(v2u*)(RAW + ((size_t)b * LTOT + l_) * DM + 2048 + g * 16 + 4 * q) = ov;
        }
        asm volatile("s_waitcnt lgkmcnt(0)" ::: "memory");
        ua = un; un = un2;
    }
#undef S5_LOADA
}
typedef short bf16x8 __attribute__((ext_vector_type(8)));
#define MFMA16(a, b, c) __builtin_amdgcn_mfma_f32_16x16x32_bf16((a), (b), (c), 0, 0, 0)
constexpr int LA_SQ = 136, LA_SJ = 72;
constexpr int LA_QT = 0, LA_KT = LA_QT + 64 * LA_SQ * 2, LA_VR = LA_KT + 64 * LA_SQ * 2, LA_SB = LA_VR + 64 * LA_SQ * 2,
              LA_STT = LA_SB + 64 * LA_SJ * 2, LA_VEC = LA_STT + 128 * LA_SQ * 2, LA_AUX = LA_VEC + 256 * 4, LA_END = LA_AUX + 2 * 64 * 33 * 4;
static_assert(LA_END <= LDSCTL_OFF, "LA LDS map");
typedef short s16x4 __attribute__((ext_vector_type(4)));

__device__ __forceinline__ bf16x8 trfrag(const LAS bf16* base, int stride, int k0, int c0, int lane) {
    const LAS bf16* a = base + (k0 + 8 * (lane >> 4) + ((lane & 15) >> 2)) * stride + c0 + 4 * (lane & 3);
    const s16x4 lo = __builtin_amdgcn_ds_read_tr16_b64_v4i16((LAS s16x4*)a), hi = __builtin_amdgcn_ds_read_tr16_b64_v4i16((LAS s16x4*)(a + 4 * stride));
    return __builtin_shufflevector(lo, hi, 0, 1, 2, 3, 4, 5, 6, 7);
}
__device__ __forceinline__ bf16x8 ldfrag(const LAS bf16* base, int stride, int row0, int k0, int lane) {
    return *(const LAS bf16x8*)(base + (row0 + (lane & 15)) * stride + k0 + 8 * (lane >> 4));
}
template <int MODE>
__device__ __forceinline__ void la_unit(KP kp, int layer, int b, int hd, int dir, int half, LAS unsigned char* lds, int tid, int lane, int w) {
    LAS bf16* QT = (LAS bf16*)(lds + LA_QT); LAS bf16* KT = (LAS bf16*)(lds + LA_KT); LAS bf16* Vr = (LAS bf16*)(lds + LA_VR);
    LAS bf16* Sb = (LAS bf16*)(lds + LA_SB); LAS bf16* Stt = (LAS bf16*)(lds + LA_STT);
    LAS float* eref = (LAS float*)(lds + LA_VEC); LAS float* elast = eref + 128;
    LAS float* aux = (LAS float*)(lds + LA_AUX);
    const bf16* P = (const bf16*)(kp->ws + WS_P); bf16* RAW = (bf16*)(kp->ws + WS_RAW) + (size_t)dir * MROWS * DM;
    const int qcol = (MODE == 0 ? CA_Q : MODE == 1 ? CB_Q : CD_Q) + hd * 128;
    const int kcol = (MODE == 0 ? (dir ? CA_FB : CA_FF) : MODE == 1 ? CB_K : CD_K) + hd * 128;
    const int vcol = (MODE == 0 ? CA_I + hd * 128 : (MODE == 1 ? CB_V : CD_V) + hd * 256 + half * 128) + 16 * w;
    const int ocol = (MODE == 0 ? hd * 128 : (MODE == 1 ? 1024 : 3072) + hd * 256 + half * 128);
    const int c0 = 16 * w;
    const int j0 = 16 * (w & 3);
    float lg = 0.f;
    bf16x8 wA = (bf16x8){0, 0, 0, 0, 0, 0, 0, 0}; f32x4 bias4 = (f32x4){0.f, 0.f, 0.f, 0.f};
    if (MODE == 0) { const float* lbl = kp->in[8];
        if (tid < 128) { float v = 0.f; if (layer == 1) v = 1.0f / (1.0f + expf(-(lbl[(2 + dir) * 1024 + hd * 128 + tid] - lbl[dir * 1024 + hd * 128 + tid]))); aux[tid] = v; aux[128 + tid] = 1.0f - v; } }
    if (MODE == 1) { const float* wg = kp->in[10] + (size_t)(layer * 2 + dir) * 16 * 512 + hd * 128 + c0 + (lane & 15); const float* bg = kp->in[11] + (layer * 2 + dir) * 512 + hd * 128 + c0 + 4 * (lane >> 4);
        const int q_ = lane >> 4;
#pragma unroll
        for (int j = 0; j < 8; ++j) { const float wf = wg[(8 * (q_ & 1) + j) * 512]; const unsigned hi = f2bf(wf); const unsigned lo = f2bf(wf - __builtin_bit_cast(float, hi << 16)); wA[j] = (short)(q_ < 2 ? hi : lo); }
        bias4 = (f32x4){bg[0], bg[1], bg[2], bg[3]}; }
    if (MODE == 2) { lg = log_sigmoidf_(kp->in[23][(layer * 2 + dir) * 4 + hd]);
        for (int i = tid; i < 64 * 32; i += 512) { const int pos = i >> 5, jj = i & 31; float sn, cs; sincos_acc((float)pos * exp2f(-(float)jj * (13.287712379549449f / 32.0f)), sn, cs); aux[pos * 33 + jj] = cs; aux[64 * 33 + pos * 33 + jj] = sn; }
        if (tid < 128) { eref[tid] = expf(32.f * lg); elast[tid] = expf(32.f * lg); } }
    f32x4 st[8];
#pragma unroll
    for (int e = 0; e < 8; ++e) st[e] = (f32x4){0.f, 0.f, 0.f, 0.f};
    v4u pa[2], pb[2], pg[4], pv[2];
    pg[0] = pg[1] = pg[2] = pg[3] = (v4u){0u, 0u, 0u, 0u};
#define LA_PREFETCH(n) do { const int p_ = 64 * (n) + lane; const int l_ = dir ? flip_pos(p_) : p_; const bf16* pr_ = P + ((size_t)b * LTOT + l_) * NP; \
        if (MODE == 2) { const int xc_ = (w < 4 ? qcol : kcol) + j0; pa[0] = *(const v4u*)(pr_ + xc_); pa[1] = *(const v4u*)(pr_ + xc_ + 8); pb[0] = *(const v4u*)(pr_ + xc_ + 64); pb[1] = *(const v4u*)(pr_ + xc_ + 72); } \
        else { pa[0] = *(const v4u*)(pr_ + qcol + c0); pa[1] = *(const v4u*)(pr_ + qcol + c0 + 8); pb[0] = *(const v4u*)(pr_ + kcol + c0); pb[1] = *(const v4u*)(pr_ + kcol + c0 + 8); } \
        if (MODE == 1) { _Pragma("unroll") for (int nt_ = 0; nt_ < 4; ++nt_) { const int p2_ = 64 * (n) + 16 * nt_ + (lane & 15); const int l2_ = dir ? flip_pos(p2_) : p2_; \
            pg[nt_] = *(const v4u*)(P + ((size_t)b * LTOT + l2_) * NP + CB_LF + dir * 16 + 8 * ((lane >> 4) & 1)); } } \
        pv[0] = *(const v4u*)(pr_ + vcol); pv[1] = *(const v4u*)(pr_ + vcol + 8); } while (0)
    LA_PREFETCH(0);
    __syncthreads();
    const int it = w >> 1;
    for (int n = 0; n < LTOT / 64; ++n) {
        {
            float xa[16], xb[16];
            unpack8(pa[0], xa); unpack8(pa[1], xa + 8); unpack8(pb[0], xb); unpack8(pb[1], xb + 8);
            if (MODE == 2) {
                const int p_ = 64 * n + lane; const int l_ = dir ? flip_pos(p_) : p_;
                const bool lat = l_ >= NCTX; const int t_ = l_ - NCTX; const int pos = (j0 < 32) ? (t_ >> 6) : (t_ & 63);
                const float dq = (w < 4) ? __expf((float)(lane - 31) * lg) * 0.08838834764831845f : __expf((float)(31 - lane) * lg);
                float o1[16], o2[16];
#pragma unroll
                for (int c = 0; c < 16; ++c) { float cs = 1.f, sn = 0.f; if (lat) { cs = aux[pos * 33 + ((j0 + c) & 31)]; sn = aux[64 * 33 + pos * 33 + ((j0 + c) & 31)]; }
                    o1[c] = (xa[c] * cs - xb[c] * sn) * dq; o2[c] = (xa[c] * sn + xb[c] * cs) * dq; }
                LAS bf16* T = (w < 4) ? QT : KT;
                *(LAS v4u*)(T + lane * LA_SQ + j0) = pack8c(o1); *(LAS v4u*)(T + lane * LA_SQ + j0 + 8) = pack8c(o1 + 8);
                *(LAS v4u*)(T + lane * LA_SQ + 64 + j0) = pack8c(o2); *(LAS v4u*)(T + lane * LA_SQ + 64 + j0 + 8) = pack8c(o2 + 8);
            } else {
                float g[16];
                if (MODE == 0) {
#pragma unroll
                    for (int c = 0; c < 16; ++c) { const float z = xb[c]; const float e = __expf(-fabsf(z)); const float r = __builtin_amdgcn_rcpf(1.0f + e);
                        const float sp = z >= 0.f ? r : e * r, sn = z >= 0.f ? e * r : r;
                        const float lb_ = aux[c0 + c], om_ = aux[128 + c0 + c];
                        g[c] = __logf(fmaxf(lb_ + om_ * sp, 1e-6f)); xb[c] = om_ * sn; }
                } else {
                    LAS float* XL = (LAS float*)(lds + LA_STT);
#pragma unroll
                    for (int nt = 0; nt < 4; ++nt) { f32x4 x = MFMA16(wA, __builtin_bit_cast(bf16x8, pg[nt]), ((f32x4){0.f, 0.f, 0.f, 0.f})); x = x + bias4;
                        f32x4 gg; gg.x = (fminf(x.x, 0.f) - __logf(1.0f + __expf(-fabsf(x.x)))) * (1.0f / 16.0f); gg.y = (fminf(x.y, 0.f) - __logf(1.0f + __expf(-fabsf(x.y)))) * (1.0f / 16.0f);
                        gg.z = (fminf(x.z, 0.f) - __logf(1.0f + __expf(-fabsf(x.z)))) * (1.0f / 16.0f); gg.w = (fminf(x.w, 0.f) - __logf(1.0f + __expf(-fabsf(x.w)))) * (1.0f / 16.0f);
                        *(LAS f32x4*)(XL + (16 * nt + (lane & 15)) * 132 + c0 + 4 * (lane >> 4)) = gg; }
                    asm volatile("s_waitcnt lgkmcnt(0)" ::: "memory");
#pragma unroll
                    for (int c4 = 0; c4 < 4; ++c4) { const f32x4 t = *(const LAS f32x4*)(XL + lane * 132 + c0 + 4 * c4); g[4 * c4] = t.x; g[4 * c4 + 1] = t.y; g[4 * c4 + 2] = t.z; g[4 * c4 + 3] = t.w; }
#pragma unroll
                    for (int c = 0; c < 16; ++c) xa[c] *= 0.08838834764831845f;
                }
#pragma unroll
                for (int c = 0; c < 16; ++c) { const float bc = lane_scan(g[c], lane); const float br = __shfl(bc, 31), bl = __shfl(bc, 63);
                    xa[c] = xa[c] * __expf(bc - br); xb[c] = xb[c] * __expf(br - bc);
                    if (lane == 0) { eref[c0 + c] = __expf(br); elast[c0 + c] = __expf(bl - br); } }
                *(LAS v4u*)(QT + lane * LA_SQ + c0) = pack8c(xa); *(LAS v4u*)(QT + lane * LA_SQ + c0 + 8) = pack8c(xa + 8);
                *(LAS v4u*)(KT + lane * LA_SQ + c0) = pack8c(xb); *(LAS v4u*)(KT + lane * LA_SQ + c0 + 8) = pack8c(xb + 8);
            }
            *(LAS v4u*)(Vr + lane * LA_SQ + 16 * w) = pv[0]; *(LAS v4u*)(Vr + lane * LA_SQ + 16 * w + 8) = pv[1];
        }
        __syncthreads();
        bf16x8 qa[4];
        {
            const f32x4 er = *(const LAS f32x4*)(eref + 16 * w + 4 * (lane >> 4));
#pragma unroll
            for (int e = 0; e < 8; ++e) { st[e] = st[e] * er;
                v2u o; o.x = cvtpk(st[e].x, st[e].y); o.y = cvtpk(st[e].z, st[e].w);
                *(LAS v2u*)(Stt + (16 * e + (lane & 15)) * LA_SQ + 16 * w + 4 * (lane >> 4)) = o; }
#pragma unroll
            for (int ks = 0; ks < 4; ++ks) qa[ks] = ldfrag(QT, LA_SQ, 16 * it, 32 * ks, lane);
#pragma unroll
            for (int t = 0; t < 2; ++t) { const int jt = 2 * (w & 1) + t; f32x4 s = (f32x4){0.f, 0.f, 0.f, 0.f};
                if (jt <= it) {
#pragma unroll
                    for (int ks = 0; ks < 4; ++ks) s = MFMA16(ldfrag(KT, LA_SQ, 16 * jt, 32 * ks, lane), qa[ks], s); }
                const int i = 16 * it + (lane & 15), jb = 16 * jt + 4 * (lane >> 4);
                v2u o; o.x = cvtpk(jb <= i ? s.x : 0.f, jb + 1 <= i ? s.y : 0.f); o.y = cvtpk(jb + 2 <= i ? s.z : 0.f, jb + 3 <= i ? s.w : 0.f);
                *(LAS v2u*)(Sb + i * LA_SJ + jb) = o; }
        }
        __syncthreads();
        if (n + 1 < LTOT / 64) LA_PREFETCH(n + 1);
        {
            const bf16x8 sb0 = ldfrag(Sb, LA_SJ, 16 * it, 0, lane), sb1 = ldfrag(Sb, LA_SJ, 16 * it, 32, lane);
            const int p_ = 64 * n + 16 * it + (lane & 15); const int l_ = dir ? flip_pos(p_) : p_;
            bf16* orow = RAW + ((size_t)b * LTOT + l_) * DM + ocol + 4 * (lane >> 4);
#pragma unroll
            for (int t = 0; t < 4; ++t) { const int et = 4 * (w & 1) + t; f32x4 o = (f32x4){0.f, 0.f, 0.f, 0.f};
                o = MFMA16(trfrag(Vr, LA_SQ, 0, 16 * et, lane), sb0, o);
                if (it >= 2) o = MFMA16(trfrag(Vr, LA_SQ, 32, 16 * et, lane), sb1, o);
#pragma unroll
                for (int ks = 0; ks < 4; ++ks) o = MFMA16(ldfrag(Stt, LA_SQ, 16 * et, 32 * ks, lane), qa[ks], o);
                v2u ov; ov.x = cvtpk(o.x, o.y); ov.y = cvtpk(o.z, o.w);
                *(v2u*)(orow + 16 * et) = ov; }
            const bf16x8 ka0 = trfrag(KT, LA_SQ, 0, 16 * w, lane), ka1 = trfrag(KT, LA_SQ, 32, 16 * w, lane);
            const f32x4 el = *(const LAS f32x4*)(elast + 16 * w + 4 * (lane >> 4));
#pragma unroll
            for (int e = 0; e < 8; ++e) { st[e] = MFMA16(ka0, trfrag(Vr, LA_SQ, 0, 16 * e, lane), st[e]); st[e] = MFMA16(ka1, trfrag(Vr, LA_SQ, 32, 16 * e, lane), st[e]); st[e] = st[e] * el; }
        }
        __syncthreads();
    }
#undef LA_PREFETCH
}
constexpr int L2_IMG = 64 * LA_SQ * 2;
constexpr int L2_BUF = 3 * L2_IMG;
constexpr int L2_SB = 2 * L2_BUF, L2_VEC = L2_SB + 64 * LA_SJ * 2, L2_AUX = L2_VEC + 2 * 256 * 4, L2_END = L2_AUX + 4 * 64 * 20 * 4;
static_assert(L2_END <= LDSCTL_OFF && 2 * 64 * 33 * 4 <= 4 * 64 * 20 * 4, "LA2 LDS map");
constexpr float LOG2E_F = 1.4426950408889634f;
__device__ __forceinline__ float ex2(float x) { return __builtin_amdgcn_exp2f(x); }
__device__ __forceinline__ float lg2(float x) { return __builtin_amdgcn_logf(x); }
__device__ __forceinline__ float rdlane(float x, int l) { return __builtin_bit_cast(float, __builtin_amdgcn_readlane(__builtin_bit_cast(int, x), l)); }
#define L2_BAR() do { asm volatile("s_waitcnt lgkmcnt(0)" ::: "memory"); __builtin_amdgcn_s_barrier(); asm volatile("" ::: "memory"); } while (0)

template <int MODE>
__device__ __forceinline__ void la_unit2(KP kp, int layer, int b, int hd, int dir, int half, LAS unsigned char* lds, int tid, int lane, int w) {
    LAS bf16* Sb = (LAS bf16*)(lds + L2_SB);
    LAS float* vec = (LAS float*)(lds + L2_VEC);
    LAS float* aux = (LAS float*)(lds + L2_AUX);
    const bf16* P = (const bf16*)(kp->ws + WS_P); bf16* RAW = (bf16*)(kp->ws + WS_RAW) + (size_t)dir * MROWS * DM;
    const int qcol = (MODE == 0 ? CA_Q : MODE == 1 ? CB_Q : CD_Q) + hd * 128;
    const int kcol = (MODE == 0 ? (dir ? CA_FB : CA_FF) : MODE == 1 ? CB_K : CD_K) + hd * 128;
    const int vcol0 = (MODE == 0 ? CA_I + hd * 128 : (MODE == 1 ? CB_V : CD_V) + hd * 256 + half * 128);
    const int ocol = (MODE == 0 ? hd * 128 : (MODE == 1 ? 1024 : 3072) + hd * 256 + half * 128);
    const int NCH = LTOT / 64;
    float lg = 0.f;
    if (MODE == 0) { const float* lbl = kp->in[8];
        if (tid < 128) { float v = 0.f; if (layer == 1) v = 1.0f / (1.0f + expf(-(lbl[(2 + dir) * 1024 + hd * 128 + tid] - lbl[dir * 1024 + hd * 128 + tid]))); aux[tid] = v; aux[128 + tid] = 1.0f - v; } }
    if (MODE == 2) { lg = log_sigmoidf_(kp->in[23][(layer * 2 + dir) * 4 + hd]) * LOG2E_F;
        for (int i = tid; i < 64 * 32; i += 512) { const int pos = i >> 5, jj = i & 31; float sn, cs; sincos_acc((float)pos * exp2f(-(float)jj * (13.287712379549449f / 32.0f)), sn, cs); aux[pos * 33 + jj] = cs; aux[64 * 33 + pos * 33 + jj] = sn; }
        if (tid < 256) { vec[tid] = exp2f(32.f * lg); vec[256 + tid] = exp2f(32.f * lg); } }
    __syncthreads();
    if (w < 4) {
        __builtin_amdgcn_s_setprio(2);
        const int pw = w;
        const int cbase = 32 * pw;
        const int isk = pw >> 1, jb = 32 * (pw & 1);
        bf16x8 wA[2]; f32x4 bias4[2];
        wA[0] = wA[1] = (bf16x8){0, 0, 0, 0, 0, 0, 0, 0}; bias4[0] = bias4[1] = (f32x4){0.f, 0.f, 0.f, 0.f};
        if (MODE == 1) {
#pragma unroll
            for (int grp = 0; grp < 2; ++grp) { const int c0 = cbase + 16 * grp;
                const float* wg = kp->in[10] + (size_t)(layer * 2 + dir) * 16 * 512 + hd * 128 + c0 + (lane & 15); const float* bg = kp->in[11] + (layer * 2 + dir) * 512 + hd * 128 + c0 + 4 * (lane >> 4);
                const int q_ = lane >> 4;
#pragma unroll
                for (int j = 0; j < 8; ++j) { const float wf = wg[(8 * (q_ & 1) + j) * 512]; const unsigned hi = f2bf(wf); const unsigned lo = f2bf(wf - __builtin_bit_cast(float, hi << 16)); wA[grp][j] = (short)(q_ < 2 ? hi : lo); }
                bias4[grp] = (f32x4){bg[0], bg[1], bg[2], bg[3]}; }
        }
        v4u pa[4], pb[4], pv[4], pg[4], na[4], nb_[4], nv[4], ng[4];
        pg[0] = pg[1] = pg[2] = pg[3] = (v4u){0u, 0u, 0u, 0u}; ng[0] = ng[1] = ng[2] = ng[3] = (v4u){0u, 0u, 0u, 0u};
#define L2_PREFETCH(n, pa, pb, pv, pg) do { const int p_ = 64 * (n) + lane; const int l_ = dir ? flip_pos(p_) : p_; const bf16* pr_ = P + ((size_t)b * LTOT + l_) * NP; \
            const int ac_ = (MODE == 2) ? ((isk ? kcol : qcol) + jb) : (qcol + cbase); const int bc_ = (MODE == 2) ? ac_ + 64 : (kcol + cbase); \
            _Pragma("unroll") for (int k_ = 0; k_ < 4; ++k_) { pa[k_] = *(const v4u*)(pr_ + ac_ + 8 * k_); pb[k_] = *(const v4u*)(pr_ + bc_ + 8 * k_); pv[k_] = *(const v4u*)(pr_ + vcol0 + 32 * pw + 8 * k_); } \
            if (MODE == 1) { _Pragma("unroll") for (int nt_ = 0; nt_ < 4; ++nt_) { const int p2_ = 64 * (n) + 16 * nt_ + (lane & 15); const int l2_ = dir ? flip_pos(p2_) : p2_; \
                pg[nt_] = *(const v4u*)(P + ((size_t)b * LTOT + l2_) * NP + CB_LF + dir * 16 + 8 * ((lane >> 4) & 1)); } } } while (0)
#define L2_GROUP(n, bi, grp) do { \
            LAS bf16* QT_ = (LAS bf16*)(lds + (bi) * L2_BUF); LAS bf16* KT_ = QT_ + 64 * LA_SQ; LAS float* ev_ = vec + (bi) * 256; \
            float xa[16], xb[16]; unpack8(pa[2 * (grp)], xa); unpack8(pa[2 * (grp) + 1], xa + 8); unpack8(pb[2 * (grp)], xb); unpack8(pb[2 * (grp) + 1], xb + 8); \
            if (MODE == 2) { \
                const int p_ = 64 * (n) + lane; const int l_ = dir ? flip_pos(p_) : p_; const bool lat = l_ >= NCTX; const int t_ = l_ - NCTX; const int pos = (jb < 32) ? (t_ >> 6) : (t_ & 63); \
                const float dq = isk ? ex2((float)(31 - lane) * lg) : ex2((float)(lane - 31) * lg) * 0.08838834764831845f; \
                const int j0_ = jb + 16 * (grp); float o1[16], o2[16]; \
                _Pragma("unroll") for (int c = 0; c < 16; ++c) { float cs = 1.f, sn = 0.f; if (lat) { cs = aux[pos * 33 + ((j0_ + c) & 31)]; sn = aux[64 * 33 + pos * 33 + ((j0_ + c) & 31)]; } \
                    o1[c] = (xa[c] * cs - xb[c] * sn) * dq; o2[c] = (xa[c] * sn + xb[c] * cs) * dq; } \
                LAS bf16* T_ = isk ? KT_ : QT_; \
                *(LAS v4u*)(T_ + lane * LA_SQ + j0_) = pack8c(o1); *(LAS v4u*)(T_ + lane * LA_SQ + j0_ + 8) = pack8c(o1 + 8); \
                *(LAS v4u*)(T_ + lane * LA_SQ + 64 + j0_) = pack8c(o2); *(LAS v4u*)(T_ + lane * LA_SQ + 64 + j0_ + 8) = pack8c(o2 + 8); \
            } else { \
                const int c0_ = cbase + 16 * (grp); float g[16]; \
                if (MODE == 0) { \
                    _Pragma("unroll") for (int c = 0; c < 16; ++c) { const float r = __builtin_amdgcn_rcpf(1.0f + ex2(-LOG2E_F * xb[c]));        \
                        const float lb_ = aux[c0_ + c], om_ = aux[128 + c0_ + c]; \
                        g[c] = lg2(fmaxf(fmaf(om_, r, lb_), 1e-6f)); xb[c] = fmaf(-om_, r, om_); }                                          \
                } else { \
                    LAS float* XL = aux + pw * (64 * 20);                 \
                    _Pragma("unroll") for (int nt = 0; nt < 4; ++nt) { f32x4 x = MFMA16(wA[grp], __builtin_bit_cast(bf16x8, pg[nt]), ((f32x4){0.f, 0.f, 0.f, 0.f})); x = x + bias4[grp]; \
                        f32x4 gg; gg.x = (fminf(x.x, 0.f) * LOG2E_F - lg2(1.0f + ex2(-LOG2E_F * fabsf(x.x)))) * (1.0f / 16.0f); gg.y = (fminf(x.y, 0.f) * LOG2E_F - lg2(1.0f + ex2(-LOG2E_F * fabsf(x.y)))) * (1.0f / 16.0f); \
                        gg.z = (fminf(x.z, 0.f) * LOG2E_F - lg2(1.0f + ex2(-LOG2E_F * fabsf(x.z)))) * (1.0f / 16.0f); gg.w = (fminf(x.w, 0.f) * LOG2E_F - lg2(1.0f + ex2(-LOG2E_F * fabsf(x.w)))) * (1.0f / 16.0f); \
                        *(LAS f32x4*)(XL + (16 * nt + (lane & 15)) * 20 + 4 * (lane >> 4)) = gg; } \
                    asm volatile("s_waitcnt lgkmcnt(0)" ::: "memory"); \
                    _Pragma("unroll") for (int c4 = 0; c4 < 4; ++c4) { const f32x4 t = *(const LAS f32x4*)(XL + lane * 20 + 4 * c4); g[4 * c4] = t.x; g[4 * c4 + 1] = t.y; g[4 * c4 + 2] = t.z; g[4 * c4 + 3] = t.w; } \
                    asm volatile("s_waitcnt lgkmcnt(0)" ::: "memory"); \
                    _Pragma("unroll") for (int c = 0; c < 16; ++c) xa[c] *= 0.08838834764831845f; \
                } \
                float vr_ = 0.f, vl_ = 0.f;                                \
                _Pragma("unroll") for (int c = 0; c < 16; ++c) g[c] += dpp_f<0x111, 0xf>(g[c]);        \
                _Pragma("unroll") for (int c = 0; c < 16; ++c) g[c] += dpp_f<0x112, 0xf>(g[c]); \
                _Pragma("unroll") for (int c = 0; c < 16; ++c) g[c] += dpp_f<0x114, 0xf>(g[c]); \
                _Pragma("unroll") for (int c = 0; c < 16; ++c) g[c] += dpp_f<0x118, 0xf>(g[c]); \
                _Pragma("unroll") for (int c = 0; c < 16; ++c) g[c] += dpp_f<0x142, 0xa>(g[c]); \
                _Pragma("unroll") for (int c = 0; c < 16; ++c) g[c] += dpp_f<0x143, 0xc>(g[c]); \
                _Pragma("unroll") for (int c = 0; c < 16; ++c) { const float bc = g[c]; const float br = rdlane(bc, 31), bl = rdlane(bc, 63); \
                    xa[c] = xa[c] * ex2(bc - br); xb[c] = xb[c] * ex2(br - bc); vr_ = (lane == c) ? br : vr_; vl_ = (lane == c) ? (bl - br) : vl_; } \
                if (lane < 16) { ev_[c0_ + lane] = ex2(vr_); ev_[128 + c0_ + lane] = ex2(vl_); } \
                *(LAS v4u*)(QT_ + lane * LA_SQ + c0_) = pack8c(xa); *(LAS v4u*)(QT_ + lane * LA_SQ + c0_ + 8) = pack8c(xa + 8); \
                *(LAS v4u*)(KT_ + lane * LA_SQ + c0_) = pack8c(xb); *(LAS v4u*)(KT_ + lane * LA_SQ + c0_ + 8) = pack8c(xb + 8); \
            } } while (0)
#define L2_VALUES(bi) do { LAS bf16* VR_ = (LAS bf16*)(lds + (bi) * L2_BUF) + 2 * 64 * LA_SQ; \
            _Pragma("unroll") for (int k_ = 0; k_ < 4; ++k_) *(LAS v4u*)(VR_ + lane * LA_SQ + 32 * pw + 8 * k_) = pv[k_]; } while (0)
        L2_PREFETCH(0, pa, pb, pv, pg);
        L2_PREFETCH(1, na, nb_, nv, ng);
        L2_GROUP(0, 0, 0); L2_GROUP(0, 0, 1); L2_VALUES(0);
#define L2_ROTATE() do { _Pragma("unroll") for (int k_ = 0; k_ < 4; ++k_) { pa[k_] = na[k_]; pb[k_] = nb_[k_]; pv[k_] = nv[k_]; pg[k_] = ng[k_]; } } while (0)
        L2_ROTATE();
        L2_PREFETCH(2, na, nb_, nv, ng);
        L2_BAR();
        for (int n = 0; n < NCH; ++n) {
            const int nb = (n + 1) & 1;
            if (n + 1 < NCH) { L2_GROUP(n + 1, nb, 0); }
            L2_BAR();
            if (n + 1 < NCH) { L2_GROUP(n + 1, nb, 1); L2_VALUES(nb); }
            L2_ROTATE();
            if (n + 3 < NCH) L2_PREFETCH(n + 3, na, nb_, nv, ng);
            L2_BAR();
        }
#undef L2_ROTATE
#undef L2_PREFETCH
#undef L2_GROUP
#undef L2_VALUES
        __builtin_amdgcn_s_setprio(0);
    } else {
        const int cw = w - 4; const int q = lane >> 4, ii = lane & 15;
        f32x4 st[2][8];
#pragma unroll
        for (int et = 0; et < 2; ++et)
#pragma unroll
            for (int dt = 0; dt < 8; ++dt) st[et][dt] = (f32x4){0.f, 0.f, 0.f, 0.f};
        v2u ovb[8]; bf16* oaddr[4];
#pragma unroll
        for (int t = 0; t < 8; ++t) ovb[t] = (v2u){0u, 0u};
#pragma unroll
        for (int t = 0; t < 4; ++t) oaddr[t] = RAW;
        L2_BAR();
        for (int n = 0; n < NCH; ++n) {
            const int bi = n & 1;
            const LAS bf16* QT = (const LAS bf16*)(lds + bi * L2_BUF); const LAS bf16* KT = QT + 64 * LA_SQ; const LAS bf16* Vr = KT + 64 * LA_SQ; const LAS float* ev = vec + bi * 256;
            {
                bf16x8 qa[4];
#pragma unroll
                for (int ks = 0; ks < 4; ++ks) qa[ks] = ldfrag(QT, LA_SQ, 16 * cw, 32 * ks, lane);
#pragma unroll
                for (int jt = 0; jt < 4; ++jt) { f32x4 s = (f32x4){0.f, 0.f, 0.f, 0.f};
                    if (jt <= cw) {
#pragma unroll
                        for (int ks = 0; ks < 4; ++ks) s = MFMA16(ldfrag(KT, LA_SQ, 16 * jt, 32 * ks, lane), qa[ks], s); }
                    const int i = 16 * cw + ii, jbb = 16 * jt + 4 * q;
                    v2u o; o.x = cvtpk(jbb <= i ? s.x : 0.f, jbb + 1 <= i ? s.y : 0.f); o.y = cvtpk(jbb + 2 <= i ? s.z : 0.f, jbb + 3 <= i ? s.w : 0.f);
                    *(LAS v2u*)(Sb + i * LA_SJ + jbb) = o; }
            }
            f32x4 o[2][4];
#pragma unroll
            for (int et = 0; et < 2; ++et)
#pragma unroll
                for (int t = 0; t < 4; ++t) o[et][t] = (f32x4){0.f, 0.f, 0.f, 0.f};
#pragma unroll
            for (int ks = 0; ks < 4; ++ks) {
                const f32x4 e0 = *(const LAS f32x4*)(ev + 32 * ks + 4 * q), e1 = *(const LAS f32x4*)(ev + 32 * ks + 16 + 4 * q);
                bf16x8 sa[2];
#pragma unroll
                for (int et = 0; et < 2; ++et) { st[et][2 * ks] = st[et][2 * ks] * e0; st[et][2 * ks + 1] = st[et][2 * ks + 1] * e1;
                    v4u pk_; pk_.x = cvtpk(st[et][2 * ks].x, st[et][2 * ks].y); pk_.y = cvtpk(st[et][2 * ks].z, st[et][2 * ks].w); pk_.z = cvtpk(st[et][2 * ks + 1].x, st[et][2 * ks + 1].y); pk_.w = cvtpk(st[et][2 * ks + 1].z, st[et][2 * ks + 1].w);
                    sa[et] = __builtin_bit_cast(bf16x8, pk_); }
#pragma unroll
                for (int t = 0; t < 4; ++t) { const LAS bf16* qp = QT + (16 * t + ii) * LA_SQ + 32 * ks + 4 * q;
                    const v2u lo = *(const LAS v2u*)qp, hi = *(const LAS v2u*)(qp + 16);
                    v4u bq; bq.x = lo.x; bq.y = lo.y; bq.z = hi.x; bq.w = hi.y;
                    const bf16x8 qb = __builtin_bit_cast(bf16x8, bq);
                    o[0][t] = MFMA16(sa[0], qb, o[0][t]); o[1][t] = MFMA16(sa[1], qb, o[1][t]); }
            }
            L2_BAR();
            bf16x8 va[2][2];
#pragma unroll
            for (int et = 0; et < 2; ++et)
#pragma unroll
                for (int ks = 0; ks < 2; ++ks) va[et][ks] = trfrag(Vr, LA_SQ, 32 * ks, 16 * (2 * cw + et), lane);
#pragma unroll
            for (int t = 0; t < 4; ++t) {
                const bf16x8 s0 = ldfrag(Sb, LA_SJ, 16 * t, 0, lane);
                o[0][t] = MFMA16(va[0][0], s0, o[0][t]); o[1][t] = MFMA16(va[1][0], s0, o[1][t]);
                if (t >= 2) { const bf16x8 s1 = ldfrag(Sb, LA_SJ, 16 * t, 32, lane); o[0][t] = MFMA16(va[0][1], s1, o[0][t]); o[1][t] = MFMA16(va[1][1], s1, o[1][t]); }
            }
#pragma unroll
            for (int t = 0; t < 4; ++t) { asm volatile("" :: "v"(ovb[2 * t]), "v"(ovb[2 * t + 1]), "v"(oaddr[t])); }
#pragma unroll
            for (int t = 0; t < 4; ++t) {
                const int p_ = 64 * n + 16 * t + ii; const int l_ = dir ? flip_pos(p_) : p_;
                oaddr[t] = RAW + ((size_t)b * LTOT + l_) * DM + ocol + 32 * cw + 4 * q;
                ovb[2 * t].x = cvtpk(o[0][t].x, o[0][t].y); ovb[2 * t].y = cvtpk(o[0][t].z, o[0][t].w);
                ovb[2 * t + 1].x = cvtpk(o[1][t].x, o[1][t].y); ovb[2 * t + 1].y = cvtpk(o[1][t].z, o[1][t].w);
                *(v2u*)oaddr[t] = ovb[2 * t]; *(v2u*)(oaddr[t] + 16) = ovb[2 * t + 1];
            }
#pragma unroll
            for (int dt = 0; dt < 8; ++dt) {
                const bf16x8 k0 = trfrag(KT, LA_SQ, 0, 16 * dt, lane), k1 = trfrag(KT, LA_SQ, 32, 16 * dt, lane);
                const f32x4 el = *(const LAS f32x4*)(ev + 128 + 16 * dt + 4 * q);
#pragma unroll
                for (int et = 0; et < 2; ++et) { st[et][dt] = MFMA16(k0, va[et][0], st[et][dt]); st[et][dt] = MFMA16(k1, va[et][1], st[et][dt]); st[et][dt] = st[et][dt] * el; }
            }
            L2_BAR();
        }
    }
    __syncthreads();
}

#define LA_TIDS() int t2 = threadIdx.x; asm volatile("" : "+v"(t2)); const int ln2 = t2 & 63, wv2 = __builtin_amdgcn_readfirstlane(t2 >> 6)
__device__ __forceinline__ void phase_d(int layer, LAS unsigned char* lds, int bid, int G) {
    for (int u0 = bid; u0 < 256; u0 += G) {
        int u = u0; asm volatile("" : "+s"(u));
        if (u < 64) { LA_TIDS(); la_unit2<0>(KARGS(), layer, u >> 4, (u >> 1) & 7, u & 1, 0, lds, t2, ln2, wv2); }
        else if (u < 128) { LA_TIDS(); const int v = u - 64; la_unit2<1>(KARGS(), layer, v >> 4, (v >> 2) & 3, (v >> 1) & 1, v & 1, lds, t2, ln2, wv2); }
        else if (u < 192) { LA_TIDS(); const int v = u - 128; la_unit2<2>(KARGS(), layer, v >> 4, (v >> 2) & 3, (v >> 1) & 1, v & 1, lds, t2, ln2, wv2); }
        else { LA_TIDS(); const int wu = (u - 192) * 8 + wv2; s5_unit(KARGS(), layer, wu >> 7, (wu >> 1) & 63, wu & 1, lds + wv2 * S5_WAVE_BYTES, ln2); }
    }
}

__device__ __forceinline__ float row16_sum(float x) {
    x += dpp_f<0xB1, 0xf>(x); x += dpp_f<0x4E, 0xf>(x); x += dpp_f<0x141, 0xf>(x); x += dpp_f<0x140, 0xf>(x); return x;
}
__device__ __forceinline__ float row32_sum(float x) { x = row16_sum(x); return x + __shfl_xor(x, 16); }
__device__ __forceinline__ void phase_e(KP kp, int layer, int lane, int wave, int bid, int G) {
    unsigned char* ws = kp->ws;
    const bf16* P = (const bf16*)(ws + WS_P); const bf16* RF = (const bf16*)(ws + WS_RAW); const bf16* RB = RF + (size_t)MROWS * DM;
    bf16* O = (bf16*)(ws + WS_O); bf16* Z = (bf16*)(ws + WS_Z);
    float ga[8], gb[8], gd[8], sd0[8], sd1[8];
    {
        const float* pa_ = kp->in[9] + layer * 128 + 8 * (lane & 15); const float* pb_ = kp->in[12] + layer * 256 + 8 * (lane & 31); const float* pd_ = kp->in[24] + layer * 256 + 8 * (lane & 31);
        const float* ps_ = kp->in[20] + layer * 1024 + 8 * lane;
#pragma unroll
        for (int e = 0; e < 8; ++e) { ga[e] = pa_[e]; gb[e] = pb_[e]; gd[e] = pd_[e]; sd0[e] = ps_[e]; sd1[e] = ps_[512 + e]; }
    }
    const int gw = bid * 8 + wave, NGW = G * 8;
    for (int row = gw; row < MROWS; row += NGW) {
        if (layer == 1 && (row % LTOT) < NCTX) continue;
        const bf16* pr = P + (size_t)row * NP + 8 * lane; const bf16* rf = RF + (size_t)row * DM + 8 * lane; const bf16* rb = RB + (size_t)row * DM + 8 * lane;
        bf16* orow = O + (size_t)row * DM + 8 * lane; bf16* zrow = Z + (size_t)row * 1024 + 8 * lane;
        v4u f_[8], b_[8], g_[8];
#pragma unroll
        for (int pt = 0; pt < 4; ++pt)
#pragma unroll
            for (int h = 0; h < 2; ++h) { f_[2 * pt + h] = *(const v4u*)(rf + 1024 * pt + 512 * h); b_[2 * pt + h] = *(const v4u*)(rb + 1024 * pt + 512 * h); }
#pragma unroll
        for (int h = 0; h < 2; ++h) { g_[h] = *(const v4u*)(pr + CA_G + 512 * h); g_[2 + h] = *(const v4u*)(pr + CB_G + 512 * h); g_[4 + h] = *(const v4u*)(pr + CC_U + 512 * h); g_[6 + h] = *(const v4u*)(pr + CD_G + 512 * h); }
#pragma unroll
        for (int h = 0; h < 2; ++h) {
            float x[8], y[8], gt[8];
            unpack8(f_[h], x); unpack8(b_[h], y); unpack8(g_[h], gt);
            float s = 0.f;
#pragma unroll
            for (int e = 0; e < 8; ++e) { x[e] += y[e]; s += x[e] * x[e]; }
            float r = 1.0f / sqrtf(row16_sum(s) * (1.0f / 128.0f) + EPSN);
#pragma unroll
            for (int e = 0; e < 8; ++e) x[e] = x[e] * r * ga[e] * siluf_(gt[e]);
            *(v4u*)(orow + 512 * h) = pack8c(x);
            unpack8(f_[2 + h], x); unpack8(b_[2 + h], y); unpack8(g_[2 + h], gt);
            s = 0.f;
#pragma unroll
            for (int e = 0; e < 8; ++e) { x[e] += y[e]; s += x[e] * x[e]; }
            r = 1.0f / sqrtf(row32_sum(s) * (1.0f / 256.0f) + EPSN);
#pragma unroll
            for (int e = 0; e < 8; ++e) x[e] = x[e] * r * gb[e] * siluf_(gt[e]);
            *(v4u*)(orow + 1024 + 512 * h) = pack8c(x);
            unpack8(f_[6 + h], x); unpack8(b_[6 + h], y); unpack8(g_[6 + h], gt);
            s = 0.f;
#pragma unroll
            for (int e = 0; e < 8; ++e) { x[e] += y[e]; s += x[e]; }
            const float mu = row32_sum(s) * (1.0f / 256.0f);
            s = 0.f;
#pragma unroll
            for (int e = 0; e < 8; ++e) { x[e] -= mu; s += x[e] * x[e]; }
            r = 1.0f / sqrtf(row32_sum(s) * (1.0f / 256.0f) + EPSN);
#pragma unroll
            for (int e = 0; e < 8; ++e) x[e] = x[e] * r * gd[e] * siluf_(gt[e]);
            *(v4u*)(orow + 3072 + 512 * h) = pack8c(x);
            unpack8(f_[4 + h], x); unpack8(b_[4 + h], y); unpack8(g_[4 + h], gt);
#pragma unroll
            for (int e = 0; e < 8; ++e) x[e] = gelu_tanhf_(x[e] + y[e] + (h ? sd1[e] : sd0[e]) * gt[e]);
            *(v4u*)(zrow + 512 * h) = pack8c(x);
        }
    }
}

__device__ __forceinline__ void phase_h(KP kp, int lane, int wave, int bid, int G) {
    const float* fg = kp->in[26]; float* out = kp->out; const float* x = kp->in[0];
    const bf16* D0 = (const bf16*)(kp->ws + WS_HL); const bf16* D1 = D0 + (size_t)NBATCH * SEQ * DM;
    const int gw = bid * 8 + wave, NGW = G * 8;
    for (int row = gw; row < NBATCH * SEQ; row += NGW) {
        const float* xrow = x + (size_t)row * DM; const bf16* d0 = D0 + (size_t)row * DM; const bf16* d1 = D1 + (size_t)row * DM; float* orow = out + (size_t)row * DM;
        f32x4 v[16]; float s = 0.f;
#pragma unroll
        for (int j = 0; j < 16; ++j) { const int col = 4 * (lane + 64 * j); const v2u a2 = *(const v2u*)(d0 + col), b2 = *(const v2u*)(d1 + col);
            v[j] = *(const f32x4*)(xrow + col) + ((f32x4){lo_bf(a2.x), hi_bf(a2.x), lo_bf(a2.y), hi_bf(a2.y)} + (f32x4){lo_bf(b2.x), hi_bf(b2.x), lo_bf(b2.y), hi_bf(b2.y)});
            s += (v[j].x * v[j].x + v[j].y * v[j].y) + (v[j].z * v[j].z + v[j].w * v[j].w); }
        s = wave_sum(s);
        const float rstd = 1.0f / sqrtf(s * (1.0f / DM) + EPSN);
#pragma unroll
        for (int j = 0; j < 16; ++j) { const int col = 4 * (lane + 64 * j); const f32x4 g4 = *(const f32x4*)(fg + col); *(f32x4*)(orow + col) = v[j] * rstd * g4; }
    }
}

constexpr int N_PHASES = 15;
__global__ void __launch_bounds__(512, 2) fwd(Args a) {
    extern __shared__ __attribute__((aligned(16))) unsigned char lds_raw[];
    LAS unsigned char* lds = (LAS unsigned char*)lds_raw;
    const int bid = blockIdx.x, G = gridDim.x;
#define TIDS() int tid = threadIdx.x; asm volatile("" : "+v"(tid)); const int lane = tid & 63, wave = __builtin_amdgcn_readfirstlane(tid >> 6); (void)lane; (void)wave
    volatile LAS unsigned* MISC = (volatile LAS unsigned*)(lds + MISC_OFF);
    for (int u = threadIdx.x; u < (LDS_BYTES - LDSCTL_OFF) / 4; u += 512) ((LAS unsigned*)(lds + LDSCTL_OFF))[u] = 0u;
    __syncthreads();
    unsigned* ctl = (unsigned*)(a.ws + WS_CTL);
    const int lo = a.ph_lo, hi = a.ph_hi;
    XcdBarrier bar; bar.bar = ctl + CW_BAR; bar.x = 0; bar.st = nullptr;
    if (hi - lo > 1) bar = xcd_barrier_post(ctl + CW_BAR, MISC + 8);
#define IN(k) (lo <= (k) && (k) < hi)
#define SEAM(k) do { if (IN(k) && IN((k) + 1)) xcd_barrier(bar); } while (0)
    for (int layer = 0; layer < 2; ++layer) {
        const int pb = layer * 7;
        if (IN(pb + 0)) { TIDS(); phase_a(KARGS(), layer, lds, tid, lane, wave, bid, G); }
        SEAM(pb + 0);
        if (IN(pb + 1)) { TIDS(); phase_b(KARGS(), layer, lds, lane, wave, bid, G); }
        SEAM(pb + 1);
        if (IN(pb + 2)) { KP kp = KARGS(); unsigned char* ws = kp->ws;
            pg8::Gemm g{(const bf16*)(ws + WS_HN), (const bf16*)(ws + WS_WIN), DM, NPG, DM};
            RowOrder S; S.init(NPG, G, bid, 0);
            EpiStoreBf16 E{(bf16*)(ws + WS_P), NP};
            pg8::gemm_phase<EpiStoreBf16, RowOrder, true, true>(lds, g, S, E);
        }
        SEAM(pb + 2);
        if (IN(pb + 3)) { phase_d(layer, lds, bid, G); }
        SEAM(pb + 3);
        if (IN(pb + 4)) { TIDS(); phase_e(KARGS(), layer, lane, wave, bid, G); }
        SEAM(pb + 4);
        if (IN(pb + 5)) { KP kp = KARGS(); unsigned char* ws = kp->ws;
            pg8::Gemm g{(const bf16*)(ws + WS_Z), (const bf16*)(ws + WS_WGLU) + (size_t)layer * 1024 * 1024, 1024, 1024, 1024};
            RowOrder S; S.init(1024, G, bid, layer == 1 ? 1 : 0);
            EpiGlu E{(const bf16*)(ws + WS_Z), (const bf16*)(ws + WS_P), (bf16*)(ws + WS_O), kp->in[22] + layer * 1024};
            pg8::gemm_phase<EpiGlu, RowOrder, true, true>(lds, g, S, E);
        }
        SEAM(pb + 5);
        if (IN(pb + 6)) { KP kp = KARGS(); unsigned char* ws = kp->ws;
            pg8::Gemm g{(const bf16*)(ws + WS_O), (const bf16*)(ws + WS_WOUT) + (size_t)layer * DM * DM, DM, DM, DM};
            const bool split = (layer == 0 && G == 256);
            RowOrder S; S.init(DM, G, bid, (layer == 1 || split) ? 1 : 0);
            EpiDelta E{(bf16*)(ws + WS_HL) + (size_t)layer * NBATCH * SEQ * DM, (bf16*)(ws + WS_HC), (const float*)(ws + WS_MOD) + (size_t)layer * 5 * 12288};
            pg8::gemm_phase<EpiDelta, RowOrder, true, true>(lds, g, S, E);
            if (split) {
                const int kq = bid & 3;
                pg8::Gemm g2{(const bf16*)(ws + WS_O) + kq * 1024, (const bf16*)(ws + WS_WOUT) + kq * 1024, DM, DM, 1024};
                CtxSplitOrder S2{bid};
                EpiCtxPart E2{(float*)(ws + WS_CPART) + (size_t)kq * NBATCH * NCTX * DM};
                pg8::gemm_phase<EpiCtxPart, CtxSplitOrder, false, true>(lds, g2, S2, E2);
            }
        }
        SEAM(pb + 6);
    }
    if (IN(14)) { TIDS(); phase_h(KARGS(), lane, wave, bid, G); }
#undef IN
#undef SEAM
#undef TIDS
}

extern "C" void kernel_launch(void* const* d_in, const int* in_sizes, int n_in, void* d_out, int out_size, void* d_ws, size_t ws_size, hipStream_t stream) {
    static int grid = 0;
    if (grid == 0) {
        if (n_in != 27 || out_size != NBATCH * SEQ * DM || ws_size < WS_END) { fprintf(stderr, "kernel_launch: unexpected problem (n_in %d out %d ws %zu need %zu); nothing launched\n", n_in, out_size, ws_size, (size_t)WS_END); grid = -1; return; }
        int dev = 0, cus = 0;
        if (hipGetDevice(&dev) != hipSuccess || hipDeviceGetAttribute(&cus, hipDeviceAttributeMultiprocessorCount, dev) != hipSuccess) { grid = -1; return; }
        if (hipFuncSetAttribute((const void*)fwd, hipFuncAttributeMaxDynamicSharedMemorySize, LDS_BYTES) != hipSuccess) { fprintf(stderr, "kernel_launch: hipFuncSetAttribute failed\n"); grid = -1; return; }
        (void)hipGetLastError();
        grid = cus;
    }
    if (grid < 0) return;
    (void)hipMemsetAsync((char*)d_ws + WS_CTL, 0, CTL_BYTES, stream);
    Args a{};
    for (int i = 0; i < 27; ++i) a.in[i] = (const float*)d_in[i];
    a.out = (float*)d_out; a.ws = (unsigned char*)d_ws;
#ifndef ONE_LAUNCH
    for (int ph = 0; ph < N_PHASES; ++ph) { a.ph_lo = ph; a.ph_hi = ph + 1; hipLaunchKernelGGL(fwd, dim3(grid), dim3(512), LDS_BYTES, stream, a); }
#else
    a.ph_lo = 0; a.ph_hi = N_PHASES; hipLaunchKernelGGL(fwd, dim3(grid), dim3(512), LDS_BYTES, stream, a);
#endif
}
```

```cpp
#include <hip/hip_runtime.h>
#include <cstdio>
#include <cstdint>
#define ONE_LAUNCH 1
namespace pg8 {
#define PG8_LAS __attribute__((address_space(3)))
typedef unsigned short bf16_t;
typedef short bf16x8 __attribute__((ext_vector_type(8)));
typedef float f32x4 __attribute__((ext_vector_type(4)));
typedef unsigned u32x4 __attribute__((ext_vector_type(4)));
constexpr int BM = 256, BK = 64, HALF = 128, HTB = HALF * BK * 2  , STAGE_BYTES = 8 * HTB, NXCD = 8, WGM = 8;

__host__ __device__ __forceinline__ int lds_byte(int r, int c) { const int st = (r >> 4) * 2 + (c >> 5), rr = r & 15, cc = c & 31, ob = rr * 64 + cc * 2; return st * 1024 + (ob ^ (((ob >> 9) & 1) << 5)); }
__host__ __device__ __forceinline__ void stage_rc(int b, int& R, int& C) { const int st = b / 1024, sb = b % 1024, swz = sb ^ (((sb >> 9) & 1) << 5); R = (st >> 1) * 16 + swz / 64; C = (st & 1) * 32 + (swz % 64) / 2; }
__host__ __device__ __forceinline__ int perm32(int rho) { const int n = rho >> 4, i = rho & 15; return 8 * (i >> 2) + 4 * n + (i & 3); }

struct Unit { int pm, pn; };
struct Gemm { const bf16_t* A; const bf16_t* Bt; int ld, N, K; };

struct StaticOrder {
    int nM, nN, nwg, G, c;
    __host__ __device__ void init(int M, int N, int G_, int c_) { nM = M / BM; nN = N / BM; nwg = nM * nN; G = G_; c = c_; }
    __host__ __device__ bool next(int i, Unit& u) const {
        const long L = (long)i * G + c; if (L >= nwg) return false;
        int wgid = (int)L; { const int q = nwg / NXCD, r = nwg % NXCD, xcd = wgid % NXCD, off = wgid / NXCD; wgid = (xcd < r ? xcd * (q + 1) : r * (q + 1) + (xcd - r) * q) + off; }
        const int nig = WGM * nN, gid = wgid / nig, fm = gid * WGM, gsz = (nM - fm) < WGM ? (nM - fm) : WGM;
        u.pm = fm + ((wgid % nig) % gsz); u.pn = (wgid % nig) / gsz; return true;
    }
    __device__ __forceinline__ void a_ready(const Unit&) const {}
    __device__ __forceinline__ void done(const Unit&) const {}
};

__device__ __forceinline__ unsigned cvt_pk_bf16(float lo, float hi) { unsigned r; asm volatile("v_cvt_pk_bf16_f32 %0, %1, %2" : "=v"(r) : "v"(lo), "v"(hi)); return r; }
typedef float f32x2 __attribute__((ext_vector_type(2)));
__device__ __forceinline__ f32x2 gelu_pk(f32x2 v) {
    const f32x2 av = __builtin_elementwise_abs(v), d = av * 0.2316418882f + 1.0f;
    f32x2 t; t.x = __builtin_amdgcn_rcpf(d.x); t.y = __builtin_amdgcn_rcpf(d.y);
    f32x2 q = t * 0.5307027145f + (-0.7265760135f); q = q * t + 0.7107068705f; q = q * t + (-0.142248368f); q = q * t + 0.127414796f; q = q * t;
    const f32x2 s = (v * v) * (-0.72134752044f);
    f32x2 e; e.x = __builtin_amdgcn_exp2f(s.x); e.y = __builtin_amdgcn_exp2f(s.y);
    const f32x2 m = v * (q * e), r = v - m;
    f32x2 o; o.x = v.x < 0.f ? m.x : r.x; o.y = v.y < 0.f ? m.y : r.y; return o;
}

template <class Epi, class Sched, bool ALIGN_EPI = false, bool SP2 = false>
__device__ __forceinline__ void gemm_phase(PG8_LAS unsigned char* lds, const Gemm g, const Sched& S, const Epi& E) {
    int tid_l = threadIdx.x; asm volatile("" : "+v"(tid_l));
    const int tid = tid_l, wid = __builtin_amdgcn_readfirstlane(tid >> 6), lane = tid & 63, wr = wid >> 2, wc = wid & 3, fr = lane & 15, fq = lane >> 4;
    const int K = g.K, LD = g.ld, nt = K / BK;
    unsigned voffA[2], voffB[2];
#pragma unroll
    for (int i = 0; i < 2; ++i) { int R, C; stage_rc(tid * 16 + i * 8192, R, C); const int Rb = Epi::PERM ? ((R & ~31) + perm32(R & 31)) : R;
        voffA[i] = (unsigned)(R * LD + C) * 2u; voffB[i] = (unsigned)(Rb * LD + C) * 2u; }
    const size_t kstep = (size_t)(BK * 2);
    const size_t hstep = (size_t)HALF * LD * 2;
    const size_t tstep = 2 * hstep;
    const unsigned ldsw = (unsigned)wid * 1024u;
    const int aoff = lds_byte(wr * 64 + fr, fq * 8), boff = lds_byte(wc * 32 + fr, fq * 8);
#define PG8_SA(b, h) (((b) * 2 + (h)) * HTB)
#define PG8_SB(b, h) ((4 + (b) * 2 + (h)) * HTB)
#define PG8_STAGE(bufoff, gbase, voff) do { _Pragma("unroll") for (int _i = 0; _i < 2; ++_i) \
        __builtin_amdgcn_global_load_lds((const unsigned*)((const char*)(gbase) + (voff)[_i]), (PG8_LAS unsigned*)(lds + (bufoff) + ldsw + _i * 8192), 16, 0, 0); } while (0)
#define PG8_LDA(dst, b, h) do { _Pragma("unroll") for (int m = 0; m < 4; ++m) _Pragma("unroll") for (int k = 0; k < 2; ++k) dst[m][k] = *(const PG8_LAS bf16x8*)(lds + PG8_SA(b, h) + aoff + m * 2048 + k * 1024); } while (0)
#define PG8_LDB(dst, b, h) do { _Pragma("unroll") for (int n = 0; n < 2; ++n) _Pragma("unroll") for (int k = 0; k < 2; ++k) dst[n][k] = *(const PG8_LAS bf16x8*)(lds + PG8_SB(b, h) + boff + n * 2048 + k * 1024); } while (0)
#define PG8_MMA(ai, bj, At, Bt) do { __builtin_amdgcn_s_setprio(1); _Pragma("unroll") for (int m = 0; m < 4; ++m) _Pragma("unroll") for (int n = 0; n < 2; ++n) _Pragma("unroll") for (int k = 0; k < 2; ++k) \
        acc[ai][bj][m][n] = __builtin_amdgcn_mfma_f32_16x16x32_bf16(Bt[n][k], At[m][k], acc[ai][bj][m][n], 0, 0, 0); __builtin_amdgcn_s_setprio(0); } while (0)
#define PG8_WAIT_V(n) asm volatile("s_waitcnt vmcnt(" #n ")" ::: "memory")
#define PG8_WAIT_L(n) asm volatile("s_waitcnt lgkmcnt(" #n ")" ::: "memory")
#define PG8_BAR __builtin_amdgcn_s_barrier()
#define PG8_SCHED __builtin_amdgcn_sched_barrier(0)
    Unit cur, nxt; int ui = 0;
    if (!S.next(0, cur)) return;
    f32x4 acc[2][2][4][2];
#pragma unroll
    for (int a = 0; a < 2; ++a)
#pragma unroll
        for (int b = 0; b < 2; ++b)
#pragma unroll
            for (int m = 0; m < 4; ++m)
#pragma unroll
                for (int n = 0; n < 2; ++n) acc[a][b][m][n] = (f32x4){0.f, 0.f, 0.f, 0.f};
    bf16x8 At[4][2], B0[2][2], B1[2][2];
    const char* cA = (const char*)g.A + (size_t)cur.pm * tstep; const char* cB = (const char*)g.Bt + (size_t)cur.pn * tstep;
    S.a_ready(cur);
    if constexpr (SP2) {
        PG8_STAGE(PG8_SB(0, 0), cB, voffB); PG8_STAGE(PG8_SB(0, 1), cB + hstep, voffB); PG8_STAGE(PG8_SA(0, 0), cA, voffA); PG8_STAGE(PG8_SA(0, 1), cA + hstep, voffA);
        if (wr == 1) PG8_BAR;
        PG8_WAIT_V(2); PG8_BAR;
        PG8_STAGE(PG8_SB(1, 0), cB + kstep, voffB); PG8_STAGE(PG8_SA(1, 0), cA + kstep, voffA); PG8_STAGE(PG8_SB(1, 1), cB + hstep + kstep, voffB);
        PG8_WAIT_V(6); PG8_BAR;
    } else {
        PG8_STAGE(PG8_SB(0, 0), cB, voffB); PG8_STAGE(PG8_SA(0, 0), cA, voffA); PG8_STAGE(PG8_SB(0, 1), cB + hstep, voffB); PG8_STAGE(PG8_SA(0, 1), cA + hstep, voffA);
        if (wr == 1) PG8_BAR;
        PG8_WAIT_V(4); PG8_BAR;
        PG8_STAGE(PG8_SB(1, 0), cB + kstep, voffB); PG8_STAGE(PG8_SA(1, 0), cA + kstep, voffA); PG8_STAGE(PG8_SB(1, 1), cB + hstep + kstep, voffB);
        PG8_WAIT_V(6); PG8_BAR;
    }
    for (;;) {
        const bool has_next = S.next(ui + 1, nxt);
        const char* nA = has_next ? (const char*)g.A + (size_t)nxt.pm * tstep : cA; const char* nB = has_next ? (const char*)g.Bt + (size_t)nxt.pn * tstep : cB;
        for (int t = 0; t < nt; t += 2) {
            const bool last = (t == nt - 2);
            const char* a1 = cA + (size_t)(t + 1) * kstep;
            const char* a2 = last ? nA : cA + (size_t)(t + 2) * kstep; const char* b2 = last ? nB : cB + (size_t)(t + 2) * kstep;
            const char* a3 = a2 + kstep; const char* b3 = b2 + kstep;
            if (last && has_next) S.a_ready(nxt);
            if constexpr (SP2) {
            PG8_LDB(B0, 0, 0); PG8_LDB(B1, 0, 1); PG8_SCHED; PG8_LDA(At, 0, 0); PG8_STAGE(PG8_SA(1, 1), a1 + hstep, voffA);
            PG8_WAIT_V(8); PG8_WAIT_L(0); PG8_BAR; PG8_MMA(0, 0, At, B0); PG8_MMA(0, 1, At, B1); PG8_BAR; PG8_SCHED;
            PG8_LDA(At, 0, 1); PG8_STAGE(PG8_SB(0, 0), b2, voffB); PG8_STAGE(PG8_SB(0, 1), b2 + hstep, voffB); PG8_STAGE(PG8_SA(0, 0), a2, voffA);
            PG8_WAIT_V(8); PG8_WAIT_L(0); PG8_BAR; PG8_MMA(1, 0, At, B0); PG8_MMA(1, 1, At, B1); PG8_BAR; PG8_SCHED;
            PG8_LDB(B0, 1, 0); PG8_LDB(B1, 1, 1); PG8_SCHED; PG8_LDA(At, 1, 0); PG8_STAGE(PG8_SA(0, 1), a2 + hstep, voffA);
            PG8_WAIT_V(8); PG8_WAIT_L(0); PG8_BAR; PG8_MMA(0, 0, At, B0); PG8_MMA(0, 1, At, B1); PG8_BAR; PG8_SCHED;
            PG8_LDA(At, 1, 1); PG8_STAGE(PG8_SB(1, 0), b3, voffB); PG8_STAGE(PG8_SB(1, 1), b3 + hstep, voffB); PG8_STAGE(PG8_SA(1, 0), a3, voffA);
            PG8_WAIT_V(8); PG8_WAIT_L(0); PG8_BAR; PG8_MMA(1, 0, At, B0); PG8_MMA(1, 1, At, B1); PG8_BAR; PG8_SCHED;
            } else {
            PG8_LDB(B0, 0, 0); PG8_SCHED; PG8_LDA(At, 0, 0); PG8_STAGE(PG8_SA(1, 1), a1 + hstep, voffA);
            PG8_WAIT_L(8); PG8_BAR; PG8_WAIT_L(0); PG8_MMA(0, 0, At, B0); PG8_BAR; PG8_SCHED;
            PG8_LDB(B1, 0, 1); PG8_STAGE(PG8_SB(0, 0), b2, voffB);
            PG8_BAR; PG8_WAIT_L(0); PG8_MMA(0, 1, At, B1); PG8_BAR;
            PG8_LDA(At, 0, 1); PG8_STAGE(PG8_SA(0, 0), a2, voffA);
            PG8_BAR; PG8_WAIT_L(0); PG8_MMA(1, 0, At, B0); PG8_BAR; PG8_SCHED;
            PG8_STAGE(PG8_SB(0, 1), b2 + hstep, voffB);
            PG8_WAIT_V(6); PG8_BAR; PG8_MMA(1, 1, At, B1); PG8_BAR;
            PG8_LDB(B0, 1, 0); PG8_SCHED; PG8_LDA(At, 1, 0); PG8_STAGE(PG8_SA(0, 1), a2 + hstep, voffA);
            PG8_WAIT_L(8); PG8_BAR; PG8_WAIT_L(0); PG8_MMA(0, 0, At, B0); PG8_BAR; PG8_SCHED;
            PG8_LDB(B1, 1, 1); PG8_STAGE(PG8_SB(1, 0), b3, voffB);
            PG8_BAR; PG8_WAIT_L(0); PG8_MMA(0, 1, At, B1); PG8_BAR;
            PG8_LDA(At, 1, 1); PG8_STAGE(PG8_SA(1, 0), a3, voffA);
            PG8_BAR; PG8_WAIT_L(0); PG8_MMA(1, 0, At, B0); PG8_BAR; PG8_SCHED;
            PG8_STAGE(PG8_SB(1, 1), b3 + hstep, voffB);
            PG8_WAIT_V(6); PG8_BAR; PG8_MMA(1, 1, At, B1); PG8_BAR;
            }
        }
        if constexpr (ALIGN_EPI) { if (wr == 0) PG8_BAR; }
        if constexpr (!Epi::AFTER_DRAIN) { E(acc, cur, wr, wc, fr, fq); S.done(cur); }
        if (!has_next) break;
#pragma unroll
        for (int a = 0; a < 2; ++a)
#pragma unroll
            for (int b = 0; b < 2; ++b)
#pragma unroll
                for (int m = 0; m < 4; ++m)
#pragma unroll
                    for (int n = 0; n < 2; ++n) acc[a][b][m][n] = (f32x4){0.f, 0.f, 0.f, 0.f};
        cur = nxt; cA = nA; cB = nB; ++ui;
        if constexpr (ALIGN_EPI) { if (wr == 1) PG8_BAR; }
    }
    PG8_WAIT_V(0);
    if constexpr (!ALIGN_EPI) { if (wr == 0) PG8_BAR; }
    PG8_BAR;
    if constexpr (Epi::AFTER_DRAIN) { E.fused(acc, cur, wr, wc, fr, fq, lds, wid, lane); S.done(cur); }
#undef PG8_SA
#undef PG8_SB
#undef PG8_STAGE
#undef PG8_LDA
#undef PG8_LDB
#undef PG8_MMA
#undef PG8_WAIT_V
#undef PG8_WAIT_L
#undef PG8_BAR
#undef PG8_SCHED
}
}
#define XB_TMO      128
#define XB_XCNT(j)  (256  + 64 * (j))
#define XB_XSUB(j)  (1280 + 64 * (j))
#define XB_XGEN(j)  (2304 + 64 * (j))
#define XB_TOP      3328
#define XB_TOPGEN   3392
#define XCD_BAR_WORDS 3456
#define XB_SPIN_CAP (1u << 18)
#define LAS __attribute__((address_space(3)))

__device__ __forceinline__ unsigned xb_ld(unsigned* p)              { return __hip_atomic_load(p, __ATOMIC_RELAXED, __HIP_MEMORY_SCOPE_AGENT); }
__device__ __forceinline__ unsigned xb_add(unsigned* p, unsigned v) { return __hip_atomic_fetch_add(p, v, __ATOMIC_RELAXED, __HIP_MEMORY_SCOPE_AGENT); }
__device__ __forceinline__ unsigned xb_xcc_id() { return (unsigned)__builtin_amdgcn_s_getreg((3 << 11) | 20) & 0xFu; }
#define XB_SPIN(cond, bar) do { unsigned _sp = 0; while (cond) { __builtin_amdgcn_s_sleep(1); \
    if ((++_sp & 255u) == 0u) { if (xb_ld(&(bar)[XB_TMO])) break; if (_sp > XB_SPIN_CAP) { atomicAdd(&(bar)[XB_TMO], 1u); break; } } } } while (0)

struct XcdBarrier {
    unsigned* bar; unsigned x;
    volatile LAS unsigned* st;
};

__device__ __forceinline__ XcdBarrier xcd_barrier_post(unsigned* bar, volatile LAS unsigned* st) {
    XcdBarrier b; b.bar = bar; b.x = xb_xcc_id(); b.st = st;
    if (threadIdx.x == 0) (void)xb_add(&bar[XB_XCNT(b.x)], 1u);
    return b;
}
__device__ __forceinline__ void xcd_barrier_complete(unsigned* bar, unsigned x, unsigned& nloc, unsigned& nx) {
    const unsigned G = gridDim.x * gridDim.y * gridDim.z;
    unsigned sum, cnt, mine, sp = 0u;
    for (;;) {
        sum = 0u; cnt = 0u; mine = 0u;
#pragma unroll
        for (unsigned j = 0; j < 16; ++j) { const unsigned c = xb_ld(&bar[XB_XCNT(j)]); sum += c; cnt += (c > 0u) ? 1u : 0u; mine = (j == x) ? c : mine; }
        if (sum == G) break;
        __builtin_amdgcn_s_sleep(1);
        if ((++sp & 255u) == 0u) { if (xb_ld(&bar[XB_TMO])) break; if (sp > XB_SPIN_CAP) { atomicAdd(&bar[XB_TMO], 1u); break; } }
    }
    nloc = mine > 0u ? mine : 1u; nx = cnt > 0u ? cnt : 1u;
}

__device__ __forceinline__ void xcd_barrier(const XcdBarrier& b) {
    asm volatile("s_waitcnt vmcnt(0)" ::: "memory");
    __syncthreads();
    if (threadIdx.x == 0) {
        unsigned* bar = b.bar;
        __builtin_amdgcn_s_waitcnt(0);
        unsigned nloc = b.st[0], nx = b.st[1];
        if (nloc == 0u) { xcd_barrier_complete(bar, b.x, nloc, nx); b.st[0] = nloc; b.st[1] = nx; }
        const unsigned old = xb_add(&bar[XB_XSUB(b.x)], 1u);
        const unsigned gen = old / nloc;
        if (old + 1u == (gen + 1u) * nloc) {
            __builtin_amdgcn_fence(__ATOMIC_RELEASE, "agent");
            asm volatile("s_waitcnt vmcnt(0)" ::: "memory");
            const unsigned og = xb_add(&bar[XB_TOP], 1u);
            const unsigned tg = og / nx;
            if (og + 1u == (tg + 1u) * nx) xb_add(&bar[XB_TOPGEN], 1u);
            else XB_SPIN(xb_ld(&bar[XB_TOPGEN]) == tg, bar);
            __builtin_amdgcn_fence(__ATOMIC_ACQUIRE, "agent");
            xb_add(&bar[XB_XGEN(b.x)], 1u);
            asm volatile("s_waitcnt vmcnt(0)" ::: "memory");
        } else {
            XB_SPIN(xb_ld(&bar[XB_XGEN(b.x)]) == gen, bar);
            __builtin_amdgcn_fence(__ATOMIC_ACQUIRE, "agent");
            asm volatile("s_waitcnt vmcnt(0)" ::: "memory");
        }
    }
    __syncthreads();
}

#define GAS __attribute__((address_space(1)))
typedef unsigned short bf16;
typedef unsigned v4u __attribute__((ext_vector_type(4)));
typedef unsigned v2u __attribute__((ext_vector_type(2)));
typedef float f32x4 __attribute__((ext_vector_type(4)));
#define LDS_WAIT() asm volatile("s_waitcnt lgkmcnt(0)" ::: "memory")

constexpr int DM = 4096, NBATCH = 4, SEQ = 4096, NCTX = 256, LTOT = NCTX + SEQ, MROWS = NBATCH * LTOT;
constexpr int NIN = 13344, NP = 13568, NPG = 13312;
constexpr int CA_Q = 0, CA_FF = 1024, CA_FB = 2048, CA_I = 3072, CA_G = 4096;
constexpr int CB_Q = 5120, CB_K = 5632, CB_V = 6144, CB_G = 7168;
constexpr int CC_U = 8192, CC_G = 9216;
constexpr int CD_Q = 10240, CD_K = 10752, CD_V = 11264, CD_G = 12288;
constexpr int CB_LF = 13312, CB_LB = 13328;
constexpr float EPSN = 1e-6f;

constexpr size_t WS_CTL = 0, CTL_BYTES = 1u << 20;
constexpr size_t WS_WIN = WS_CTL + CTL_BYTES;
constexpr size_t WS_WOUT = WS_WIN + (size_t)NP * DM * 2;
constexpr size_t WS_WGLU = WS_WOUT + (size_t)2 * DM * DM * 2;
constexpr size_t WS_WLR = WS_WGLU + (size_t)2 * 1024 * 1024 * 2;
constexpr size_t WS_MOD = WS_WLR + (size_t)32 * DM * 2;
constexpr size_t WS_HN = WS_MOD + (size_t)2 * 5 * 12288 * 4;
constexpr size_t WS_P = WS_HN + (size_t)MROWS * DM * 2;
constexpr size_t WS_HC = WS_P + (size_t)MROWS * NP * 2;
constexpr size_t WS_HL = WS_HC + (size_t)NBATCH * NCTX * DM * 4;
constexpr size_t WS_O = WS_HL + (size_t)NBATCH * SEQ * DM * 4;
constexpr size_t WS_Z = WS_O + (size_t)MROWS * DM * 2;
constexpr size_t WS_RAW = WS_Z + (size_t)MROWS * 1024 * 2;
constexpr size_t WS_CPART = WS_RAW + (size_t)2 * MROWS * DM * 2;
constexpr size_t WS_END = WS_CPART + (size_t)4 * NBATCH * NCTX * DM * 4;

constexpr int RING_BYTES = 131072, LDSCTL_OFF = 146944, MISC_OFF = LDSCTL_OFF + 320, LDS_BYTES = 147456;
constexpr int CW_BAR = 1024;

struct Args { const float* in[27]; float* out; unsigned char* ws; int ph_lo, ph_hi; };
typedef const __attribute__((address_space(4))) Args* KP;
#define KARGS() ({ KP _p = (KP)__builtin_amdgcn_kernarg_segment_ptr(); asm volatile("" : "+s"(_p)); _p; })

__device__ __forceinline__ float bf2f(bf16 v) { return __builtin_bit_cast(float, (unsigned)v << 16); }
__device__ __forceinline__ unsigned f2bf(float f) { unsigned u = __builtin_bit_cast(unsigned, f); return (u + 0x7fffu + ((u >> 16) & 1u)) >> 16; }
__device__ __forceinline__ unsigned pk2(float lo, float hi) { return f2bf(lo) | (f2bf(hi) << 16); }
typedef float f32x2_ __attribute__((ext_vector_type(2)));
typedef __bf16 bf16x2_ __attribute__((ext_vector_type(2)));
__device__ __forceinline__ unsigned cvtpk(float lo, float hi) { const f32x2_ v = {lo, hi}; return __builtin_bit_cast(unsigned, __builtin_convertvector(v, bf16x2_)); }
template <int CTRL, int ROW_MASK> __device__ __forceinline__ float dpp_f(float x) {
    return __builtin_bit_cast(float, __builtin_amdgcn_update_dpp(0, __builtin_bit_cast(int, x), CTRL, ROW_MASK, 0xf, true));
}
__device__ __forceinline__ float lane_scan(float x, int lane) {
    (void)lane;
    x += dpp_f<0x111, 0xf>(x);
    x += dpp_f<0x112, 0xf>(x);
    x += dpp_f<0x114, 0xf>(x);
    x += dpp_f<0x118, 0xf>(x);
    x += dpp_f<0x142, 0xa>(x);
    x += dpp_f<0x143, 0xc>(x);
    return x;
}

__device__ __forceinline__ float lo_bf(unsigned w) { return __builtin_bit_cast(float, w << 16); }
__device__ __forceinline__ float hi_bf(unsigned w) { return __builtin_bit_cast(float, w & 0xffff0000u); }
__device__ __forceinline__ void unpack8(const v4u w, float* f) {
    f[0] = lo_bf(w.x); f[1] = hi_bf(w.x); f[2] = lo_bf(w.y); f[3] = hi_bf(w.y); f[4] = lo_bf(w.z); f[5] = hi_bf(w.z); f[6] = lo_bf(w.w); f[7] = hi_bf(w.w);
}
__device__ __forceinline__ v4u pack8(const float* f) { v4u w; w.x = pk2(f[0], f[1]); w.y = pk2(f[2], f[3]); w.z = pk2(f[4], f[5]); w.w = pk2(f[6], f[7]); return w; }
__device__ __forceinline__ v4u pack8c(const float* f) { v4u w; w.x = cvtpk(f[0], f[1]); w.y = cvtpk(f[2], f[3]); w.z = cvtpk(f[4], f[5]); w.w = cvtpk(f[6], f[7]); return w; }
__device__ __forceinline__ float wave_sum(float v) {
    const float s = lane_scan(v, 0);
    return __builtin_bit_cast(float, __builtin_amdgcn_readlane(__builtin_bit_cast(int, s), 63));
}
__device__ __forceinline__ float sigmoidf_(float x) { return __builtin_amdgcn_rcpf(1.0f + __builtin_amdgcn_exp2f(-1.4426950408889634f * x)); }
__device__ __forceinline__ float siluf_(float x) { return x * __builtin_amdgcn_rcpf(1.0f + __builtin_amdgcn_exp2f(-1.4426950408889634f * x)); }
__device__ __forceinline__ float log_sigmoidf_(float x) { return fminf(x, 0.f) - log1pf(__expf(-fabsf(x))); }
__device__ __forceinline__ float gelu_tanhf_(float y) { const float t = 0.7978845608028654f * (y + 0.044715f * y * y * y); const float e = __expf(2.f * t); return 0.5f * y * (1.f + (1.f - 2.f / (e + 1.f))); }
__device__ __forceinline__ void sincos_acc(float x, float& s, float& c) {
    const float k = rintf(x * 0.63661977236758134f);
    float r = fmaf(-k, 1.57079637050628662109375f, x);
    r = fmaf(-k, -4.37113882867379e-8f, r);
    const int q = ((int)k) & 3;
    const float r2 = r * r;
    const float sp = r + r * r2 * (-1.6666654611e-1f + r2 * (8.3321608736e-3f + r2 * (-1.9515295891e-4f)));
    const float cp = 1.0f - 0.5f * r2 + r2 * r2 * (4.166664568298827e-2f + r2 * (-1.388731625493765e-3f + r2 * 2.443315711809948e-5f));
    s = (q == 0) ? sp : (q == 1) ? cp : (q == 2) ? -sp : -cp;
    c = (q == 0) ? cp : (q == 1) ? -sp : (q == 2) ? -cp : sp;
}
__device__ __forceinline__ int flip_pos(int p) { return p < NCTX ? (NCTX - 1 - p) : (LTOT + NCTX - 1 - p); }

struct EpiStoreBf16 {
    static constexpr bool PERM = true, AFTER_DRAIN = false;
    bf16* O; int ldc;
    __device__ __forceinline__ void operator()(const pg8::f32x4 (&acc)[2][2][4][2], const pg8::Unit& u, int wr, int wc, int fr, int fq) const {
        const int row0 = u.pm * 256 + wr * 64 + fr, col0 = u.pn * 256 + wc * 32 + 8 * fq;
#pragma unroll
        for (int ai = 0; ai < 2; ++ai)
#pragma unroll
            for (int m = 0; m < 4; ++m) { bf16* rowp = O + (size_t)(row0 + ai * 128 + m * 16) * ldc + col0;
#pragma unroll
                for (int bj = 0; bj < 2; ++bj) { const pg8::f32x4 v0 = acc[ai][bj][m][0], v1 = acc[ai][bj][m][1];
                    pg8::u32x4 w; w.x = pg8::cvt_pk_bf16(v0[0], v0[1]); w.y = pg8::cvt_pk_bf16(v0[2], v0[3]); w.z = pg8::cvt_pk_bf16(v1[0], v1[1]); w.w = pg8::cvt_pk_bf16(v1[2], v1[3]);
                    __builtin_nontemporal_store(w, (pg8::u32x4*)(rowp + bj * 128)); } }
    }
};
struct EpiGlu {
    static constexpr bool PERM = true, AFTER_DRAIN = false;
    const bf16* Z; const bf16* P; bf16* O; const float* bias;
    __device__ __forceinline__ void operator()(const pg8::f32x4 (&acc)[2][2][4][2], const pg8::Unit& u, int wr, int wc, int fr, int fq) const {
        const int row0 = u.pm * 256 + wr * 64 + fr, col0 = u.pn * 256 + wc * 32 + 8 * fq;
#pragma unroll
        for (int ai = 0; ai < 2; ++ai)
#pragma unroll
            for (int m = 0; m < 4; ++m) { const size_t row = (size_t)(row0 + ai * 128 + m * 16);
#pragma unroll
                for (int bj = 0; bj < 2; ++bj) { const int col = col0 + bj * 128;
                    const pg8::u32x4 z8 = *(const pg8::u32x4*)(Z + row * 1024 + col), g8 = *(const pg8::u32x4*)(P + row * NP + CC_G + col);
                    const pg8::f32x4 b0 = *(const pg8::f32x4*)(bias + col), b1 = *(const pg8::f32x4*)(bias + col + 4);
                    const pg8::f32x4 v0 = acc[ai][bj][m][0] + b0, v1 = acc[ai][bj][m][1] + b1;
                    float o[8];
                    o[0] = lo_bf(z8.x) * sigmoidf_(v0[0]) * siluf_(lo_bf(g8.x)); o[1] = hi_bf(z8.x) * sigmoidf_(v0[1]) * siluf_(hi_bf(g8.x));
                    o[2] = lo_bf(z8.y) * sigmoidf_(v0[2]) * siluf_(lo_bf(g8.y)); o[3] = hi_bf(z8.y) * sigmoidf_(v0[3]) * siluf_(hi_bf(g8.y));
                    o[4] = lo_bf(z8.z) * sigmoidf_(v1[0]) * siluf_(lo_bf(g8.z)); o[5] = hi_bf(z8.z) * sigmoidf_(v1[1]) * siluf_(hi_bf(g8.z));
                    o[6] = lo_bf(z8.w) * sigmoidf_(v1[2]) * siluf_(lo_bf(g8.w)); o[7] = hi_bf(z8.w) * sigmoidf_(v1[3]) * siluf_(hi_bf(g8.w));
                    pg8::u32x4 w; w.x = pg8::cvt_pk_bf16(o[0], o[1]); w.y = pg8::cvt_pk_bf16(o[2], o[3]); w.z = pg8::cvt_pk_bf16(o[4], o[5]); w.w = pg8::cvt_pk_bf16(o[6], o[7]);
                    *(pg8::u32x4*)(O + row * DM + 2048 + col) = w; } }
    }
};
struct EpiOut {
    static constexpr bool PERM = false, AFTER_DRAIN = false;
    const float* src_ctx; const float* src_lat; float* dst_ctx; float* dst_lat; const float* modl;
    __device__ __forceinline__ void operator()(const pg8::f32x4 (&acc)[2][2][4][2], const pg8::Unit& u, int wr, int wc, int fr, int fq) const {
        const int b = u.pm / 17, t = u.pm % 17;
        const float* gt = modl + (size_t)(t == 0 ? 4 : b) * 12288 + 8192;
        const size_t rbase = (t == 0) ? (size_t)b * NCTX : (size_t)b * SEQ + (size_t)(t - 1) * 256;
        const float* src = (t == 0) ? src_ctx : src_lat; float* dst = (t == 0) ? dst_ctx : dst_lat;
        const int rr0 = wr * 64 + fr, col0 = u.pn * 256 + wc * 32 + 4 * fq;
        pg8::f32x4 gv[2][2];
#pragma unroll
        for (int bj = 0; bj < 2; ++bj)
#pragma unroll
            for (int n = 0; n < 2; ++n) gv[bj][n] = *(const pg8::f32x4*)(gt + col0 + bj * 128 + n * 16);
#pragma unroll
        for (int ai = 0; ai < 2; ++ai)
#pragma unroll
            for (int m = 0; m < 4; ++m) { const size_t off = (rbase + rr0 + ai * 128 + m * 16) * DM + col0;
#pragma unroll
                for (int bj = 0; bj < 2; ++bj)
#pragma unroll
                    for (int n = 0; n < 2; ++n) { const pg8::f32x4 s = *(const pg8::f32x4*)(src + off + bj * 128 + n * 16);
                        *(pg8::f32x4*)(dst + off + bj * 128 + n * 16) = s + gv[bj][n] * acc[ai][bj][m][n]; } }
    }
};
struct EpiDelta {
    static constexpr bool PERM = true, AFTER_DRAIN = false;
    bf16* dlat; bf16* dctx; const float* modl;
    __device__ __forceinline__ void operator()(const pg8::f32x4 (&acc)[2][2][4][2], const pg8::Unit& u, int wr, int wc, int fr, int fq) const {
        const int b = u.pm / 17, t = u.pm % 17;
        const float* gt = modl + (size_t)(t == 0 ? 4 : b) * 12288 + 8192;
        bf16* dst = (t == 0) ? dctx + (size_t)b * NCTX * DM : dlat + ((size_t)b * SEQ + (size_t)(t - 1) * 256) * DM;
        const int rr0 = wr * 64 + fr, col0 = u.pn * 256 + wc * 32 + 8 * fq;
        pg8::f32x4 gv[2][2];
#pragma unroll
        for (int bj = 0; bj < 2; ++bj)
#pragma unroll
            for (int n = 0; n < 2; ++n) gv[bj][n] = *(const pg8::f32x4*)(gt + col0 + bj * 128 + 4 * n);
#pragma unroll
        for (int ai = 0; ai < 2; ++ai)
#pragma unroll
            for (int m = 0; m < 4; ++m) { bf16* rowp = dst + (size_t)(rr0 + ai * 128 + m * 16) * DM + col0;
#pragma unroll
                for (int bj = 0; bj < 2; ++bj) { const pg8::f32x4 v0 = gv[bj][0] * acc[ai][bj][m][0], v1 = gv[bj][1] * acc[ai][bj][m][1];
                    pg8::u32x4 w; w.x = cvtpk(v0[0], v0[1]); w.y = cvtpk(v0[2], v0[3]); w.z = cvtpk(v1[0], v1[1]); w.w = cvtpk(v1[2], v1[3]);
                    *(pg8::u32x4*)(rowp + bj * 128) = w; } }
    }
};
struct EpiCtxPart {
    static constexpr bool PERM = false, AFTER_DRAIN = false;
    float* part;
    __device__ __forceinline__ void operator()(const pg8::f32x4 (&acc)[2][2][4][2], const pg8::Unit& u, int wr, int wc, int fr, int fq) const {
        const int b = u.pm / 17; const size_t rbase = (size_t)b * NCTX; const int rr0 = wr * 64 + fr, col0 = u.pn * 256 + wc * 32 + 4 * fq;
#pragma unroll
        for (int ai = 0; ai < 2; ++ai)
#pragma unroll
            for (int m = 0; m < 4; ++m) { float* rowp = part + (rbase + rr0 + ai * 128 + m * 16) * DM + col0;
#pragma unroll
                for (int bj = 0; bj < 2; ++bj)
#pragma unroll
                    for (int n = 0; n < 2; ++n) *(pg8::f32x4*)(rowp + bj * 128 + n * 16) = acc[ai][bj][m][n]; }
    }
};
struct CtxSplitOrder {
    int c;
    __device__ __forceinline__ bool next(int i, pg8::Unit& u) const { if (i > 0 || c >= 256) return false; u.pm = (c >> 6) * 17; u.pn = (c >> 2) & 15; return true; }
    __device__ __forceinline__ void a_ready(const pg8::Unit&) const {}
    __device__ __forceinline__ void done(const pg8::Unit&) const {}
};
struct RowOrder {
    pg8::StaticOrder S; int lat;
    __device__ __forceinline__ void init(int N, int G, int c, int lat_) { lat = lat_; S.init(lat_ ? 64 * 256 : MROWS, N, G, c); }
    __device__ __forceinline__ bool next(int i, pg8::Unit& u) const { if (!S.next(i, u)) return false; if (lat) u.pm = (u.pm >> 4) * 17 + 1 + (u.pm & 15); return true; }
    __device__ __forceinline__ void a_ready(const pg8::Unit&) const {}
    __device__ __forceinline__ void done(const pg8::Unit&) const {}
};

__device__ __forceinline__ void transpose_item(const float* W, int K, int Nsrc, int nsrc0, int k0, bf16* WT, int ndst0, LAS float* scr, int lane) {
    if (nsrc0 >= 0) {
#pragma unroll 8
        for (int i = 0; i < 32; ++i) { const int kk = 2 * i + (lane >> 5); scr[kk * 33 + (lane & 31)] = W[(size_t)(k0 + kk) * Nsrc + nsrc0 + (lane & 31)]; }
    } else {
#pragma unroll 8
        for (int i = 0; i < 32; ++i) { const int kk = 2 * i + (lane >> 5); scr[kk * 33 + (lane & 31)] = 0.f; }
    }
    LDS_WAIT(); asm volatile("" ::: "memory");
    const int c = lane & 7;
#pragma unroll
    for (int j = 0; j < 4; ++j) { const int n = (lane >> 3) + 8 * j; const LAS float* s = scr + (8 * c) * 33 + n;
        v4u o; o.x = pk2(s[0 * 33], s[1 * 33]); o.y = pk2(s[2 * 33], s[3 * 33]); o.z = pk2(s[4 * 33], s[5 * 33]); o.w = pk2(s[6 * 33], s[7 * 33]);
        *(v4u*)(WT + (size_t)(ndst0 + n) * K + k0 + 8 * c) = o; }
    LDS_WAIT(); asm volatile("" ::: "memory");
}

__device__ __forceinline__ void phase_a(KP kp, int layer, LAS unsigned char* lds, int tid, int lane, int wave, int bid, int G) {
    unsigned char* ws = kp->ws;
    float* mod = (float*)(ws + WS_MOD);
    {
        LAS float* sc = (LAS float*)lds;
        LAS float* red = (LAS float*)(lds + 81920);
        const float* cin = kp->in[1]; const float* cctx = kp->in[3]; const float* wada = kp->in[5] + (size_t)layer * DM * 12288; const float* bada = kp->in[6] + (size_t)layer * 12288;
        bool have = false;
        for (int u = bid; u < 192; u += G) {
            if (!have) {
                for (int i = tid; i < 5 * DM; i += 512) { const int bi = i / DM, k = i % DM; const float v = bi < 4 ? cin[bi * DM + k] : cctx[k]; sc[i] = v / (1.0f + expf(-v)); }
                __syncthreads(); have = true;
            }
            const float* W = wada + u * 64 + lane;
            float acc0 = 0.f, acc1 = 0.f, acc2 = 0.f, acc3 = 0.f, acc4 = 0.f;
            const int k0 = wave * 512;
#pragma unroll 8
            for (int k = 0; k < 512; ++k) { const float w = W[(size_t)(k0 + k) * 12288];
                acc0 += sc[0 * DM + k0 + k] * w; acc1 += sc[1 * DM + k0 + k] * w; acc2 += sc[2 * DM + k0 + k] * w; acc3 += sc[3 * DM + k0 + k] * w; acc4 += sc[4 * DM + k0 + k] * w; }
            red[(wave * 5 + 0) * 64 + lane] = acc0; red[(wave * 5 + 1) * 64 + lane] = acc1; red[(wave * 5 + 2) * 64 + lane] = acc2; red[(wave * 5 + 3) * 64 + lane] = acc3; red[(wave * 5 + 4) * 64 + lane] = acc4;
            __syncthreads();
            if (tid < 320) { const int bi = tid / 64, cl = tid % 64; float s = 0.f;
#pragma unroll
                for (int w = 0; w < 8; ++w) s += red[(w * 5 + bi) * 64 + cl];
                mod[(size_t)(layer * 5 + bi) * 12288 + u * 64 + cl] = s + bada[u * 64 + cl]; }
            __syncthreads();
        }
        __syncthreads();
    }
    {
        LAS float* scr = (LAS float*)(lds + wave * 16384);
        const int gw = bid * 8 + wave, NGW = G * 8;
        const float* win = kp->in[7] + (size_t)layer * DM * NIN; const float* wout = kp->in[25] + (size_t)layer * DM * DM; const float* wglu = kp->in[21] + (size_t)layer * 1024 * 1024;
        bf16* WIN = (bf16*)(ws + WS_WIN); bf16* WOUT = (bf16*)(ws + WS_WOUT) + (size_t)layer * DM * DM; bf16* WGLU = (bf16*)(ws + WS_WGLU) + (size_t)layer * 1024 * 1024;
        constexpr int I_IN = 64 * (NIN / 32), I_OUT = 64 * (DM / 32), I_GLU = 16 * 32;
        for (int it = gw; it < I_IN + I_OUT + I_GLU; it += NGW) {
            int r = it;
            if (r < I_IN) { const int kb = r / (NIN / 32), nb = r % (NIN / 32), nd = nb * 32;
                if (nd < NPG) { const int ns = nd < 7168 ? nd : nd + 32; transpose_item(win, DM, NIN, ns, kb * 64, WIN, nd, scr, lane); }
                else transpose_item(win, DM, NIN, 7168, kb * 64, (bf16*)(ws + WS_WLR), 0, scr, lane);
                continue; }
            r -= I_IN;
            if (r < I_OUT) { const int kb = r / (DM / 32), nb = r % (DM / 32); transpose_item(wout, DM, DM, nb * 32, kb * 64, WOUT, nb * 32, scr, lane); continue; }
            r -= I_OUT;
            { const int kb = r / 32, nb = r % 32; transpose_item(wglu, 1024, 1024, nb * 32, kb * 64, WGLU, nb * 32, scr, lane); }
        }
    }
}

__device__ __forceinline__ void phase_b(KP kp, int layer, LAS unsigned char* lds, int lane, int wave, int bid, int G) {
    typedef short bf16x8_ __attribute__((ext_vector_type(8)));
    unsigned char* ws = kp->ws;
    const float* src_ctx = kp->in[2];
    const float* src_lat = kp->in[0];
    const float* mod = (const float*)(ws + WS_MOD) + (size_t)layer * 5 * 12288;
    const float* ng = kp->in[4] + (size_t)layer * DM;
    bf16* HN = (bf16*)(ws + WS_HN); bf16* P = (bf16*)(ws + WS_P); const bf16* WLR = (const bf16*)(ws + WS_WLR);
    LAS unsigned char* T = lds;
    LAS f32x4* red = (LAS f32x4*)(lds + 131072);
    const int q = lane >> 4, ii = lane & 15;
    for (int grp = bid; grp < MROWS / 16; grp += G) {
#pragma unroll
        for (int rr = 0; rr < 2; ++rr) {
            const int rl = 2 * wave + rr, row = grp * 16 + rl;
            const int b = row / LTOT, l = row % LTOT;
            const float* hrow = l < NCTX ? src_ctx + ((size_t)b * NCTX + l) * DM : src_lat + ((size_t)b * SEQ + (l - NCTX)) * DM;
            const float* md = mod + (size_t)(l < NCTX ? 4 : b) * 12288;
            f32x4 v[16]; float s = 0.f;
            const bool asm_ctx = (layer == 1 && G == 256 && l < NCTX);
            if (asm_ctx) { const float* crow = kp->in[2] + ((size_t)b * NCTX + l) * DM; const float* prow = (const float*)(ws + WS_CPART) + ((size_t)b * NCTX + l) * DM;
                const float* gt0 = (const float*)(ws + WS_MOD) + (size_t)4 * 12288 + 8192; const size_t qs = (size_t)NBATCH * NCTX * DM;
#pragma unroll
                for (int j = 0; j < 16; ++j) { const int col = 4 * (lane + 64 * j);
                    const f32x4 p4 = (*(const f32x4*)(prow + col) + *(const f32x4*)(prow + qs + col)) + (*(const f32x4*)(prow + 2 * qs + col) + *(const f32x4*)(prow + 3 * qs + col));
                    v[j] = *(const f32x4*)(crow + col) + *(const f32x4*)(gt0 + col) * p4; s += (v[j].x * v[j].x + v[j].y * v[j].y) + (v[j].z * v[j].z + v[j].w * v[j].w); }
            } else if (layer == 1) {
                const bf16* drow = l < NCTX ? (const bf16*)(ws + WS_HC) + ((size_t)b * NCTX + l) * DM : (const bf16*)(ws + WS_HL) + ((size_t)b * SEQ + (l - NCTX)) * DM;
#pragma unroll
                for (int j = 0; j < 16; ++j) { const int col = 4 * (lane + 64 * j); const v2u d2 = *(const v2u*)(drow + col);
                    v[j] = *(const f32x4*)(hrow + col) + (f32x4){lo_bf(d2.x), hi_bf(d2.x), lo_bf(d2.y), hi_bf(d2.y)}; s += (v[j].x * v[j].x + v[j].y * v[j].y) + (v[j].z * v[j].z + v[j].w * v[j].w); }
            } else {
#pragma unroll
                for (int j = 0; j < 16; ++j) { v[j] = *(const f32x4*)(hrow + 4 * (lane + 64 * j)); s += (v[j].x * v[j].x + v[j].y * v[j].y) + (v[j].z * v[j].z + v[j].w * v[j].w); }
            }
            s = wave_sum(s);
            const float rstd = 1.0f / sqrtf(s * (1.0f / DM) + EPSN);
#pragma unroll
            for (int j = 0; j < 16; ++j) { const int col = 4 * (lane + 64 * j);
                const f32x4 g4 = *(const f32x4*)(ng + col), sh = *(const f32x4*)(md + col), sc = *(const f32x4*)(md + DM + col);
                const f32x4 y = v[j] * rstd * g4 * (sc + 1.0f) + sh;
                v2u o; o.x = cvtpk(y.x, y.y); o.y = cvtpk(y.z, y.w);
                *(v2u*)(HN + (size_t)row * DM + col) = o;
                *(LAS v2u*)(T + rl * 8192 + ((((col >> 3) ^ rl) & 511) << 4) + ((col & 7) << 1)) = o; }
        }
        __syncthreads();
        f32x4 acc0 = (f32x4){0.f, 0.f, 0.f, 0.f}, acc1 = (f32x4){0.f, 0.f, 0.f, 0.f};
#pragma unroll 8
        for (int ks = 0; ks < 16; ++ks) { const int k0 = 512 * wave + 32 * ks + 8 * q;
            const bf16x8_ a = *(const LAS bf16x8_*)(T + ii * 8192 + ((((k0 >> 3) ^ ii) & 511) << 4));
            const bf16x8_ b0 = *(const bf16x8_*)(WLR + (size_t)ii * DM + k0), b1 = *(const bf16x8_*)(WLR + (size_t)(16 + ii) * DM + k0);
            acc0 = __builtin_amdgcn_mfma_f32_16x16x32_bf16(a, b0, acc0, 0, 0, 0); acc1 = __builtin_amdgcn_mfma_f32_16x16x32_bf16(a, b1, acc1, 0, 0, 0); }
        if (wave > 0) { red[((wave - 1) * 2 + 0) * 64 + lane] = acc0; red[((wave - 1) * 2 + 1) * 64 + lane] = acc1; }
        __syncthreads();
        if (wave == 0) {
#pragma unroll
            for (int w2 = 0; w2 < 7; ++w2) { acc0 = acc0 + red[(w2 * 2 + 0) * 64 + lane]; acc1 = acc1 + red[(w2 * 2 + 1) * 64 + lane]; }
            bf16* pr = P + (size_t)(grp * 16 + 4 * q) * NP + CB_LF + ii;
            pr[0] = (bf16)f2bf(acc0.x); pr[NP] = (bf16)f2bf(acc0.y); pr[2 * NP] = (bf16)f2bf(acc0.z); pr[3 * NP] = (bf16)f2bf(acc0.w);
            pr[16] = (bf16)f2bf(acc1.x); pr[NP + 16] = (bf16)f2bf(acc1.y); pr[2 * NP + 16] = (bf16)f2bf(acc1.z); pr[3 * NP + 16] = (bf16)f2bf(acc1.w);
        }
    }
    __syncthreads();
}

template <int MODE>
__device__ __forceinline__ void naive_lin_unit(KP kp, int layer, int b, int hd, int dir, LAS unsigned char* lds, int tid) {
    constexpr int DV = MODE == 0 ? 128 : 256, NPART = 512 / DV, ND = 128 / NPART;
    LAS float* qs = (LAS float*)lds; LAS float* ks = qs + 256; LAS float* dsv = ks + 256; LAS float* po = dsv + 256;
    const int e = tid % DV, part = tid / DV, d0 = part * ND;
    const bf16* P = (const bf16*)(kp->ws + WS_P); bf16* RAW = (bf16*)(kp->ws + WS_RAW) + (size_t)dir * MROWS * DM;
    float s[ND];
#pragma unroll
    for (int i = 0; i < ND; ++i) s[i] = 0.f;
    const int qcol = (MODE == 0 ? CA_Q : MODE == 1 ? CB_Q : CD_Q) + hd * 128;
    const int kcol = (MODE == 0 ? (dir ? CA_FB : CA_FF) : MODE == 1 ? CB_K : CD_K) + hd * 128;
    const int vcol = (MODE == 0 ? CA_I : MODE == 1 ? CB_V : CD_V) + hd * DV;
    const int ocol = (MODE == 0 ? 0 : MODE == 1 ? 1024 : 3072) + hd * DV;
    const int d = tid & 127;
    float lbv = 0.f, bias = 0.f, gam = 0.f, frq = 0.f, wg[16];
#pragma unroll
    for (int r = 0; r < 16; ++r) wg[r] = 0.f;
    if (tid < 128) {
        if (MODE == 0) { if (layer == 1) { const float* lbl = kp->in[8]; lbv = 1.0f / (1.0f + expf(-(lbl[(2 + dir) * 1024 + hd * 128 + d] - lbl[dir * 1024 + hd * 128 + d]))); } }
        if (MODE == 1) { const float* w = kp->in[10] + (size_t)(layer * 2 + dir) * 16 * 512 + hd * 128 + d;
#pragma unroll
            for (int r = 0; r < 16; ++r) wg[r] = w[r * 512];
            bias = kp->in[11][(layer * 2 + dir) * 512 + hd * 128 + d]; }
        if (MODE == 2) { gam = 1.0f / (1.0f + expf(-kp->in[23][(layer * 2 + dir) * 4 + hd])); frq = exp2f(-(float)(d & 31) * (13.287712379549449f / 32.0f)); }
    }
    for (int p = 0; p < LTOT; ++p) {
        const int l = dir ? flip_pos(p) : p; const size_t row = (size_t)b * LTOT + l; const bf16* pr = P + row * NP; const int buf = (p & 1) * 128;
        if (tid < 128) {
            float q, key, dec;
            if (MODE == 0) { q = bf2f(pr[qcol + d]); const float z = bf2f(pr[kcol + d]); const float sg = 1.0f / (1.0f + __expf(-z)), sgn = 1.0f / (1.0f + __expf(z));
                dec = fmaxf(lbv + (1.0f - lbv) * sg, 1e-6f); key = (1.0f - lbv) * sgn; }
            if (MODE == 1) { q = bf2f(pr[qcol + d]) * 0.08838834764831845f; key = bf2f(pr[kcol + d]); float x = bias;
#pragma unroll
                for (int r = 0; r < 16; ++r) x += bf2f(pr[CB_LF + dir * 16 + r]) * wg[r];
                dec = __expf(log_sigmoidf_(x) * (1.0f / 16.0f)); }
            if (MODE == 2) { const int j = d & 63; const float q1 = bf2f(pr[qcol + j]), q2 = bf2f(pr[qcol + j + 64]), k1 = bf2f(pr[kcol + j]), k2 = bf2f(pr[kcol + j + 64]);
                float cs = 1.f, sn = 0.f;
                if (l >= NCTX) { const int t = l - NCTX; const float pos = (float)((j < 32) ? (t >> 6) : (t & 63)); sincos_acc(pos * frq, sn, cs); }
                q = ((d < 64) ? (q1 * cs - q2 * sn) : (q1 * sn + q2 * cs)) * 0.08838834764831845f; key = (d < 64) ? (k1 * cs - k2 * sn) : (k1 * sn + k2 * cs); dec = gam; }
            qs[buf + d] = q; ks[buf + d] = key; dsv[buf + d] = dec;
        }
        const float v = bf2f(pr[vcol + e]);
        __syncthreads();
        float acc = 0.f;
#pragma unroll
        for (int i = 0; i < ND; ++i) { s[i] = dsv[buf + d0 + i] * s[i] + ks[buf + d0 + i] * v; acc += s[i] * qs[buf + d0 + i]; }
        po[part * 256 + e] = acc;
        __syncthreads();
        if (part == 0) { float tot = 0.f;
#pragma unroll
            for (int pp = 0; pp < NPART; ++pp) tot += po[pp * 256 + e];
            RAW[row * DM + ocol + e] = (bf16)f2bf(tot); }
    }
    __syncthreads();
}
constexpr int S5_BUS = 132, S5_XS = 136, S5_WAVE_BYTES = 16 * S5_BUS * 4 + 16 * S5_XS * 2;
__device__ __forceinline__ void s5_coef(KP kp, int ld, int g, int p, float& lbr, float& lbi, float& cr, float& ci) {
    const float lre = fminf(kp->in[13][(ld * 64 + g) * 64 + p], -1e-4f), lim = kp->in[14][(ld * 64 + g) * 64 + p];
    const float dt = expf(kp->in[15][ld * 64 + g]);
    const float xr_ = lre * dt, ang = lim * dt;
    float sn, cs, snh, csh; sincos_acc(ang, sn, cs); sincos_acc(0.5f * ang, snh, csh);
    const float mag = expf(xr_), em1 = expm1f(xr_);
    lbr = mag * cs; lbi = mag * sn;
    const float nr = em1 * cs - 2.0f * snh * snh, ni = mag * sn;
    const float den = lre * lre + lim * lim;
    cr = (nr * lre + ni * lim) / den; ci = (ni * lre - nr * lim) / den;
}
__device__ __forceinline__ void s5_unit(KP kp, int layer, int b, int g, int dir, LAS unsigned char* wlds, int lane) {
    typedef short bf16x8_ __attribute__((ext_vector_type(8)));
    typedef float f32x2s __attribute__((ext_vector_type(2)));
    const int ld = layer * 2 + dir; const int ii = lane & 15, q = lane >> 4;
    LAS float* BU = (LAS float*)wlds; LAS bf16* X = (LAS bf16*)(wlds + 16 * S5_BUS * 4);
    float lbr, lbi;
    { float cr_, ci_; s5_coef(kp, ld, g, lane, lbr, lbi, cr_, ci_); }
    bf16x8_ bA[8];
    {
        const float* bre = kp->in[16] + (size_t)(ld * 64 + g) * 64 * 16; const float* bim = kp->in[17] + (size_t)(ld * 64 + g) * 64 * 16;
#pragma unroll
        for (int mt = 0; mt < 8; ++mt) { const int p = 8 * mt + (ii >> 1); float l0, l1, cr, ci; s5_coef(kp, ld, g, p, l0, l1, cr, ci);
#pragma unroll
            for (int j = 0; j < 8; ++j) { const int h = 8 * (q & 1) + j; const float br = bre[p * 16 + h], bi = bim[p * 16 + h];
                const float v = (ii & 1) ? (cr * bi + ci * br) : (cr * br - ci * bi);
                const unsigned hv = f2bf(v); const unsigned lv = f2bf(v - __builtin_bit_cast(float, hv << 16));
                bA[mt][j] = (short)(q < 2 ? hv : lv); } }
    }
    bf16x8_ cA[4];
    {
        const float* cre = kp->in[18] + (size_t)(ld * 64 + g) * 16 * 64 + ii * 64; const float* cim = kp->in[19] + (size_t)(ld * 64 + g) * 16 * 64 + ii * 64;
#pragma unroll
        for (int ks = 0; ks < 4; ++ks)
#pragma unroll
            for (int j = 0; j < 8; ++j) { const int p = 16 * ks + 4 * q + (j >> 1); const float v = (j & 1) ? -cim[p] : cre[p]; cA[ks][j] = (short)f2bf(v); }
    }
    const bf16* P = (const bf16*)(kp->ws + WS_P); bf16* RAW = (bf16*)(kp->ws + WS_RAW) + (size_t)dir * MROWS * DM;
    float xr = 0.f, xi = 0.f;
    v4u ua, un;
#define S5_LOADA(dst, ti_) do { const int ps_ = 16 * (ti_) + ii; const int l_ = dir ? flip_pos(ps_) : ps_; dst = *(const v4u*)(P + ((size_t)b * LTOT + l_) * NP + CC_U + g * 16 + 8 * (q & 1)); } while (0)
    v4u un2;
    S5_LOADA(ua, 0); S5_LOADA(un, 1); un2 = un;
    for (int ti = 0; ti < LTOT / 16; ++ti) {
        if (ti + 2 < LTOT / 16) S5_LOADA(un2, ti + 2);
        const bf16x8_ uf = __builtin_bit_cast(bf16x8_, ua);
#pragma unroll
        for (int mt = 0; mt < 8; ++mt) { const f32x4 c4 = __builtin_amdgcn_mfma_f32_16x16x32_bf16(bA[mt], uf, ((f32x4){0.f, 0.f, 0.f, 0.f}), 0, 0, 0);
            *(LAS f32x4*)(BU + ii * S5_BUS + 16 * mt + 4 * q) = c4; }
        asm volatile("s_waitcnt lgkmcnt(0)" ::: "memory");
        f32x2s bu[16];
#pragma unroll
        for (int t = 0; t < 16; ++t) bu[t] = *(const LAS f32x2s*)(BU + t * S5_BUS + 2 * lane);
#pragma unroll
        for (int t = 0; t < 16; ++t) { const float nxr = lbr * xr - lbi * xi + bu[t].x, nxi = lbr * xi + lbi * xr + bu[t].y; xr = nxr; xi = nxi;
            *(LAS unsigned*)(X + t * S5_XS + 2 * lane) = cvtpk(xr, xi); }
        asm volatile("s_waitcnt lgkmcnt(0)" ::: "memory");
        f32x4 y = (f32x4){0.f, 0.f, 0.f, 0.f};
#pragma unroll
        for (int ks = 0; ks < 4; ++ks) { const bf16x8_ xb_ = *(const LAS bf16x8_*)(X + ii * S5_XS + 32 * ks + 8 * q); y = __builtin_amdgcn_mfma_f32_16x16x32_bf16(cA[ks], xb_, y, 0, 0, 0); }
        {
            const int ps_ = 16 * ti + ii; const int l_ = dir ? flip_pos(ps_) : ps_;
            v2u ov; ov.x = cvtpk(y.x, y.y); ov.y = cvtpk(y.z, y.w);
            *(v2u*)(RAW + ((size_t)b * LTOT + l_) * DM + 2048 + g * 16 + 4 * q) = ov;
        }
        asm volatile("s_waitcnt lgkmcnt(0)" ::: "memory");
        ua = un; un = un2;
    }
#undef S5_LOADA
}
typedef short bf16x8 __attribute__((ext_vector_type(8)));
#define MFMA16(a, b, c) __builtin_amdgcn_mfma_f32_16x16x32_bf16((a), (b), (c), 0, 0, 0)
constexpr int LA_SQ = 136, LA_SJ = 72;
constexpr int LA_QT = 0, LA_KT = LA_QT + 64 * LA_SQ * 2, LA_VR = LA_KT + 64 * LA_SQ * 2, LA_SB = LA_VR + 64 * LA_SQ * 2,
              LA_STT = LA_SB + 64 * LA_SJ * 2, LA_VEC = LA_STT + 128 * LA_SQ * 2, LA_AUX = LA_VEC + 256 * 4, LA_END = LA_AUX + 2 * 64 * 33 * 4;
static_assert(LA_END <= LDSCTL_OFF, "LA LDS map");
typedef short s16x4 __attribute__((ext_vector_type(4)));

__device__ __forceinline__ bf16x8 trfrag(const LAS bf16* base, int stride, int k0, int c0, int lane) {
    const LAS bf16* a = base + (k0 + 8 * (lane >> 4) + ((lane & 15) >> 2)) * stride + c0 + 4 * (lane & 3);
    const s16x4 lo = __builtin_amdgcn_ds_read_tr16_b64_v4i16((LAS s16x4*)a), hi = __builtin_amdgcn_ds_read_tr16_b64_v4i16((LAS s16x4*)(a + 4 * stride));
    return __builtin_shufflevector(lo, hi, 0, 1, 2, 3, 4, 5, 6, 7);
}
__device__ __forceinline__ bf16x8 ldfrag(const LAS bf16* base, int stride, int row0, int k0, int lane) {
    return *(const LAS bf16x8*)(base + (row0 + (lane & 15)) * stride + k0 + 8 * (lane >> 4));
}
template <int MODE>
__device__ __forceinline__ void la_unit(KP kp, int layer, int b, int hd, int dir, int half, LAS unsigned char* lds, int tid, int lane, int w) {
    LAS bf16* QT = (LAS bf16*)(lds + LA_QT); LAS bf16* KT = (LAS bf16*)(lds + LA_KT); LAS bf16* Vr = (LAS bf16*)(lds + LA_VR);
    LAS bf16* Sb = (LAS bf16*)(lds + LA_SB); LAS bf16* Stt = (LAS bf16*)(lds + LA_STT);
    LAS float* eref = (LAS float*)(lds + LA_VEC); LAS float* elast = eref + 128;
    LAS float* aux = (LAS float*)(lds + LA_AUX);
    const bf16* P = (const bf16*)(kp->ws + WS_P); bf16* RAW = (bf16*)(kp->ws + WS_RAW) + (size_t)dir * MROWS * DM;
    const int qcol = (MODE == 0 ? CA_Q : MODE == 1 ? CB_Q : CD_Q) + hd * 128;
    const int kcol = (MODE == 0 ? (dir ? CA_FB : CA_FF) : MODE == 1 ? CB_K : CD_K) + hd * 128;
    const int vcol = (MODE == 0 ? CA_I + hd * 128 : (MODE == 1 ? CB_V : CD_V) + hd * 256 + half * 128) + 16 * w;
    const int ocol = (MODE == 0 ? hd * 128 : (MODE == 1 ? 1024 : 3072) + hd * 256 + half * 128);
    const int c0 = 16 * w;
    const int j0 = 16 * (w & 3);
    float lg = 0.f;
    bf16x8 wA = (bf16x8){0, 0, 0, 0, 0, 0, 0, 0}; f32x4 bias4 = (f32x4){0.f, 0.f, 0.f, 0.f};
    if (MODE == 0) { const float* lbl = kp->in[8];
        if (tid < 128) { float v = 0.f; if (layer == 1) v = 1.0f / (1.0f + expf(-(lbl[(2 + dir) * 1024 + hd * 128 + tid] - lbl[dir * 1024 + hd * 128 + tid]))); aux[tid] = v; aux[128 + tid] = 1.0f - v; } }
    if (MODE == 1) { const float* wg = kp->in[10] + (size_t)(layer * 2 + dir) * 16 * 512 + hd * 128 + c0 + (lane & 15); const float* bg = kp->in[11] + (layer * 2 + dir) * 512 + hd * 128 + c0 + 4 * (lane >> 4);
        const int q_ = lane >> 4;
#pragma unroll
        for (int j = 0; j < 8; ++j) { const float wf = wg[(8 * (q_ & 1) + j) * 512]; const unsigned hi = f2bf(wf); const unsigned lo = f2bf(wf - __builtin_bit_cast(float, hi << 16)); wA[j] = (short)(q_ < 2 ? hi : lo); }
        bias4 = (f32x4){bg[0], bg[1], bg[2], bg[3]}; }
    if (MODE == 2) { lg = log_sigmoidf_(kp->in[23][(layer * 2 + dir) * 4 + hd]);
        for (int i = tid; i < 64 * 32; i += 512) { const int pos = i >> 5, jj = i & 31; float sn, cs; sincos_acc((float)pos * exp2f(-(float)jj * (13.287712379549449f / 32.0f)), sn, cs); aux[pos * 33 + jj] = cs; aux[64 * 33 + pos * 33 + jj] = sn; }
        if (tid < 128) { eref[tid] = expf(32.f * lg); elast[tid] = expf(32.f * lg); } }
    f32x4 st[8];
#pragma unroll
    for (int e = 0; e < 8; ++e) st[e] = (f32x4){0.f, 0.f, 0.f, 0.f};
    v4u pa[2], pb[2], pg[4], pv[2];
    pg[0] = pg[1] = pg[2] = pg[3] = (v4u){0u, 0u, 0u, 0u};
#define LA_PREFETCH(n) do { const int p_ = 64 * (n) + lane; const int l_ = dir ? flip_pos(p_) : p_; const bf16* pr_ = P + ((size_t)b * LTOT + l_) * NP; \
        if (MODE == 2) { const int xc_ = (w < 4 ? qcol : kcol) + j0; pa[0] = *(const v4u*)(pr_ + xc_); pa[1] = *(const v4u*)(pr_ + xc_ + 8); pb[0] = *(const v4u*)(pr_ + xc_ + 64); pb[1] = *(const v4u*)(pr_ + xc_ + 72); } \
        else { pa[0] = *(const v4u*)(pr_ + qcol + c0); pa[1] = *(const v4u*)(pr_ + qcol + c0 + 8); pb[0] = *(const v4u*)(pr_ + kcol + c0); pb[1] = *(const v4u*)(pr_ + kcol + c0 + 8); } \
        if (MODE == 1) { _Pragma("unroll") for (int nt_ = 0; nt_ < 4; ++nt_) { const int p2_ = 64 * (n) + 16 * nt_ + (lane & 15); const int l2_ = dir ? flip_pos(p2_) : p2_; \
            pg[nt_] = *(const v4u*)(P + ((size_t)b * LTOT + l2_) * NP + CB_LF + dir * 16 + 8 * ((lane >> 4) & 1)); } } \
        pv[0] = *(const v4u*)(pr_ + vcol); pv[1] = *(const v4u*)(pr_ + vcol + 8); } while (0)
    LA_PREFETCH(0);
    __syncthreads();
    const int it = w >> 1;
    for (int n = 0; n < LTOT / 64; ++n) {
        {
            float xa[16], xb[16];
            unpack8(pa[0], xa); unpack8(pa[1], xa + 8); unpack8(pb[0], xb); unpack8(pb[1], xb + 8);
            if (MODE == 2) {
                const int p_ = 64 * n + lane; const int l_ = dir ? flip_pos(p_) : p_;
                const bool lat = l_ >= NCTX; const int t_ = l_ - NCTX; const int pos = (j0 < 32) ? (t_ >> 6) : (t_ & 63);
                const float dq = (w < 4) ? __expf((float)(lane - 31) * lg) * 0.08838834764831845f : __expf((float)(31 - lane) * lg);
                float o1[16], o2[16];
#pragma unroll
                for (int c = 0; c < 16; ++c) { float cs = 1.f, sn = 0.f; if (lat) { cs = aux[pos * 33 + ((j0 + c) & 31)]; sn = aux[64 * 33 + pos * 33 + ((j0 + c) & 31)]; }
                    o1[c] = (xa[c] * cs - xb[c] * sn) * dq; o2[c] = (xa[c] * sn + xb[c] * cs) * dq; }
                LAS bf16* T = (w < 4) ? QT : KT;
                *(LAS v4u*)(T + lane * LA_SQ + j0) = pack8c(o1); *(LAS v4u*)(T + lane * LA_SQ + j0 + 8) = pack8c(o1 + 8);
                *(LAS v4u*)(T + lane * LA_SQ + 64 + j0) = pack8c(o2); *(LAS v4u*)(T + lane * LA_SQ + 64 + j0 + 8) = pack8c(o2 + 8);
            } else {
                float g[16];
                if (MODE == 0) {
#pragma unroll
                    for (int c = 0; c < 16; ++c) { const float z = xb[c]; const float e = __expf(-fabsf(z)); const float r = __builtin_amdgcn_rcpf(1.0f + e);
                        const float sp = z >= 0.f ? r : e * r, sn = z >= 0.f ? e * r : r;
                        const float lb_ = aux[c0 + c], om_ = aux[128 + c0 + c];
                        g[c] = __logf(fmaxf(lb_ + om_ * sp, 1e-6f)); xb[c] = om_ * sn; }
                } else {
                    LAS float* XL = (LAS float*)(lds + LA_STT);
#pragma unroll
                    for (int nt = 0; nt < 4; ++nt) { f32x4 x = MFMA16(wA, __builtin_bit_cast(bf16x8, pg[nt]), ((f32x4){0.f, 0.f, 0.f, 0.f})); x = x + bias4;
                        f32x4 gg; gg.x = (fminf(x.x, 0.f) - __logf(1.0f + __expf(-fabsf(x.x)))) * (1.0f / 16.0f); gg.y = (fminf(x.y, 0.f) - __logf(1.0f + __expf(-fabsf(x.y)))) * (1.0f / 16.0f);
                        gg.z = (fminf(x.z, 0.f) - __logf(1.0f + __expf(-fabsf(x.z)))) * (1.0f / 16.0f); gg.w = (fminf(x.w, 0.f) - __logf(1.0f + __expf(-fabsf(x.w)))) * (1.0f / 16.0f);
                        *(LAS f32x4*)(XL + (16 * nt + (lane & 15)) * 132 + c0 + 4 * (lane >> 4)) = gg; }
                    asm volatile("s_waitcnt lgkmcnt(0)" ::: "memory");
#pragma unroll
                    for (int c4 = 0; c4 < 4; ++c4) { const f32x4 t = *(const LAS f32x4*)(XL + lane * 132 + c0 + 4 * c4); g[4 * c4] = t.x; g[4 * c4 + 1] = t.y; g[4 * c4 + 2] = t.z; g[4 * c4 + 3] = t.w; }
#pragma unroll
                    for (int c = 0; c < 16; ++c) xa[c] *= 0.08838834764831845f;
                }
#pragma unroll
                for (int c = 0; c < 16; ++c) { const float bc = lane_scan(g[c], lane); const float br = __shfl(bc, 31), bl = __shfl(bc, 63);
                    xa[c] = xa[c] * __expf(bc - br); xb[c] = xb[c] * __expf(br - bc);
                    if (lane == 0) { eref[c0 + c] = __expf(br); elast[c0 + c] = __expf(bl - br); } }
                *(LAS v4u*)(QT + lane * LA_SQ + c0) = pack8c(xa); *(LAS v4u*)(QT + lane * LA_SQ + c0 + 8) = pack8c(xa + 8);
                *(LAS v4u*)(KT + lane * LA_SQ + c0) = pack8c(xb); *(LAS v4u*)(KT + lane * LA_SQ + c0 + 8) = pack8c(xb + 8);
            }
            *(LAS v4u*)(Vr + lane * LA_SQ + 16 * w) = pv[0]; *(LAS v4u*)(Vr + lane * LA_SQ + 16 * w + 8) = pv[1];
        }
        __syncthreads();
        bf16x8 qa[4];
        {
            const f32x4 er = *(const LAS f32x4*)(eref + 16 * w + 4 * (lane >> 4));
#pragma unroll
            for (int e = 0; e < 8; ++e) { st[e] = st[e] * er;
                v2u o; o.x = cvtpk(st[e].x, st[e].y); o.y = cvtpk(st[e].z, st[e].w);
                *(LAS v2u*)(Stt + (16 * e + (lane & 15)) * LA_SQ + 16 * w + 4 * (lane >> 4)) = o; }
#pragma unroll
            for (int ks = 0; ks < 4; ++ks) qa[ks] = ldfrag(QT, LA_SQ, 16 * it, 32 * ks, lane);
#pragma unroll
            for (int t = 0; t < 2; ++t) { const int jt = 2 * (w & 1) + t; f32x4 s = (f32x4){0.f, 0.f, 0.f, 0.f};
                if (jt <= it) {
#pragma unroll
                    for (int ks = 0; ks < 4; ++ks) s = MFMA16(ldfrag(KT, LA_SQ, 16 * jt, 32 * ks, lane), qa[ks], s); }
                const int i = 16 * it + (lane & 15), jb = 16 * jt + 4 * (lane >> 4);
                v2u o; o.x = cvtpk(jb <= i ? s.x : 0.f, jb + 1 <= i ? s.y : 0.f); o.y = cvtpk(jb + 2 <= i ? s.z : 0.f, jb + 3 <= i ? s.w : 0.f);
                *(LAS v2u*)(Sb + i * LA_SJ + jb) = o; }
        }
        __syncthreads();
        if (n + 1 < LTOT / 64) LA_PREFETCH(n + 1);
        {
            const bf16x8 sb0 = ldfrag(Sb, LA_SJ, 16 * it, 0, lane), sb1 = ldfrag(Sb, LA_SJ, 16 * it, 32, lane);
            const int p_ = 64 * n + 16 * it + (lane & 15); const int l_ = dir ? flip_pos(p_) : p_;
            bf16* orow = RAW + ((size_t)b * LTOT + l_) * DM + ocol + 4 * (lane >> 4);
#pragma unroll
            for (int t = 0; t < 4; ++t) { const int et = 4 * (w & 1) + t; f32x4 o = (f32x4){0.f, 0.f, 0.f, 0.f};
                o = MFMA16(trfrag(Vr, LA_SQ, 0, 16 * et, lane), sb0, o);
                if (it >= 2) o = MFMA16(trfrag(Vr, LA_SQ, 32, 16 * et, lane), sb1, o);
#pragma unroll
                for (int ks = 0; ks < 4; ++ks) o = MFMA16(ldfrag(Stt, LA_SQ, 16 * et, 32 * ks, lane), qa[ks], o);
                v2u ov; ov.x = cvtpk(o.x, o.y); ov.y = cvtpk(o.z, o.w);
                *(v2u*)(orow + 16 * et) = ov; }
            const bf16x8 ka0 = trfrag(KT, LA_SQ, 0, 16 * w, lane), ka1 = trfrag(KT, LA_SQ, 32, 16 * w, lane);
            const f32x4 el = *(const LAS f32x4*)(elast + 16 * w + 4 * (lane >> 4));
#pragma unroll
            for (int e = 0; e < 8; ++e) { st[e] = MFMA16(ka0, trfrag(Vr, LA_SQ, 0, 16 * e, lane), st[e]); st[e] = MFMA16(ka1, trfrag(Vr, LA_SQ, 32, 16 * e, lane), st[e]); st[e] = st[e] * el; }
        }
        __syncthreads();
    }
#undef LA_PREFETCH
}
constexpr int L2_IMG = 64 * LA_SQ * 2;
constexpr int L2_BUF = 3 * L2_IMG;
constexpr int L2_SB = 2 * L2_BUF, L2_VEC = L2_SB + 64 * LA_SJ * 2, L2_AUX = L2_VEC + 2 * 256 * 4, L2_END = L2_AUX + 4 * 64 * 20 * 4;
static_assert(L2_END <= LDSCTL_OFF && 2 * 64 * 33 * 4 <= 4 * 64 * 20 * 4, "LA2 LDS map");
constexpr float LOG2E_F = 1.4426950408889634f;
__device__ __forceinline__ float ex2(float x) { return __builtin_amdgcn_exp2f(x); }
__device__ __forceinline__ float lg2(float x) { return __builtin_amdgcn_logf(x); }
__device__ __forceinline__ float rdlane(float x, int l) { return __builtin_bit_cast(float, __builtin_amdgcn_readlane(__builtin_bit_cast(int, x), l)); }
#define L2_BAR() do { asm volatile("s_waitcnt lgkmcnt(0)" ::: "memory"); __builtin_amdgcn_s_barrier(); asm volatile("" ::: "memory"); } while (0)

template <int MODE>
__device__ __forceinline__ void la_unit2(KP kp, int layer, int b, int hd, int dir, int half, LAS unsigned char* lds, int tid, int lane, int w) {
    LAS bf16* Sb = (LAS bf16*)(lds + L2_SB);
    LAS float* vec = (LAS float*)(lds + L2_VEC);
    LAS float* aux = (LAS float*)(lds + L2_AUX);
    const bf16* P = (const bf16*)(kp->ws + WS_P); bf16* RAW = (bf16*)(kp->ws + WS_RAW) + (size_t)dir * MROWS * DM;
    const int qcol = (MODE == 0 ? CA_Q : MODE == 1 ? CB_Q : CD_Q) + hd * 128;
    const int kcol = (MODE == 0 ? (dir ? CA_FB : CA_FF) : MODE == 1 ? CB_K : CD_K) + hd * 128;
    const int vcol0 = (MODE == 0 ? CA_I + hd * 128 : (MODE == 1 ? CB_V : CD_V) + hd * 256 + half * 128);
    const int ocol = (MODE == 0 ? hd * 128 : (MODE == 1 ? 1024 : 3072) + hd * 256 + half * 128);
    const int NCH = LTOT / 64;
    float lg = 0.f;
    if (MODE == 0) { const float* lbl = kp->in[8];
        if (tid < 128) { float v = 0.f; if (layer == 1) v = 1.0f / (1.0f + expf(-(lbl[(2 + dir) * 1024 + hd * 128 + tid] - lbl[dir * 1024 + hd * 128 + tid]))); aux[tid] = v; aux[128 + tid] = 1.0f - v; } }
    if (MODE == 2) { lg = log_sigmoidf_(kp->in[23][(layer * 2 + dir) * 4 + hd]) * LOG2E_F;
        for (int i = tid; i < 64 * 32; i += 512) { const int pos = i >> 5, jj = i & 31; float sn, cs; sincos_acc((float)pos * exp2f(-(float)jj * (13.287712379549449f / 32.0f)), sn, cs); aux[pos * 33 + jj] = cs; aux[64 * 33 + pos * 33 + jj] = sn; }
        if (tid < 256) { vec[tid] = exp2f(32.f * lg); vec[256 + tid] = exp2f(32.f * lg); } }
    __syncthreads();
    if (w < 4) {
        const int pw = w;
        const int cbase = 32 * pw;
        const int isk = pw >> 1, jb = 32 * (pw & 1);
        bf16x8 wA[2]; f32x4 bias4[2];
        wA[0] = wA[1] = (bf16x8){0, 0, 0, 0, 0, 0, 0, 0}; bias4[0] = bias4[1] = (f32x4){0.f, 0.f, 0.f, 0.f};
        if (MODE == 1) {
#pragma unroll
            for (int grp = 0; grp < 2; ++grp) { const int c0 = cbase + 16 * grp;
                const float* wg = kp->in[10] + (size_t)(layer * 2 + dir) * 16 * 512 + hd * 128 + c0 + (lane & 15); const float* bg = kp->in[11] + (layer * 2 + dir) * 512 + hd * 128 + c0 + 4 * (lane >> 4);
                const int q_ = lane >> 4;
#pragma unroll
                for (int j = 0; j < 8; ++j) { const float wf = wg[(8 * (q_ & 1) + j) * 512]; const unsigned hi = f2bf(wf); const unsigned lo = f2bf(wf - __builtin_bit_cast(float, hi << 16)); wA[grp][j] = (short)(q_ < 2 ? hi : lo); }
                bias4[grp] = (f32x4){bg[0], bg[1], bg[2], bg[3]}; }
        }
        v4u pa[4], pb[4], pv[4], pg[4], na[4], nb_[4], nv[4], ng[4];
        pg[0] = pg[1] = pg[2] = pg[3] = (v4u){0u, 0u, 0u, 0u}; ng[0] = ng[1] = ng[2] = ng[3] = (v4u){0u, 0u, 0u, 0u};
#define L2_PREFETCH(n, pa, pb, pv, pg) do { const int p_ = 64 * (n) + lane; const int l_ = dir ? flip_pos(p_) : p_; const bf16* pr_ = P + ((size_t)b * LTOT + l_) * NP; \
            const int ac_ = (MODE == 2) ? ((isk ? kcol : qcol) + jb) : (qcol + cbase); const int bc_ = (MODE == 2) ? ac_ + 64 : (kcol + cbase); \
            _Pragma("unroll") for (int k_ = 0; k_ < 4; ++k_) { pa[k_] = *(const v4u*)(pr_ + ac_ + 8 * k_); pb[k_] = *(const v4u*)(pr_ + bc_ + 8 * k_); pv[k_] = *(const v4u*)(pr_ + vcol0 + 32 * pw + 8 * k_); } \
            if (MODE == 1) { _Pragma("unroll") for (int nt_ = 0; nt_ < 4; ++nt_) { const int p2_ = 64 * (n) + 16 * nt_ + (lane & 15); const int l2_ = dir ? flip_pos(p2_) : p2_; \
                pg[nt_] = *(const v4u*)(P + ((size_t)b * LTOT + l2_) * NP + CB_LF + dir * 16 + 8 * ((lane >> 4) & 1)); } } } while (0)
#define L2_GROUP(n, bi, grp) do { \
            LAS bf16* QT_ = (LAS bf16*)(lds + (bi) * L2_BUF); LAS bf16* KT_ = QT_ + 64 * LA_SQ; LAS float* ev_ = vec + (bi) * 256; \
            float xa[16], xb[16]; unpack8(pa[2 * (grp)], xa); unpack8(pa[2 * (grp) + 1], xa + 8); unpack8(pb[2 * (grp)], xb); unpack8(pb[2 * (grp) + 1], xb + 8); \
            if (MODE == 2) { \
                const int p_ = 64 * (n) + lane; const int l_ = dir ? flip_pos(p_) : p_; const bool lat = l_ >= NCTX; const int t_ = l_ - NCTX; const int pos = (jb < 32) ? (t_ >> 6) : (t_ & 63); \
                const float dq = isk ? ex2((float)(31 - lane) * lg) : ex2((float)(lane - 31) * lg) * 0.08838834764831845f; \
                const int j0_ = jb + 16 * (grp); float o1[16], o2[16]; \
                _Pragma("unroll") for (int c = 0; c < 16; ++c) { float cs = 1.f, sn = 0.f; if (lat) { cs = aux[pos * 33 + ((j0_ + c) & 31)]; sn = aux[64 * 33 + pos * 33 + ((j0_ + c) & 31)]; } \
                    o1[c] = (xa[c] * cs - xb[c] * sn) * dq; o2[c] = (xa[c] * sn + xb[c] * cs) * dq; } \
                LAS bf16* T_ = isk ? KT_ : QT_; \
                *(LAS v4u*)(T_ + lane * LA_SQ + j0_) = pack8c(o1); *(LAS v4u*)(T_ + lane * LA_SQ + j0_ + 8) = pack8c(o1 + 8); \
                *(LAS v4u*)(T_ + lane * LA_SQ + 64 + j0_) = pack8c(o2); *(LAS v4u*)(T_ + lane * LA_SQ + 64 + j0_ + 8) = pack8c(o2 + 8); \
            } else { \
                const int c0_ = cbase + 16 * (grp); float g[16]; \
                if (MODE == 0) { \
                    _Pragma("unroll") for (int c = 0; c < 16; ++c) { const float r = __builtin_amdgcn_rcpf(1.0f + ex2(-LOG2E_F * xb[c]));        \
                        const float lb_ = aux[c0_ + c], om_ = aux[128 + c0_ + c]; \
                        g[c] = lg2(fmaxf(fmaf(om_, r, lb_), 1e-6f)); xb[c] = fmaf(-om_, r, om_); }                                          \
                } else { \
                    LAS float* XL = aux + pw * (64 * 20);                 \
                    _Pragma("unroll") for (int nt = 0; nt < 4; ++nt) { f32x4 x = MFMA16(wA[grp], __builtin_bit_cast(bf16x8, pg[nt]), ((f32x4){0.f, 0.f, 0.f, 0.f})); x = x + bias4[grp]; \
                        f32x4 gg; gg.x = (fminf(x.x, 0.f) * LOG2E_F - lg2(1.0f + ex2(-LOG2E_F * fabsf(x.x)))) * (1.0f / 16.0f); gg.y = (fminf(x.y, 0.f) * LOG2E_F - lg2(1.0f + ex2(-LOG2E_F * fabsf(x.y)))) * (1.0f / 16.0f); \
                        gg.z = (fminf(x.z, 0.f) * LOG2E_F - lg2(1.0f + ex2(-LOG2E_F * fabsf(x.z)))) * (1.0f / 16.0f); gg.w = (fminf(x.w, 0.f) * LOG2E_F - lg2(1.0f + ex2(-LOG2E_F * fabsf(x.w)))) * (1.0f / 16.0f); \
                        *(LAS f32x4*)(XL + (16 * nt + (lane & 15)) * 20 + 4 * (lane >> 4)) = gg; } \
                    asm volatile("s_waitcnt lgkmcnt(0)" ::: "memory"); \
                    _Pragma("unroll") for (int c4 = 0; c4 < 4; ++c4) { const f32x4 t = *(const LAS f32x4*)(XL + lane * 20 + 4 * c4); g[4 * c4] = t.x; g[4 * c4 + 1] = t.y; g[4 * c4 + 2] = t.z; g[4 * c4 + 3] = t.w; } \
                    asm volatile("s_waitcnt lgkmcnt(0)" ::: "memory"); \
                    _Pragma("unroll") for (int c = 0; c < 16; ++c) xa[c] *= 0.08838834764831845f; \
                } \
                float vr_ = 0.f, vl_ = 0.f;                                \
                _Pragma("unroll") for (int c = 0; c < 16; ++c) g[c] += dpp_f<0x111, 0xf>(g[c]);        \
                _Pragma("unroll") for (int c = 0; c < 16; ++c) g[c] += dpp_f<0x112, 0xf>(g[c]); \
                _Pragma("unroll") for (int c = 0; c < 16; ++c) g[c] += dpp_f<0x114, 0xf>(g[c]); \
                _Pragma("unroll") for (int c = 0; c < 16; ++c) g[c] += dpp_f<0x118, 0xf>(g[c]); \
                _Pragma("unroll") for (int c = 0; c < 16; ++c) g[c] += dpp_f<0x142, 0xa>(g[c]); \
                _Pragma("unroll") for (int c = 0; c < 16; ++c) g[c] += dpp_f<0x143, 0xc>(g[c]); \
                _Pragma("unroll") for (int c = 0; c < 16; ++c) { const float bc = g[c]; const float br = rdlane(bc, 31), bl = rdlane(bc, 63); \
                    xa[c] = xa[c] * ex2(bc - br); xb[c] = xb[c] * ex2(br - bc); vr_ = (lane == c) ? br : vr_; vl_ = (lane == c) ? (bl - br) : vl_; } \
                if (lane < 16) { ev_[c0_ + lane] = ex2(vr_); ev_[128 + c0_ + lane] = ex2(vl_); } \
                *(LAS v4u*)(QT_ + lane * LA_SQ + c0_) = pack8c(xa); *(LAS v4u*)(QT_ + lane * LA_SQ + c0_ + 8) = pack8c(xa + 8); \
                *(LAS v4u*)(KT_ + lane * LA_SQ + c0_) = pack8c(xb); *(LAS v4u*)(KT_ + lane * LA_SQ + c0_ + 8) = pack8c(xb + 8); \
            } } while (0)
#define L2_VALUES(bi) do { LAS bf16* VR_ = (LAS bf16*)(lds + (bi) * L2_BUF) + 2 * 64 * LA_SQ; \
            _Pragma("unroll") for (int k_ = 0; k_ < 4; ++k_) *(LAS v4u*)(VR_ + lane * LA_SQ + 32 * pw + 8 * k_) = pv[k_]; } while (0)
        L2_PREFETCH(0, pa, pb, pv, pg);
        L2_PREFETCH(1, na, nb_, nv, ng);
        L2_GROUP(0, 0, 0); L2_GROUP(0, 0, 1); L2_VALUES(0);
#define L2_ROTATE() do { _Pragma("unroll") for (int k_ = 0; k_ < 4; ++k_) { pa[k_] = na[k_]; pb[k_] = nb_[k_]; pv[k_] = nv[k_]; pg[k_] = ng[k_]; } } while (0)
        L2_ROTATE();
        L2_PREFETCH(2, na, nb_, nv, ng);
        L2_BAR();
        for (int n = 0; n < NCH; ++n) {
            const int nb = (n + 1) & 1;
            if (n + 1 < NCH) { L2_GROUP(n + 1, nb, 0); }
            L2_BAR();
            if (n + 1 < NCH) { L2_GROUP(n + 1, nb, 1); L2_VALUES(nb); }
            L2_ROTATE();
            if (n + 3 < NCH) L2_PREFETCH(n + 3, na, nb_, nv, ng);
            L2_BAR();
        }
#undef L2_ROTATE
#undef L2_PREFETCH
#undef L2_GROUP
#undef L2_VALUES
    } else {
        const int cw = w - 4; const int q = lane >> 4, ii = lane & 15;
        f32x4 st[2][8];
#pragma unroll
        for (int et = 0; et < 2; ++et)
#pragma unroll
            for (int dt = 0; dt < 8; ++dt) st[et][dt] = (f32x4){0.f, 0.f, 0.f, 0.f};
        v2u ovb[8]; bf16* oaddr[4];
#pragma unroll
        for (int t = 0; t < 8; ++t) ovb[t] = (v2u){0u, 0u};
#pragma unroll
        for (int t = 0; t < 4; ++t) oaddr[t] = RAW;
        L2_BAR();
        for (int n = 0; n < NCH; ++n) {
            const int bi = n & 1;
            const LAS bf16* QT = (const LAS bf16*)(lds + bi * L2_BUF); const LAS bf16* KT = QT + 64 * LA_SQ; const LAS bf16* Vr = KT + 64 * LA_SQ; const LAS float* ev = vec + bi * 256;
            {
                bf16x8 qa[4];
#pragma unroll
                for (int ks = 0; ks < 4; ++ks) qa[ks] = ldfrag(QT, LA_SQ, 16 * cw, 32 * ks, lane);
#pragma unroll
                for (int jt = 0; jt < 4; ++jt) { f32x4 s = (f32x4){0.f, 0.f, 0.f, 0.f};
                    if (jt <= cw) {
#pragma unroll
                        for (int ks = 0; ks < 4; ++ks) s = MFMA16(ldfrag(KT, LA_SQ, 16 * jt, 32 * ks, lane), qa[ks], s); }
                    const int i = 16 * cw + ii, jbb = 16 * jt + 4 * q;
                    v2u o; o.x = cvtpk(jbb <= i ? s.x : 0.f, jbb + 1 <= i ? s.y : 0.f); o.y = cvtpk(jbb + 2 <= i ? s.z : 0.f, jbb + 3 <= i ? s.w : 0.f);
                    *(LAS v2u*)(Sb + i * LA_SJ + jbb) = o; }
            }
            f32x4 o[2][4];
#pragma unroll
            for (int et = 0; et < 2; ++et)
#pragma unroll
                for (int t = 0; t < 4; ++t) o[et][t] = (f32x4){0.f, 0.f, 0.f, 0.f};
#pragma unroll
            for (int ks = 0; ks < 4; ++ks) {
                const f32x4 e0 = *(const LAS f32x4*)(ev + 32 * ks + 4 * q), e1 = *(const LAS f32x4*)(ev + 32 * ks + 16 + 4 * q);
                bf16x8 sa[2];
#pragma unroll
                for (int et = 0; et < 2; ++et) { st[et][2 * ks] = st[et][2 * ks] * e0; st[et][2 * ks + 1] = st[et][2 * ks + 1] * e1;
                    v4u pk_; pk_.x = cvtpk(st[et][2 * ks].x, st[et][2 * ks].y); pk_.y = cvtpk(st[et][2 * ks].z, st[et][2 * ks].w); pk_.z = cvtpk(st[et][2 * ks + 1].x, st[et][2 * ks + 1].y); pk_.w = cvtpk(st[et][2 * ks + 1].z, st[et][2 * ks + 1].w);
                    sa[et] = __builtin_bit_cast(bf16x8, pk_); }
#pragma unroll
                for (int t = 0; t < 4; ++t) { const LAS bf16* qp = QT + (16 * t + ii) * LA_SQ + 32 * ks + 4 * q;
                    const v2u lo = *(const LAS v2u*)qp, hi = *(const LAS v2u*)(qp + 16);
                    v4u bq; bq.x = lo.x; bq.y = lo.y; bq.z = hi.x; bq.w = hi.y;
                    const bf16x8 qb = __builtin_bit_cast(bf16x8, bq);
                    o[0][t] = MFMA16(sa[0], qb, o[0][t]); o[1][t] = MFMA16(sa[1], qb, o[1][t]); }
            }
            L2_BAR();
            bf16x8 va[2][2];
#pragma unroll
            for (int et = 0; et < 2; ++et)
#pragma unroll
                for (int ks = 0; ks < 2; ++ks) {
                    const LAS bf16* a_ = Vr + (32 * ks + 8 * (lane >> 4) + ((lane & 15) >> 2)) * LA_SQ + 32 * cw + 8 * (lane & 3) + 4 * et;
                    const s16x4 lo_ = __builtin_amdgcn_ds_read_tr16_b64_v4i16((LAS s16x4*)a_), hi_ = __builtin_amdgcn_ds_read_tr16_b64_v4i16((LAS s16x4*)(a_ + 4 * LA_SQ));
                    va[et][ks] = __builtin_shufflevector(lo_, hi_, 0, 1, 2, 3, 4, 5, 6, 7); }
#pragma unroll
            for (int t = 0; t < 4; ++t) {
                const bf16x8 s0 = ldfrag(Sb, LA_SJ, 16 * t, 0, lane);
                o[0][t] = MFMA16(va[0][0], s0, o[0][t]); o[1][t] = MFMA16(va[1][0], s0, o[1][t]);
                if (t >= 2) { const bf16x8 s1 = ldfrag(Sb, LA_SJ, 16 * t, 32, lane); o[0][t] = MFMA16(va[0][1], s1, o[0][t]); o[1][t] = MFMA16(va[1][1], s1, o[1][t]); }
            }
#pragma unroll
            for (int t = 0; t < 4; ++t) { asm volatile("" :: "v"(ovb[2 * t]), "v"(ovb[2 * t + 1]), "v"(oaddr[t])); }
#pragma unroll
            for (int t = 0; t < 4; ++t) {
                const int p_ = 64 * n + 16 * t + ii; const int l_ = dir ? flip_pos(p_) : p_;
                oaddr[t] = RAW + ((size_t)b * LTOT + l_) * DM + ocol + 32 * cw + 8 * q;
                ovb[2 * t].x = cvtpk(o[0][t].x, o[0][t].y); ovb[2 * t].y = cvtpk(o[0][t].z, o[0][t].w);
                ovb[2 * t + 1].x = cvtpk(o[1][t].x, o[1][t].y); ovb[2 * t + 1].y = cvtpk(o[1][t].z, o[1][t].w);
                { v4u w4; w4.x = ovb[2 * t].x; w4.y = ovb[2 * t].y; w4.z = ovb[2 * t + 1].x; w4.w = ovb[2 * t + 1].y; *(v4u*)oaddr[t] = w4; }
            }
#pragma unroll
            for (int dt = 0; dt < 8; ++dt) {
                const bf16x8 k0 = trfrag(KT, LA_SQ, 0, 16 * dt, lane), k1 = trfrag(KT, LA_SQ, 32, 16 * dt, lane);
                const f32x4 el = *(const LAS f32x4*)(ev + 128 + 16 * dt + 4 * q);
#pragma unroll
                for (int et = 0; et < 2; ++et) { st[et][dt] = MFMA16(k0, va[et][0], st[et][dt]); st[et][dt] = MFMA16(k1, va[et][1], st[et][dt]); st[et][dt] = st[et][dt] * el; }
            }
            L2_BAR();
        }
    }
    __syncthreads();
}

#define LA_TIDS() int t2 = threadIdx.x; asm volatile("" : "+v"(t2)); const int ln2 = t2 & 63, wv2 = __builtin_amdgcn_readfirstlane(t2 >> 6)
__device__ __forceinline__ void phase_d(int layer, LAS unsigned char* lds, int bid, int G) {
    for (int u0 = bid; u0 < 256; u0 += G) {
        int u = u0; asm volatile("" : "+s"(u));
        if (u < 64) { LA_TIDS(); la_unit2<0>(KARGS(), layer, u >> 4, (u >> 1) & 7, u & 1, 0, lds, t2, ln2, wv2); }
        else if (u < 128) { LA_TIDS(); const int v = u - 64; la_unit2<1>(KARGS(), layer, v >> 4, (v >> 2) & 3, (v >> 1) & 1, v & 1, lds, t2, ln2, wv2); }
        else if (u < 192) { LA_TIDS(); const int v = u - 128; la_unit2<2>(KARGS(), layer, v >> 4, (v >> 2) & 3, (v >> 1) & 1, v & 1, lds, t2, ln2, wv2); }
        else { LA_TIDS(); const int wu = (u - 192) * 8 + wv2; s5_unit(KARGS(), layer, wu >> 7, (wu >> 1) & 63, wu & 1, lds + wv2 * S5_WAVE_BYTES, ln2); }
    }
}

__device__ __forceinline__ float row16_sum(float x) {
    x += dpp_f<0xB1, 0xf>(x); x += dpp_f<0x4E, 0xf>(x); x += dpp_f<0x141, 0xf>(x); x += dpp_f<0x140, 0xf>(x); return x;
}
__device__ __forceinline__ float row32_sum(float x) { x = row16_sum(x); return x + __shfl_xor(x, 16); }
__device__ __forceinline__ void phase_e(KP kp, int layer, int lane, int wave, int bid, int G) {
    unsigned char* ws = kp->ws;
    const bf16* P = (const bf16*)(ws + WS_P); const bf16* RF = (const bf16*)(ws + WS_RAW); const bf16* RB = RF + (size_t)MROWS * DM;
    bf16* O = (bf16*)(ws + WS_O); bf16* Z = (bf16*)(ws + WS_Z);
    float ga[8], gb[8], gd[8], sd0[8], sd1[8];
    {
        const float* pa_ = kp->in[9] + layer * 128 + 8 * (lane & 15); const float* pb_ = kp->in[12] + layer * 256 + 8 * (lane & 31); const float* pd_ = kp->in[24] + layer * 256 + 8 * (lane & 31);
        const float* ps_ = kp->in[20] + layer * 1024 + 8 * lane;
#pragma unroll
        for (int e = 0; e < 8; ++e) { ga[e] = pa_[e]; gb[e] = pb_[e]; gd[e] = pd_[e]; sd0[e] = ps_[e]; sd1[e] = ps_[512 + e]; }
    }
    const int gw = bid * 8 + wave, NGW = G * 8;
    for (int row = gw; row < MROWS; row += NGW) {
        if (layer == 1 && (row % LTOT) < NCTX) continue;
        const bf16* pr = P + (size_t)row * NP + 8 * lane; const bf16* rf = RF + (size_t)row * DM + 8 * lane; const bf16* rb = RB + (size_t)row * DM + 8 * lane;
        bf16* orow = O + (size_t)row * DM + 8 * lane; bf16* zrow = Z + (size_t)row * 1024 + 8 * lane;
        v4u f_[8], b_[8], g_[8];
#pragma unroll
        for (int pt = 0; pt < 4; ++pt)
#pragma unroll
            for (int h = 0; h < 2; ++h) { f_[2 * pt + h] = *(const v4u*)(rf + 1024 * pt + 512 * h); b_[2 * pt + h] = *(const v4u*)(rb + 1024 * pt + 512 * h); }
#pragma unroll
        for (int h = 0; h < 2; ++h) { g_[h] = *(const v4u*)(pr + CA_G + 512 * h); g_[2 + h] = *(const v4u*)(pr + CB_G + 512 * h); g_[4 + h] = *(const v4u*)(pr + CC_U + 512 * h); g_[6 + h] = *(const v4u*)(pr + CD_G + 512 * h); }
#pragma unroll
        for (int h = 0; h < 2; ++h) {
            float x[8], y[8], gt[8];
            unpack8(f_[h], x); unpack8(b_[h], y); unpack8(g_[h], gt);
            float s = 0.f;
#pragma unroll
            for (int e = 0; e < 8; ++e) { x[e] += y[e]; s += x[e] * x[e]; }
            float r = 1.0f / sqrtf(row16_sum(s) * (1.0f / 128.0f) + EPSN);
#pragma unroll
            for (int e = 0; e < 8; ++e) x[e] = x[e] * r * ga[e] * siluf_(gt[e]);
            *(v4u*)(orow + 512 * h) = pack8c(x);
            unpack8(f_[2 + h], x); unpack8(b_[2 + h], y); unpack8(g_[2 + h], gt);
            s = 0.f;
#pragma unroll
            for (int e = 0; e < 8; ++e) { x[e] += y[e]; s += x[e] * x[e]; }
            r = 1.0f / sqrtf(row32_sum(s) * (1.0f / 256.0f) + EPSN);
#pragma unroll
            for (int e = 0; e < 8; ++e) x[e] = x[e] * r * gb[e] * siluf_(gt[e]);
            *(v4u*)(orow + 1024 + 512 * h) = pack8c(x);
            unpack8(f_[6 + h], x); unpack8(b_[6 + h], y); unpack8(g_[6 + h], gt);
            s = 0.f;
#pragma unroll
            for (int e = 0; e < 8; ++e) { x[e] += y[e]; s += x[e]; }
            const float mu = row32_sum(s) * (1.0f / 256.0f);
            s = 0.f;
#pragma unroll
            for (int e = 0; e < 8; ++e) { x[e] -= mu; s += x[e] * x[e]; }
            r = 1.0f / sqrtf(row32_sum(s) * (1.0f / 256.0f) + EPSN);
#pragma unroll
            for (int e = 0; e < 8; ++e) x[e] = x[e] * r * gd[e] * siluf_(gt[e]);
            *(v4u*)(orow + 3072 + 512 * h) = pack8c(x);
            unpack8(f_[4 + h], x); unpack8(b_[4 + h], y); unpack8(g_[4 + h], gt);
#pragma unroll
            for (int e = 0; e < 8; ++e) x[e] = gelu_tanhf_(x[e] + y[e] + (h ? sd1[e] : sd0[e]) * gt[e]);
            *(v4u*)(zrow + 512 * h) = pack8c(x);
        }
    }
}

__device__ __forceinline__ void phase_h(KP kp, int lane, int wave, int bid, int G) {
    const float* fg = kp->in[26]; float* out = kp->out; const float* x = kp->in[0];
    const bf16* D0 = (const bf16*)(kp->ws + WS_HL); const bf16* D1 = D0 + (size_t)NBATCH * SEQ * DM;
    const int gw = bid * 8 + wave, NGW = G * 8;
    for (int row = gw; row < NBATCH * SEQ; row += NGW) {
        const float* xrow = x + (size_t)row * DM; const bf16* d0 = D0 + (size_t)row * DM; const bf16* d1 = D1 + (size_t)row * DM; float* orow = out + (size_t)row * DM;
        f32x4 v[16]; float s = 0.f;
#pragma unroll
        for (int j = 0; j < 16; ++j) { const int col = 4 * (lane + 64 * j); const v2u a2 = *(const v2u*)(d0 + col), b2 = *(const v2u*)(d1 + col);
            v[j] = *(const f32x4*)(xrow + col) + ((f32x4){lo_bf(a2.x), hi_bf(a2.x), lo_bf(a2.y), hi_bf(a2.y)} + (f32x4){lo_bf(b2.x), hi_bf(b2.x), lo_bf(b2.y), hi_bf(b2.y)});
            s += (v[j].x * v[j].x + v[j].y * v[j].y) + (v[j].z * v[j].z + v[j].w * v[j].w); }
        s = wave_sum(s);
        const float rstd = 1.0f / sqrtf(s * (1.0f / DM) + EPSN);
#pragma unroll
        for (int j = 0; j < 16; ++j) { const int col = 4 * (lane + 64 * j); const f32x4 g4 = *(const f32x4*)(fg + col); *(f32x4*)(orow + col) = v[j] * rstd * g4; }
    }
}

constexpr int N_PHASES = 15;
__global__ void __launch_bounds__(512, 2) fwd(Args a) {
    extern __shared__ __attribute__((aligned(16))) unsigned char lds_raw[];
    LAS unsigned char* lds = (LAS unsigned char*)lds_raw;
    const int bid = blockIdx.x, G = gridDim.x;
#define TIDS() int tid = threadIdx.x; asm volatile("" : "+v"(tid)); const int lane = tid & 63, wave = __builtin_amdgcn_readfirstlane(tid >> 6); (void)lane; (void)wave
    volatile LAS unsigned* MISC = (volatile LAS unsigned*)(lds + MISC_OFF);
    for (int u = threadIdx.x; u < (LDS_BYTES - LDSCTL_OFF) / 4; u += 512) ((LAS unsigned*)(lds + LDSCTL_OFF))[u] = 0u;
    __syncthreads();
    unsigned* ctl = (unsigned*)(a.ws + WS_CTL);
    const int lo = a.ph_lo, hi = a.ph_hi;
    XcdBarrier bar; bar.bar = ctl + CW_BAR; bar.x = 0; bar.st = nullptr;
    if (hi - lo > 1) bar = xcd_barrier_post(ctl + CW_BAR, MISC + 8);
#define IN(k) (lo <= (k) && (k) < hi)
#define SEAM(k) do { if (IN(k) && IN((k) + 1)) xcd_barrier(bar); } while (0)
    for (int layer = 0; layer < 2; ++layer) {
        const int pb = layer * 7;
        if (IN(pb + 0)) { TIDS(); phase_a(KARGS(), layer, lds, tid, lane, wave, bid, G); }
        SEAM(pb + 0);
        if (IN(pb + 1)) { TIDS(); phase_b(KARGS(), layer, lds, lane, wave, bid, G); }
        SEAM(pb + 1);
        if (IN(pb + 2)) { KP kp = KARGS(); unsigned char* ws = kp->ws;
            pg8::Gemm g{(const bf16*)(ws + WS_HN), (const bf16*)(ws + WS_WIN), DM, NPG, DM};
            RowOrder S; S.init(NPG, G, bid, 0);
            EpiStoreBf16 E{(bf16*)(ws + WS_P), NP};
            pg8::gemm_phase<EpiStoreBf16, RowOrder, true, true>(lds, g, S, E);
        }
        SEAM(pb + 2);
        if (IN(pb + 3)) { phase_d(layer, lds, bid, G); }
        SEAM(pb + 3);
        if (IN(pb + 4)) { TIDS(); phase_e(KARGS(), layer, lane, wave, bid, G); }
        SEAM(pb + 4);
        if (IN(pb + 5)) { KP kp = KARGS(); unsigned char* ws = kp->ws;
            pg8::Gemm g{(const bf16*)(ws + WS_Z), (const bf16*)(ws + WS_WGLU) + (size_t)layer * 1024 * 1024, 1024, 1024, 1024};
            RowOrder S; S.init(1024, G, bid, layer == 1 ? 1 : 0);
            EpiGlu E{(const bf16*)(ws + WS_Z), (const bf16*)(ws + WS_P), (bf16*)(ws + WS_O), kp->in[22] + layer * 1024};
            pg8::gemm_phase<EpiGlu, RowOrder, true, true>(lds, g, S, E);
        }
        SEAM(pb + 5);
        if (IN(pb + 6)) { KP kp = KARGS(); unsigned char* ws = kp->ws;
            pg8::Gemm g{(const bf16*)(ws + WS_O), (const bf16*)(ws + WS_WOUT) + (size_t)layer * DM * DM, DM, DM, DM};
            const bool split = (layer == 0 && G == 256);
            RowOrder S; S.init(DM, G, bid, (layer == 1 || split) ? 1 : 0);
            EpiDelta E{(bf16*)(ws + WS_HL) + (size_t)layer * NBATCH * SEQ * DM, (bf16*)(ws + WS_HC), (const float*)(ws + WS_MOD) + (size_t)layer * 5 * 12288};
            pg8::gemm_phase<EpiDelta, RowOrder, true, true>(lds, g, S, E);
            if (split) {
                const int kq = bid & 3;
                pg8::Gemm g2{(const bf16*)(ws + WS_O) + kq * 1024, (const bf16*)(ws + WS_WOUT) + kq * 1024, DM, DM, 1024};
                CtxSplitOrder S2{bid};
                EpiCtxPart E2{(float*)(ws + WS_CPART) + (size_t)kq * NBATCH * NCTX * DM};
                pg8::gemm_phase<EpiCtxPart, CtxSplitOrder, false, true>(lds, g2, S2, E2);
            }
        }
        SEAM(pb + 6);
    }
    if (IN(14)) { TIDS(); phase_h(KARGS(), lane, wave, bid, G); }
#undef IN
#undef SEAM
#undef TIDS
}

extern "C" void kernel_launch(void* const* d_in, const int* in_sizes, int n_in, void* d_out, int out_size, void* d_ws, size_t ws_size, hipStream_t stream) {
    static int grid = 0;
    if (grid == 0) {
        if (n_in != 27 || out_size != NBATCH * SEQ * DM || ws_size < WS_END) { fprintf(stderr, "kernel_launch: unexpected problem (n_in %d out %d ws %zu need %zu); nothing launched\n", n_in, out_size, ws_size, (size_t)WS_END); grid = -1; return; }
        int dev = 0, cus = 0;
        if (hipGetDevice(&dev) != hipSuccess || hipDeviceGetAttribute(&cus, hipDeviceAttributeMultiprocessorCount, dev) != hipSuccess) { grid = -1; return; }
        if (hipFuncSetAttribute((const void*)fwd, hipFuncAttributeMaxDynamicSharedMemorySize, LDS_BYTES) != hipSuccess) { fprintf(stderr, "kernel_launch: hipFuncSetAttribute failed\n"); grid = -1; return; }
        (void)hipGetLastError();
        grid = cus;
    }
    if (grid < 0) return;
    (void)hipMemsetAsync((char*)d_ws + WS_CTL, 0, CTL_BYTES, stream);
    Args a{};
    for (int i = 0; i < 27; ++i) a.in[i] = (const float*)d_in[i];
    a.out = (float*)d_out; a.ws = (unsigned char*)d_ws;
#ifndef ONE_LAUNCH
    for (int ph = 0; ph < N_PHASES; ++ph) { a.ph_lo = ph; a.ph_hi = ph + 1; hipLaunchKernelGGL(fwd, dim3(grid), dim3(512), LDS_BYTES, stream, a); }
#else
    a.ph_lo = 0; a.ph_hi = N_PHASES; hipLaunchKernelGGL(fwd, dim3(grid), dim3(512), LDS_BYTES, stream, a);
#endif
}
```

```cpp
#include <hip/hip_runtime.h>
#include <cstdio>
#include <cstdint>
#define ONE_LAUNCH 1
namespace pg8 {
#define PG8_LAS __attribute__((address_space(3)))
typedef unsigned short bf16_t;
typedef short bf16x8 __attribute__((ext_vector_type(8)));
typedef float f32x4 __attribute__((ext_vector_type(4)));
typedef unsigned u32x4 __attribute__((ext_vector_type(4)));
constexpr int BM = 256, BK = 64, HALF = 128, HTB = HALF * BK * 2  , STAGE_BYTES = 8 * HTB, NXCD = 8, WGM = 8;

__host__ __device__ __forceinline__ int lds_byte(int r, int c) { const int st = (r >> 4) * 2 + (c >> 5), rr = r & 15, cc = c & 31, ob = rr * 64 + cc * 2; return st * 1024 + (ob ^ (((ob >> 9) & 1) << 5)); }
__host__ __device__ __forceinline__ void stage_rc(int b, int& R, int& C) { const int st = b / 1024, sb = b % 1024, swz = sb ^ (((sb >> 9) & 1) << 5); R = (st >> 1) * 16 + swz / 64; C = (st & 1) * 32 + (swz % 64) / 2; }
__host__ __device__ __forceinline__ int perm32(int rho) { const int n = rho >> 4, i = rho & 15; return 8 * (i >> 2) + 4 * n + (i & 3); }

struct Unit { int pm, pn; };
struct Gemm { const bf16_t* A; const bf16_t* Bt; int ld, N, K; };

struct StaticOrder {
    int nM, nN, nwg, G, c;
    __host__ __device__ void init(int M, int N, int G_, int c_) { nM = M / BM; nN = N / BM; nwg = nM * nN; G = G_; c = c_; }
    __host__ __device__ bool next(int i, Unit& u) const {
        const long L = (long)i * G + c; if (L >= nwg) return false;
        int wgid = (int)L; { const int q = nwg / NXCD, r = nwg % NXCD, xcd = wgid % NXCD, off = wgid / NXCD; wgid = (xcd < r ? xcd * (q + 1) : r * (q + 1) + (xcd - r) * q) + off; }
        const int nig = WGM * nN, gid = wgid / nig, fm = gid * WGM, gsz = (nM - fm) < WGM ? (nM - fm) : WGM;
        u.pm = fm + ((wgid % nig) % gsz); u.pn = (wgid % nig) / gsz; return true;
    }
    __device__ __forceinline__ void a_ready(const Unit&) const {}
    __device__ __forceinline__ void done(const Unit&) const {}
};

__device__ __forceinline__ unsigned cvt_pk_bf16(float lo, float hi) { unsigned r; asm volatile("v_cvt_pk_bf16_f32 %0, %1, %2" : "=v"(r) : "v"(lo), "v"(hi)); return r; }
typedef float f32x2 __attribute__((ext_vector_type(2)));
__device__ __forceinline__ f32x2 gelu_pk(f32x2 v) {
    const f32x2 av = __builtin_elementwise_abs(v), d = av * 0.2316418882f + 1.0f;
    f32x2 t; t.x = __builtin_amdgcn_rcpf(d.x); t.y = __builtin_amdgcn_rcpf(d.y);
    f32x2 q = t * 0.5307027145f + (-0.7265760135f); q = q * t + 0.7107068705f; q = q * t + (-0.142248368f); q = q * t + 0.127414796f; q = q * t;
    const f32x2 s = (v * v) * (-0.72134752044f);
    f32x2 e; e.x = __builtin_amdgcn_exp2f(s.x); e.y = __builtin_amdgcn_exp2f(s.y);
    const f32x2 m = v * (q * e), r = v - m;
    f32x2 o; o.x = v.x < 0.f ? m.x : r.x; o.y = v.y < 0.f ? m.y : r.y; return o;
}

template <class Epi, class Sched, bool ALIGN_EPI = false, bool SP2 = false>
__device__ __forceinline__ void gemm_phase(PG8_LAS unsigned char* lds, const Gemm g, const Sched& S, const Epi& E) {
    int tid_l = threadIdx.x; asm volatile("" : "+v"(tid_l));
    const int tid = tid_l, wid = __builtin_amdgcn_readfirstlane(tid >> 6), lane = tid & 63, wr = wid >> 2, wc = wid & 3, fr = lane & 15, fq = lane >> 4;
    const int K = g.K, LD = g.ld, nt = K / BK;
    unsigned voffA[2], voffB[2];
#pragma unroll
    for (int i = 0; i < 2; ++i) { int R, C; stage_rc(tid * 16 + i * 8192, R, C); const int Rb = Epi::PERM ? ((R & ~31) + perm32(R & 31)) : R;
        voffA[i] = (unsigned)(R * LD + C) * 2u; voffB[i] = (unsigned)(Rb * LD + C) * 2u; }
    const size_t kstep = (size_t)(BK * 2);
    const size_t hstep = (size_t)HALF * LD * 2;
    const size_t tstep = 2 * hstep;
    const unsigned ldsw = (unsigned)wid * 1024u;
    const int aoff = lds_byte(wr * 64 + fr, fq * 8), boff = lds_byte(wc * 32 + fr, fq * 8);
#define PG8_SA(b, h) (((b) * 2 + (h)) * HTB)
#define PG8_SB(b, h) ((4 + (b) * 2 + (h)) * HTB)
#define PG8_STAGE(bufoff, gbase, voff) do { _Pragma("unroll") for (int _i = 0; _i < 2; ++_i) \
        __builtin_amdgcn_global_load_lds((const unsigned*)((const char*)(gbase) + (voff)[_i]), (PG8_LAS unsigned*)(lds + (bufoff) + ldsw + _i * 8192), 16, 0, 0); } while (0)
#define PG8_LDA(dst, b, h) do { _Pragma("unroll") for (int m = 0; m < 4; ++m) _Pragma("unroll") for (int k = 0; k < 2; ++k) dst[m][k] = *(const PG8_LAS bf16x8*)(lds + PG8_SA(b, h) + aoff + m * 2048 + k * 1024); } while (0)
#define PG8_LDB(dst, b, h) do { _Pragma("unroll") for (int n = 0; n < 2; ++n) _Pragma("unroll") for (int k = 0; k < 2; ++k) dst[n][k] = *(const PG8_LAS bf16x8*)(lds + PG8_SB(b, h) + boff + n * 2048 + k * 1024); } while (0)
#define PG8_MMA(ai, bj, At, Bt) do { __builtin_amdgcn_s_setprio(1); _Pragma("unroll") for (int m = 0; m < 4; ++m) _Pragma("unroll") for (int n = 0; n < 2; ++n) _Pragma("unroll") for (int k = 0; k < 2; ++k) \
        acc[ai][bj][m][n] = __builtin_amdgcn_mfma_f32_16x16x32_bf16(Bt[n][k], At[m][k], acc[ai][bj][m][n], 0, 0, 0); __builtin_amdgcn_s_setprio(0); } while (0)
#define PG8_WAIT_V(n) asm volatile("s_waitcnt vmcnt(" #n ")" ::: "memory")
#define PG8_WAIT_L(n) asm volatile("s_waitcnt lgkmcnt(" #n ")" ::: "memory")
#define PG8_BAR __builtin_amdgcn_s_barrier()
#define PG8_SCHED __builtin_amdgcn_sched_barrier(0)
    Unit cur, nxt; int ui = 0;
    if (!S.next(0, cur)) return;
    f32x4 acc[2][2][4][2];
#pragma unroll
    for (int a = 0; a < 2; ++a)
#pragma unroll
        for (int b = 0; b < 2; ++b)
#pragma unroll
            for (int m = 0; m < 4; ++m)
#pragma unroll
                for (int n = 0; n < 2; ++n) acc[a][b][m][n] = (f32x4){0.f, 0.f, 0.f, 0.f};
    bf16x8 At[4][2], B0[2][2], B1[2][2];
    const char* cA = (const char*)g.A + (size_t)cur.pm * tstep; const char* cB = (const char*)g.Bt + (size_t)cur.pn * tstep;
    S.a_ready(cur);
    if constexpr (SP2) {
        PG8_STAGE(PG8_SB(0, 0), cB, voffB); PG8_STAGE(PG8_SB(0, 1), cB + hstep, voffB); PG8_STAGE(PG8_SA(0, 0), cA, voffA); PG8_STAGE(PG8_SA(0, 1), cA + hstep, voffA);
        if (wr == 1) PG8_BAR;
        PG8_WAIT_V(2); PG8_BAR;
        PG8_STAGE(PG8_SB(1, 0), cB + kstep, voffB); PG8_STAGE(PG8_SA(1, 0), cA + kstep, voffA); PG8_STAGE(PG8_SB(1, 1), cB + hstep + kstep, voffB);
        PG8_WAIT_V(6); PG8_BAR;
    } else {
        PG8_STAGE(PG8_SB(0, 0), cB, voffB); PG8_STAGE(PG8_SA(0, 0), cA, voffA); PG8_STAGE(PG8_SB(0, 1), cB + hstep, voffB); PG8_STAGE(PG8_SA(0, 1), cA + hstep, voffA);
        if (wr == 1) PG8_BAR;
        PG8_WAIT_V(4); PG8_BAR;
        PG8_STAGE(PG8_SB(1, 0), cB + kstep, voffB); PG8_STAGE(PG8_SA(1, 0), cA + kstep, voffA); PG8_STAGE(PG8_SB(1, 1), cB + hstep + kstep, voffB);
        PG8_WAIT_V(6); PG8_BAR;
    }
    for (;;) {
        const bool has_next = S.next(ui + 1, nxt);
        const char* nA = has_next ? (const char*)g.A + (size_t)nxt.pm * tstep : cA; const char* nB = has_next ? (const char*)g.Bt + (size_t)nxt.pn * tstep : cB;
        for (int t = 0; t < nt; t += 2) {
            const bool last = (t == nt - 2);
            const char* a1 = cA + (size_t)(t + 1) * kstep;
            const char* a2 = last ? nA : cA + (size_t)(t + 2) * kstep; const char* b2 = last ? nB : cB + (size_t)(t + 2) * kstep;
            const char* a3 = a2 + kstep; const char* b3 = b2 + kstep;
            if (last && has_next) S.a_ready(nxt);
            if constexpr (SP2) {
            PG8_LDB(B0, 0, 0); PG8_LDB(B1, 0, 1); PG8_SCHED; PG8_LDA(At, 0, 0); PG8_STAGE(PG8_SA(1, 1), a1 + hstep, voffA);
            PG8_WAIT_V(8); PG8_WAIT_L(0); PG8_BAR; PG8_MMA(0, 0, At, B0); PG8_MMA(0, 1, At, B1); PG8_BAR; PG8_SCHED;
            PG8_LDA(At, 0, 1); PG8_STAGE(PG8_SB(0, 0), b2, voffB); PG8_STAGE(PG8_SB(0, 1), b2 + hstep, voffB); PG8_STAGE(PG8_SA(0, 0), a2, voffA);
            PG8_WAIT_V(8); PG8_WAIT_L(0); PG8_BAR; PG8_MMA(1, 0, At, B0); PG8_MMA(1, 1, At, B1); PG8_BAR; PG8_SCHED;
            PG8_LDB(B0, 1, 0); PG8_LDB(B1, 1, 1); PG8_SCHED; PG8_LDA(At, 1, 0); PG8_STAGE(PG8_SA(0, 1), a2 + hstep, voffA);
            PG8_WAIT_V(8); PG8_WAIT_L(0); PG8_BAR; PG8_MMA(0, 0, At, B0); PG8_MMA(0, 1, At, B1); PG8_BAR; PG8_SCHED;
            PG8_LDA(At, 1, 1); PG8_STAGE(PG8_SB(1, 0), b3, voffB); PG8_STAGE(PG8_SB(1, 1), b3 + hstep, voffB); PG8_STAGE(PG8_SA(1, 0), a3, voffA);
            PG8_WAIT_V(8); PG8_WAIT_L(0); PG8_BAR; PG8_MMA(1, 0, At, B0); PG8_MMA(1, 1, At, B1); PG8_BAR; PG8_SCHED;
            } else {
            PG8_LDB(B0, 0, 0); PG8_SCHED; PG8_LDA(At, 0, 0); PG8_STAGE(PG8_SA(1, 1), a1 + hstep, voffA);
            PG8_WAIT_L(8); PG8_BAR; PG8_WAIT_L(0); PG8_MMA(0, 0, At, B0); PG8_BAR; PG8_SCHED;
            PG8_LDB(B1, 0, 1); PG8_STAGE(PG8_SB(0, 0), b2, voffB);
            PG8_BAR; PG8_WAIT_L(0); PG8_MMA(0, 1, At, B1); PG8_BAR;
            PG8_LDA(At, 0, 1); PG8_STAGE(PG8_SA(0, 0), a2, voffA);
            PG8_BAR; PG8_WAIT_L(0); PG8_MMA(1, 0, At, B0); PG8_BAR; PG8_SCHED;
            PG8_STAGE(PG8_SB(0, 1), b2 + hstep, voffB);
            PG8_WAIT_V(6); PG8_BAR; PG8_MMA(1, 1, At, B1); PG8_BAR;
            PG8_LDB(B0, 1, 0); PG8_SCHED; PG8_LDA(At, 1, 0); PG8_STAGE(PG8_SA(0, 1), a2 + hstep, voffA);
            PG8_WAIT_L(8); PG8_BAR; PG8_WAIT_L(0); PG8_MMA(0, 0, At, B0); PG8_BAR; PG8_SCHED;
            PG8_LDB(B1, 1, 1); PG8_STAGE(PG8_SB(1, 0), b3, voffB);
            PG8_BAR; PG8_WAIT_L(0); PG8_MMA(0, 1, At, B1); PG8_BAR;
            PG8_LDA(At, 1, 1); PG8_STAGE(PG8_SA(1, 0), a3, voffA);
            PG8_BAR; PG8_WAIT_L(0); PG8_MMA(1, 0, At, B0); PG8_BAR; PG8_SCHED;
            PG8_STAGE(PG8_SB(1, 1), b3 + hstep, voffB);
            PG8_WAIT_V(6); PG8_BAR; PG8_MMA(1, 1, At, B1); PG8_BAR;
            }
        }
        if constexpr (ALIGN_EPI) { if (wr == 0) PG8_BAR; }
        if constexpr (!Epi::AFTER_DRAIN) { E(acc, cur, wr, wc, fr, fq); S.done(cur); }
        if (!has_next) break;
#pragma unroll
        for (int a = 0; a < 2; ++a)
#pragma unroll
            for (int b = 0; b < 2; ++b)
#pragma unroll
                for (int m = 0; m < 4; ++m)
#pragma unroll
                    for (int n = 0; n < 2; ++n) acc[a][b][m][n] = (f32x4){0.f, 0.f, 0.f, 0.f};
        cur = nxt; cA = nA; cB = nB; ++ui;
        if constexpr (ALIGN_EPI) { if (wr == 1) PG8_BAR; }
    }
    PG8_WAIT_V(0);
    if constexpr (!ALIGN_EPI) { if (wr == 0) PG8_BAR; }
    PG8_BAR;
    if constexpr (Epi::AFTER_DRAIN) { E.fused(acc, cur, wr, wc, fr, fq, lds, wid, lane); S.done(cur); }
#undef PG8_SA
#undef PG8_SB
#undef PG8_STAGE
#undef PG8_LDA
#undef PG8_LDB
#undef PG8_MMA
#undef PG8_WAIT_V
#undef PG8_WAIT_L
#undef PG8_BAR
#undef PG8_SCHED
}
}
#define XB_TMO      128
#define XB_XCNT(j)  (256  + 64 * (j))
#define XB_XSUB(j)  (1280 + 64 * (j))
#define XB_XGEN(j)  (2304 + 64 * (j))
#define XB_TOP      3328
#define XB_TOPGEN   3392
#define XCD_BAR_WORDS 3456
#define XB_SPIN_CAP (1u << 18)
#define LAS __attribute__((address_space(3)))

__device__ __forceinline__ unsigned xb_ld(unsigned* p)              { return __hip_atomic_load(p, __ATOMIC_RELAXED, __HIP_MEMORY_SCOPE_AGENT); }
__device__ __forceinline__ unsigned xb_add(unsigned* p, unsigned v) { return __hip_atomic_fetch_add(p, v, __ATOMIC_RELAXED, __HIP_MEMORY_SCOPE_AGENT); }
__device__ __forceinline__ unsigned xb_xcc_id() { return (unsigned)__builtin_amdgcn_s_getreg((3 << 11) | 20) & 0xFu; }
#define XB_SPIN(cond, bar) do { unsigned _sp = 0; while (cond) { __builtin_amdgcn_s_sleep(1); \
    if ((++_sp & 255u) == 0u) { if (xb_ld(&(bar)[XB_TMO])) break; if (_sp > XB_SPIN_CAP) { atomicAdd(&(bar)[XB_TMO], 1u); break; } } } } while (0)

struct XcdBarrier {
    unsigned* bar; unsigned x;
    volatile LAS unsigned* st;
};

__device__ __forceinline__ XcdBarrier xcd_barrier_post(unsigned* bar, volatile LAS unsigned* st) {
    XcdBarrier b; b.bar = bar; b.x = xb_xcc_id(); b.st = st;
    if (threadIdx.x == 0) (void)xb_add(&bar[XB_XCNT(b.x)], 1u);
    return b;
}
__device__ __forceinline__ void xcd_barrier_complete(unsigned* bar, unsigned x, unsigned& nloc, unsigned& nx) {
    const unsigned G = gridDim.x * gridDim.y * gridDim.z;
    unsigned sum, cnt, mine, sp = 0u;
    for (;;) {
        sum = 0u; cnt = 0u; mine = 0u;
#pragma unroll
        for (unsigned j = 0; j < 16; ++j) { const unsigned c = xb_ld(&bar[XB_XCNT(j)]); sum += c; cnt += (c > 0u) ? 1u : 0u; mine = (j == x) ? c : mine; }
        if (sum == G) break;
        __builtin_amdgcn_s_sleep(1);
        if ((++sp & 255u) == 0u) { if (xb_ld(&bar[XB_TMO])) break; if (sp > XB_SPIN_CAP) { atomicAdd(&bar[XB_TMO], 1u); break; } }
    }
    nloc = mine > 0u ? mine : 1u; nx = cnt > 0u ? cnt : 1u;
}

__device__ __forceinline__ void xcd_barrier(const XcdBarrier& b) {
    asm volatile("s_waitcnt vmcnt(0)" ::: "memory");
    __syncthreads();
    if (threadIdx.x == 0) {
        unsigned* bar = b.bar;
        __builtin_amdgcn_s_waitcnt(0);
        unsigned nloc = b.st[0], nx = b.st[1];
        if (nloc == 0u) { xcd_barrier_complete(bar, b.x, nloc, nx); b.st[0] = nloc; b.st[1] = nx; }
        const unsigned old = xb_add(&bar[XB_XSUB(b.x)], 1u);
        const unsigned gen = old / nloc;
        if (old + 1u == (gen + 1u) * nloc) {
            __builtin_amdgcn_fence(__ATOMIC_RELEASE, "agent");
            asm volatile("s_waitcnt vmcnt(0)" ::: "memory");
            const unsigned og = xb_add(&bar[XB_TOP], 1u);
            const unsigned tg = og / nx;
            if (og + 1u == (tg + 1u) * nx) xb_add(&bar[XB_TOPGEN], 1u);
            else XB_SPIN(xb_ld(&bar[XB_TOPGEN]) == tg, bar);
            __builtin_amdgcn_fence(__ATOMIC_ACQUIRE, "agent");
            xb_add(&bar[XB_XGEN(b.x)], 1u);
            asm volatile("s_waitcnt vmcnt(0)" ::: "memory");
        } else {
            XB_SPIN(xb_ld(&bar[XB_XGEN(b.x)]) == gen, bar);
            __builtin_amdgcn_fence(__ATOMIC_ACQUIRE, "agent");
            asm volatile("s_waitcnt vmcnt(0)" ::: "memory");
        }
    }
    __syncthreads();
}

#define GAS __attribute__((address_space(1)))
typedef unsigned short bf16;
typedef unsigned v4u __attribute__((ext_vector_type(4)));
typedef unsigned v2u __attribute__((ext_vector_type(2)));
typedef float f32x4 __attribute__((ext_vector_type(4)));
#define LDS_WAIT() asm volatile("s_waitcnt lgkmcnt(0)" ::: "memory")

constexpr int DM = 4096, NBATCH = 4, SEQ = 4096, NCTX = 256, LTOT = NCTX + SEQ, MROWS = NBATCH * LTOT;
constexpr int NIN = 13344, NP = 13568, NPG = 13312;
constexpr int CA_Q = 0, CA_FF = 1024, CA_FB = 2048, CA_I = 3072, CA_G = 4096;
constexpr int CB_Q = 5120, CB_K = 5632, CB_V = 6144, CB_G = 7168;
constexpr int CC_U = 8192, CC_G = 9216;
constexpr int CD_Q = 10240, CD_K = 10752, CD_V = 11264, CD_G = 12288;
constexpr int CB_LF = 13312, CB_LB = 13328;
constexpr float EPSN = 1e-6f;
constexpr size_t P_BLK_ELEMS = (size_t)NBATCH * (NCTX + SEQ) * 512;
constexpr size_t P_LRB_OFF = (size_t)26 * P_BLK_ELEMS;
__device__ __forceinline__ size_t p_off(size_t row, int col) { return (size_t)(col >> 9) * P_BLK_ELEMS + row * 512 + (col & 511); }

constexpr size_t WS_CTL = 0, CTL_BYTES = 1u << 20;
constexpr size_t WS_WIN = WS_CTL + CTL_BYTES;
constexpr size_t WS_WOUT = WS_WIN + (size_t)NP * DM * 2;
constexpr size_t WS_WGLU = WS_WOUT + (size_t)2 * DM * DM * 2;
constexpr size_t WS_WLR = WS_WGLU + (size_t)2 * 1024 * 1024 * 2;
constexpr size_t WS_MOD = WS_WLR + (size_t)32 * DM * 2;
constexpr size_t WS_HN = WS_MOD + (size_t)2 * 5 * 12288 * 4;
constexpr size_t WS_P = WS_HN + (size_t)MROWS * DM * 2;
constexpr size_t WS_HC = WS_P + (size_t)MROWS * NP * 2;
constexpr size_t WS_HL = WS_HC + (size_t)NBATCH * NCTX * DM * 4;
constexpr size_t WS_O = WS_HL + (size_t)NBATCH * SEQ * DM * 4;
constexpr size_t WS_Z = WS_O + (size_t)MROWS * DM * 2;
constexpr size_t WS_RAW = WS_Z + (size_t)MROWS * 1024 * 2;
constexpr size_t WS_CPART = WS_RAW + (size_t)2 * MROWS * DM * 2;
constexpr size_t WS_END = WS_CPART + (size_t)4 * NBATCH * NCTX * DM * 4;

constexpr int RING_BYTES = 131072, LDSCTL_OFF = 146944, MISC_OFF = LDSCTL_OFF + 320, LDS_BYTES = 147456;
constexpr int CW_BAR = 1024;

struct Args { const float* in[27]; float* out; unsigned char* ws; int ph_lo, ph_hi; };
typedef const __attribute__((address_space(4))) Args* KP;
#define KARGS() ({ KP _p = (KP)__builtin_amdgcn_kernarg_segment_ptr(); asm volatile("" : "+s"(_p)); _p; })

__device__ __forceinline__ float bf2f(bf16 v) { return __builtin_bit_cast(float, (unsigned)v << 16); }
__device__ __forceinline__ unsigned f2bf(float f) { unsigned u = __builtin_bit_cast(unsigned, f); return (u + 0x7fffu + ((u >> 16) & 1u)) >> 16; }
__device__ __forceinline__ unsigned pk2(float lo, float hi) { return f2bf(lo) | (f2bf(hi) << 16); }
typedef float f32x2_ __attribute__((ext_vector_type(2)));
typedef __bf16 bf16x2_ __attribute__((ext_vector_type(2)));
__device__ __forceinline__ unsigned cvtpk(float lo, float hi) { const f32x2_ v = {lo, hi}; return __builtin_bit_cast(unsigned, __builtin_convertvector(v, bf16x2_)); }
template <int CTRL, int ROW_MASK> __device__ __forceinline__ float dpp_f(float x) {
    return __builtin_bit_cast(float, __builtin_amdgcn_update_dpp(0, __builtin_bit_cast(int, x), CTRL, ROW_MASK, 0xf, true));
}
__device__ __forceinline__ float lane_scan(float x, int lane) {
    (void)lane;
    x += dpp_f<0x111, 0xf>(x);
    x += dpp_f<0x112, 0xf>(x);
    x += dpp_f<0x114, 0xf>(x);
    x += dpp_f<0x118, 0xf>(x);
    x += dpp_f<0x142, 0xa>(x);
    x += dpp_f<0x143, 0xc>(x);
    return x;
}

__device__ __forceinline__ float lo_bf(unsigned w) { return __builtin_bit_cast(float, w << 16); }
__device__ __forceinline__ float hi_bf(unsigned w) { return __builtin_bit_cast(float, w & 0xffff0000u); }
__device__ __forceinline__ void unpack8(const v4u w, float* f) {
    f[0] = lo_bf(w.x); f[1] = hi_bf(w.x); f[2] = lo_bf(w.y); f[3] = hi_bf(w.y); f[4] = lo_bf(w.z); f[5] = hi_bf(w.z); f[6] = lo_bf(w.w); f[7] = hi_bf(w.w);
}
__device__ __forceinline__ v4u pack8(const float* f) { v4u w; w.x = pk2(f[0], f[1]); w.y = pk2(f[2], f[3]); w.z = pk2(f[4], f[5]); w.w = pk2(f[6], f[7]); return w; }
__device__ __forceinline__ v4u pack8c(const float* f) { v4u w; w.x = cvtpk(f[0], f[1]); w.y = cvtpk(f[2], f[3]); w.z = cvtpk(f[4], f[5]); w.w = cvtpk(f[6], f[7]); return w; }
__device__ __forceinline__ float wave_sum(float v) {
    const float s = lane_scan(v, 0);
    return __builtin_bit_cast(float, __builtin_amdgcn_readlane(__builtin_bit_cast(int, s), 63));
}
__device__ __forceinline__ float sigmoidf_(float x) { return __builtin_amdgcn_rcpf(1.0f + __builtin_amdgcn_exp2f(-1.4426950408889634f * x)); }
__device__ __forceinline__ float siluf_(float x) { return x * __builtin_amdgcn_rcpf(1.0f + __builtin_amdgcn_exp2f(-1.4426950408889634f * x)); }
__device__ __forceinline__ float log_sigmoidf_(float x) { return fminf(x, 0.f) - log1pf(__expf(-fabsf(x))); }
__device__ __forceinline__ float gelu_tanhf_(float y) { const float t = 0.7978845608028654f * (y + 0.044715f * y * y * y); const float e = __expf(2.f * t); return 0.5f * y * (1.f + (1.f - 2.f / (e + 1.f))); }
__device__ __forceinline__ void sincos_acc(float x, float& s, float& c) {
    const float k = rintf(x * 0.63661977236758134f);
    float r = fmaf(-k, 1.57079637050628662109375f, x);
    r = fmaf(-k, -4.37113882867379e-8f, r);
    const int q = ((int)k) & 3;
    const float r2 = r * r;
    const float sp = r + r * r2 * (-1.6666654611e-1f + r2 * (8.3321608736e-3f + r2 * (-1.9515295891e-4f)));
    const float cp = 1.0f - 0.5f * r2 + r2 * r2 * (4.166664568298827e-2f + r2 * (-1.388731625493765e-3f + r2 * 2.443315711809948e-5f));
    s = (q == 0) ? sp : (q == 1) ? cp : (q == 2) ? -sp : -cp;
    c = (q == 0) ? cp : (q == 1) ? -sp : (q == 2) ? -cp : sp;
}
__device__ __forceinline__ int flip_pos(int p) { return p < NCTX ? (NCTX - 1 - p) : (LTOT + NCTX - 1 - p); }

struct EpiStoreBf16 {
    static constexpr bool PERM = true, AFTER_DRAIN = false;
    bf16* O; int ldc;
    __device__ __forceinline__ void operator()(const pg8::f32x4 (&acc)[2][2][4][2], const pg8::Unit& u, int wr, int wc, int fr, int fq) const {
        const int row0 = u.pm * 256 + wr * 64 + fr, col0 = u.pn * 256 + wc * 32 + 8 * fq;
#pragma unroll
        for (int ai = 0; ai < 2; ++ai)
#pragma unroll
            for (int m = 0; m < 4; ++m) { bf16* rowp = O + p_off((size_t)(row0 + ai * 128 + m * 16), col0);
#pragma unroll
                for (int bj = 0; bj < 2; ++bj) { const pg8::f32x4 v0 = acc[ai][bj][m][0], v1 = acc[ai][bj][m][1];
                    pg8::u32x4 w; w.x = pg8::cvt_pk_bf16(v0[0], v0[1]); w.y = pg8::cvt_pk_bf16(v0[2], v0[3]); w.z = pg8::cvt_pk_bf16(v1[0], v1[1]); w.w = pg8::cvt_pk_bf16(v1[2], v1[3]);
                    __builtin_nontemporal_store(w, (pg8::u32x4*)(rowp + bj * 128)); } }
    }
};
struct EpiGlu {
    static constexpr bool PERM = true, AFTER_DRAIN = false;
    const bf16* Z; const bf16* P; bf16* O; const float* bias;
    __device__ __forceinline__ void operator()(const pg8::f32x4 (&acc)[2][2][4][2], const pg8::Unit& u, int wr, int wc, int fr, int fq) const {
        const int row0 = u.pm * 256 + wr * 64 + fr, col0 = u.pn * 256 + wc * 32 + 8 * fq;
#pragma unroll
        for (int ai = 0; ai < 2; ++ai)
#pragma unroll
            for (int m = 0; m < 4; ++m) { const size_t row = (size_t)(row0 + ai * 128 + m * 16);
#pragma unroll
                for (int bj = 0; bj < 2; ++bj) { const int col = col0 + bj * 128;
                    const pg8::u32x4 z8 = *(const pg8::u32x4*)(Z + row * 1024 + col), g8 = *(const pg8::u32x4*)(P + p_off(row, CC_G + col));
                    const pg8::f32x4 b0 = *(const pg8::f32x4*)(bias + col), b1 = *(const pg8::f32x4*)(bias + col + 4);
                    const pg8::f32x4 v0 = acc[ai][bj][m][0] + b0, v1 = acc[ai][bj][m][1] + b1;
                    float o[8];
                    o[0] = lo_bf(z8.x) * sigmoidf_(v0[0]) * siluf_(lo_bf(g8.x)); o[1] = hi_bf(z8.x) * sigmoidf_(v0[1]) * siluf_(hi_bf(g8.x));
                    o[2] = lo_bf(z8.y) * sigmoidf_(v0[2]) * siluf_(lo_bf(g8.y)); o[3] = hi_bf(z8.y) * sigmoidf_(v0[3]) * siluf_(hi_bf(g8.y));
                    o[4] = lo_bf(z8.z) * sigmoidf_(v1[0]) * siluf_(lo_bf(g8.z)); o[5] = hi_bf(z8.z) * sigmoidf_(v1[1]) * siluf_(hi_bf(g8.z));
                    o[6] = lo_bf(z8.w) * sigmoidf_(v1[2]) * siluf_(lo_bf(g8.w)); o[7] = hi_bf(z8.w) * sigmoidf_(v1[3]) * siluf_(hi_bf(g8.w));
                    pg8::u32x4 w; w.x = pg8::cvt_pk_bf16(o[0], o[1]); w.y = pg8::cvt_pk_bf16(o[2], o[3]); w.z = pg8::cvt_pk_bf16(o[4], o[5]); w.w = pg8::cvt_pk_bf16(o[6], o[7]);
                    *(pg8::u32x4*)(O + row * DM + 2048 + col) = w; } }
    }
};
struct EpiOut {
    static constexpr bool PERM = false, AFTER_DRAIN = false;
    const float* src_ctx; const float* src_lat; float* dst_ctx; float* dst_lat; const float* modl;
    __device__ __forceinline__ void operator()(const pg8::f32x4 (&acc)[2][2][4][2], const pg8::Unit& u, int wr, int wc, int fr, int fq) const {
        const int b = u.pm / 17, t = u.pm % 17;
        const float* gt = modl + (size_t)(t == 0 ? 4 : b) * 12288 + 8192;
        const size_t rbase = (t == 0) ? (size_t)b * NCTX : (size_t)b * SEQ + (size_t)(t - 1) * 256;
        const float* src = (t == 0) ? src_ctx : src_lat; float* dst = (t == 0) ? dst_ctx : dst_lat;
        const int rr0 = wr * 64 + fr, col0 = u.pn * 256 + wc * 32 + 4 * fq;
        pg8::f32x4 gv[2][2];
#pragma unroll
        for (int bj = 0; bj < 2; ++bj)
#pragma unroll
            for (int n = 0; n < 2; ++n) gv[bj][n] = *(const pg8::f32x4*)(gt + col0 + bj * 128 + n * 16);
#pragma unroll
        for (int ai = 0; ai < 2; ++ai)
#pragma unroll
            for (int m = 0; m < 4; ++m) { const size_t off = (rbase + rr0 + ai * 128 + m * 16) * DM + col0;
#pragma unroll
                for (int bj = 0; bj < 2; ++bj)
#pragma unroll
                    for (int n = 0; n < 2; ++n) { const pg8::f32x4 s = *(const pg8::f32x4*)(src + off + bj * 128 + n * 16);
                        *(pg8::f32x4*)(dst + off + bj * 128 + n * 16) = s + gv[bj][n] * acc[ai][bj][m][n]; } }
    }
};
struct EpiDelta {
    static constexpr bool PERM = true, AFTER_DRAIN = false;
    bf16* dlat; bf16* dctx; const float* modl;
    __device__ __forceinline__ void operator()(const pg8::f32x4 (&acc)[2][2][4][2], const pg8::Unit& u, int wr, int wc, int fr, int fq) const {
        const int b = u.pm / 17, t = u.pm % 17;
        const float* gt = modl + (size_t)(t == 0 ? 4 : b) * 12288 + 8192;
        bf16* dst = (t == 0) ? dctx + (size_t)b * NCTX * DM : dlat + ((size_t)b * SEQ + (size_t)(t - 1) * 256) * DM;
        const int rr0 = wr * 64 + fr, col0 = u.pn * 256 + wc * 32 + 8 * fq;
        pg8::f32x4 gv[2][2];
#pragma unroll
        for (int bj = 0; bj < 2; ++bj)
#pragma unroll
            for (int n = 0; n < 2; ++n) gv[bj][n] = *(const pg8::f32x4*)(gt + col0 + bj * 128 + 4 * n);
#pragma unroll
        for (int ai = 0; ai < 2; ++ai)
#pragma unroll
            for (int m = 0; m < 4; ++m) { bf16* rowp = dst + (size_t)(rr0 + ai * 128 + m * 16) * DM + col0;
#pragma unroll
                for (int bj = 0; bj < 2; ++bj) { const pg8::f32x4 v0 = gv[bj][0] * acc[ai][bj][m][0], v1 = gv[bj][1] * acc[ai][bj][m][1];
                    pg8::u32x4 w; w.x = cvtpk(v0[0], v0[1]); w.y = cvtpk(v0[2], v0[3]); w.z = cvtpk(v1[0], v1[1]); w.w = cvtpk(v1[2], v1[3]);
                    *(pg8::u32x4*)(rowp + bj * 128) = w; } }
    }
};
struct EpiCtxPart {
    static constexpr bool PERM = false, AFTER_DRAIN = false;
    float* part;
    __device__ __forceinline__ void operator()(const pg8::f32x4 (&acc)[2][2][4][2], const pg8::Unit& u, int wr, int wc, int fr, int fq) const {
        const int b = u.pm / 17; const size_t rbase = (size_t)b * NCTX; const int rr0 = wr * 64 + fr, col0 = u.pn * 256 + wc * 32 + 4 * fq;
#pragma unroll
        for (int ai = 0; ai < 2; ++ai)
#pragma unroll
            for (int m = 0; m < 4; ++m) { float* rowp = part + (rbase + rr0 + ai * 128 + m * 16) * DM + col0;
#pragma unroll
                for (int bj = 0; bj < 2; ++bj)
#pragma unroll
                    for (int n = 0; n < 2; ++n) *(pg8::f32x4*)(rowp + bj * 128 + n * 16) = acc[ai][bj][m][n]; }
    }
};
struct CtxSplitOrder {
    int c;
    __device__ __forceinline__ bool next(int i, pg8::Unit& u) const { if (i > 0 || c >= 256) return false; u.pm = (c >> 6) * 17; u.pn = (c >> 2) & 15; return true; }
    __device__ __forceinline__ void a_ready(const pg8::Unit&) const {}
    __device__ __forceinline__ void done(const pg8::Unit&) const {}
};
struct RowOrder {
    pg8::StaticOrder S; int lat;
    __device__ __forceinline__ void init(int N, int G, int c, int lat_) { lat = lat_; S.init(lat_ ? 64 * 256 : MROWS, N, G, c); }
    __device__ __forceinline__ bool next(int i, pg8::Unit& u) const { if (!S.next(i, u)) return false; if (lat) u.pm = (u.pm >> 4) * 17 + 1 + (u.pm & 15); return true; }
    __device__ __forceinline__ void a_ready(const pg8::Unit&) const {}
    __device__ __forceinline__ void done(const pg8::Unit&) const {}
};

__device__ __forceinline__ void transpose_item(const float* W, int K, int Nsrc, int nsrc0, int k0, bf16* WT, int ndst0, LAS float* scr, int lane) {
    if (nsrc0 >= 0) {
#pragma unroll 8
        for (int i = 0; i < 32; ++i) { const int kk = 2 * i + (lane >> 5); scr[kk * 33 + (lane & 31)] = W[(size_t)(k0 + kk) * Nsrc + nsrc0 + (lane & 31)]; }
    } else {
#pragma unroll 8
        for (int i = 0; i < 32; ++i) { const int kk = 2 * i + (lane >> 5); scr[kk * 33 + (lane & 31)] = 0.f; }
    }
    LDS_WAIT(); asm volatile("" ::: "memory");
    const int c = lane & 7;
#pragma unroll
    for (int j = 0; j < 4; ++j) { const int n = (lane >> 3) + 8 * j; const LAS float* s = scr + (8 * c) * 33 + n;
        v4u o; o.x = pk2(s[0 * 33], s[1 * 33]); o.y = pk2(s[2 * 33], s[3 * 33]); o.z = pk2(s[4 * 33], s[5 * 33]); o.w = pk2(s[6 * 33], s[7 * 33]);
        *(v4u*)(WT + (size_t)(ndst0 + n) * K + k0 + 8 * c) = o; }
    LDS_WAIT(); asm volatile("" ::: "memory");
}

__device__ __forceinline__ void phase_a(KP kp, int layer, LAS unsigned char* lds, int tid, int lane, int wave, int bid, int G) {
    unsigned char* ws = kp->ws;
    float* mod = (float*)(ws + WS_MOD);
    {
        LAS float* sc = (LAS float*)lds;
        LAS float* red = (LAS float*)(lds + 81920);
        const float* cin = kp->in[1]; const float* cctx = kp->in[3]; const float* wada = kp->in[5] + (size_t)layer * DM * 12288; const float* bada = kp->in[6] + (size_t)layer * 12288;
        bool have = false;
        for (int u = bid; u < 192; u += G) {
            if (!have) {
                for (int i = tid; i < 5 * DM; i += 512) { const int bi = i / DM, k = i % DM; const float v = bi < 4 ? cin[bi * DM + k] : cctx[k]; sc[i] = v / (1.0f + expf(-v)); }
                __syncthreads(); have = true;
            }
            const float* W = wada + u * 64 + lane;
            float acc0 = 0.f, acc1 = 0.f, acc2 = 0.f, acc3 = 0.f, acc4 = 0.f;
            const int k0 = wave * 512;
#pragma unroll 8
            for (int k = 0; k < 512; ++k) { const float w = W[(size_t)(k0 + k) * 12288];
                acc0 += sc[0 * DM + k0 + k] * w; acc1 += sc[1 * DM + k0 + k] * w; acc2 += sc[2 * DM + k0 + k] * w; acc3 += sc[3 * DM + k0 + k] * w; acc4 += sc[4 * DM + k0 + k] * w; }
            red[(wave * 5 + 0) * 64 + lane] = acc0; red[(wave * 5 + 1) * 64 + lane] = acc1; red[(wave * 5 + 2) * 64 + lane] = acc2; red[(wave * 5 + 3) * 64 + lane] = acc3; red[(wave * 5 + 4) * 64 + lane] = acc4;
            __syncthreads();
            if (tid < 320) { const int bi = tid / 64, cl = tid % 64; float s = 0.f;
#pragma unroll
                for (int w = 0; w < 8; ++w) s += red[(w * 5 + bi) * 64 + cl];
                mod[(size_t)(layer * 5 + bi) * 12288 + u * 64 + cl] = s + bada[u * 64 + cl]; }
            __syncthreads();
        }
        __syncthreads();
    }
    {
        LAS float* scr = (LAS float*)(lds + wave * 16384);
        const int gw = bid * 8 + wave, NGW = G * 8;
        const float* win = kp->in[7] + (size_t)layer * DM * NIN; const float* wout = kp->in[25] + (size_t)layer * DM * DM; const float* wglu = kp->in[21] + (size_t)layer * 1024 * 1024;
        bf16* WIN = (bf16*)(ws + WS_WIN); bf16* WOUT = (bf16*)(ws + WS_WOUT) + (size_t)layer * DM * DM; bf16* WGLU = (bf16*)(ws + WS_WGLU) + (size_t)layer * 1024 * 1024;
        constexpr int I_IN = 64 * (NIN / 32), I_OUT = 64 * (DM / 32), I_GLU = 16 * 32;
        for (int it = gw; it < I_IN + I_OUT + I_GLU; it += NGW) {
            int r = it;
            if (r < I_IN) { const int kb = r / (NIN / 32), nb = r % (NIN / 32), nd = nb * 32;
                if (nd < NPG) { int ns;
                    if (nd < 4096) { const int h = nd >> 9, r = nd & 511; ns = (r >> 7) * 1024 + h * 128 + (r & 127); }
                    else if (nd < 5120) ns = nd;
                    else if (nd < 7168) { const int h = (nd - 5120) >> 9, r = (nd - 5120) & 511; ns = r < 128 ? 5120 + h * 128 + r : r < 256 ? 5632 + h * 128 + (r - 128) : 6144 + h * 256 + (r - 256); }
                    else if (nd < 10240) ns = nd + 32;
                    else if (nd < 12288) { const int h = (nd - 10240) >> 9, r = (nd - 10240) & 511; ns = r < 128 ? 10272 + h * 128 + r : r < 256 ? 10784 + h * 128 + (r - 128) : 11296 + h * 256 + (r - 256); }
                    else ns = nd + 32;
                    transpose_item(win, DM, NIN, ns, kb * 64, WIN, nd, scr, lane); }
                else transpose_item(win, DM, NIN, 7168, kb * 64, (bf16*)(ws + WS_WLR), 0, scr, lane);
                continue; }
            r -= I_IN;
            if (r < I_OUT) { const int kb = r / (DM / 32), nb = r % (DM / 32); transpose_item(wout, DM, DM, nb * 32, kb * 64, WOUT, nb * 32, scr, lane); continue; }
            r -= I_OUT;
            { const int kb = r / 32, nb = r % 32; transpose_item(wglu, 1024, 1024, nb * 32, kb * 64, WGLU, nb * 32, scr, lane); }
        }
    }
}

__device__ __forceinline__ void phase_b(KP kp, int layer, LAS unsigned char* lds, int lane, int wave, int bid, int G) {
    typedef short bf16x8_ __attribute__((ext_vector_type(8)));
    unsigned char* ws = kp->ws;
    const float* src_ctx = kp->in[2];
    const float* src_lat = kp->in[0];
    const float* mod = (const float*)(ws + WS_MOD) + (size_t)layer * 5 * 12288;
    const float* ng = kp->in[4] + (size_t)layer * DM;
    bf16* HN = (bf16*)(ws + WS_HN); bf16* P = (bf16*)(ws + WS_P); const bf16* WLR = (const bf16*)(ws + WS_WLR);
    LAS unsigned char* T = lds;
    LAS f32x4* red = (LAS f32x4*)(lds + 131072);
    const int q = lane >> 4, ii = lane & 15;
    for (int grp = bid; grp < MROWS / 16; grp += G) {
#pragma unroll
        for (int rr = 0; rr < 2; ++rr) {
            const int rl = 2 * wave + rr, row = grp * 16 + rl;
            const int b = row / LTOT, l = row % LTOT;
            const float* hrow = l < NCTX ? src_ctx + ((size_t)b * NCTX + l) * DM : src_lat + ((size_t)b * SEQ + (l - NCTX)) * DM;
            const float* md = mod + (size_t)(l < NCTX ? 4 : b) * 12288;
            f32x4 v[16]; float s = 0.f;
            const bool asm_ctx = (layer == 1 && G == 256 && l < NCTX);
            if (asm_ctx) { const float* crow = kp->in[2] + ((size_t)b * NCTX + l) * DM; const float* prow = (const float*)(ws + WS_CPART) + ((size_t)b * NCTX + l) * DM;
                const float* gt0 = (const float*)(ws + WS_MOD) + (size_t)4 * 12288 + 8192; const size_t qs = (size_t)NBATCH * NCTX * DM;
#pragma unroll
                for (int j = 0; j < 16; ++j) { const int col = 4 * (lane + 64 * j);
                    const f32x4 p4 = (*(const f32x4*)(prow + col) + *(const f32x4*)(prow + qs + col)) + (*(const f32x4*)(prow + 2 * qs + col) + *(const f32x4*)(prow + 3 * qs + col));
                    v[j] = *(const f32x4*)(crow + col) + *(const f32x4*)(gt0 + col) * p4; s += (v[j].x * v[j].x + v[j].y * v[j].y) + (v[j].z * v[j].z + v[j].w * v[j].w); }
            } else if (layer == 1) {
                const bf16* drow = l < NCTX ? (const bf16*)(ws + WS_HC) + ((size_t)b * NCTX + l) * DM : (const bf16*)(ws + WS_HL) + ((size_t)b * SEQ + (l - NCTX)) * DM;
#pragma unroll
                for (int j = 0; j < 16; ++j) { const int col = 4 * (lane + 64 * j); const v2u d2 = *(const v2u*)(drow + col);
                    v[j] = *(const f32x4*)(hrow + col) + (f32x4){lo_bf(d2.x), hi_bf(d2.x), lo_bf(d2.y), hi_bf(d2.y)}; s += (v[j].x * v[j].x + v[j].y * v[j].y) + (v[j].z * v[j].z + v[j].w * v[j].w); }
            } else {
#pragma unroll
                for (int j = 0; j < 16; ++j) { v[j] = *(const f32x4*)(hrow + 4 * (lane + 64 * j)); s += (v[j].x * v[j].x + v[j].y * v[j].y) + (v[j].z * v[j].z + v[j].w * v[j].w); }
            }
            s = wave_sum(s);
            const float rstd = 1.0f / sqrtf(s * (1.0f / DM) + EPSN);
#pragma unroll
            for (int j = 0; j < 16; ++j) { const int col = 4 * (lane + 64 * j);
                const f32x4 g4 = *(const f32x4*)(ng + col), sh = *(const f32x4*)(md + col), sc = *(const f32x4*)(md + DM + col);
                const f32x4 y = v[j] * rstd * g4 * (sc + 1.0f) + sh;
                v2u o; o.x = cvtpk(y.x, y.y); o.y = cvtpk(y.z, y.w);
                *(v2u*)(HN + (size_t)row * DM + col) = o;
                *(LAS v2u*)(T + rl * 8192 + ((((col >> 3) ^ rl) & 511) << 4) + ((col & 7) << 1)) = o; }
        }
        __syncthreads();
        f32x4 acc0 = (f32x4){0.f, 0.f, 0.f, 0.f}, acc1 = (f32x4){0.f, 0.f, 0.f, 0.f};
#pragma unroll 8
        for (int ks = 0; ks < 16; ++ks) { const int k0 = 512 * wave + 32 * ks + 8 * q;
            const bf16x8_ a = *(const LAS bf16x8_*)(T + ii * 8192 + ((((k0 >> 3) ^ ii) & 511) << 4));
            const bf16x8_ b0 = *(const bf16x8_*)(WLR + (size_t)ii * DM + k0), b1 = *(const bf16x8_*)(WLR + (size_t)(16 + ii) * DM + k0);
            acc0 = __builtin_amdgcn_mfma_f32_16x16x32_bf16(a, b0, acc0, 0, 0, 0); acc1 = __builtin_amdgcn_mfma_f32_16x16x32_bf16(a, b1, acc1, 0, 0, 0); }
        if (wave > 0) { red[((wave - 1) * 2 + 0) * 64 + lane] = acc0; red[((wave - 1) * 2 + 1) * 64 + lane] = acc1; }
        __syncthreads();
        if (wave == 0) {
#pragma unroll
            for (int w2 = 0; w2 < 7; ++w2) { acc0 = acc0 + red[(w2 * 2 + 0) * 64 + lane]; acc1 = acc1 + red[(w2 * 2 + 1) * 64 + lane]; }
            bf16* pr = P + P_LRB_OFF + (size_t)(grp * 16 + 4 * q) * 32 + ii;
            pr[0] = (bf16)f2bf(acc0.x); pr[32] = (bf16)f2bf(acc0.y); pr[64] = (bf16)f2bf(acc0.z); pr[96] = (bf16)f2bf(acc0.w);
            pr[16] = (bf16)f2bf(acc1.x); pr[48] = (bf16)f2bf(acc1.y); pr[80] = (bf16)f2bf(acc1.z); pr[112] = (bf16)f2bf(acc1.w);
        }
    }
    __syncthreads();
}

template <int MODE>
__device__ __forceinline__ void naive_lin_unit(KP kp, int layer, int b, int hd, int dir, LAS unsigned char* lds, int tid) {
    constexpr int DV = MODE == 0 ? 128 : 256, NPART = 512 / DV, ND = 128 / NPART;
    LAS float* qs = (LAS float*)lds; LAS float* ks = qs + 256; LAS float* dsv = ks + 256; LAS float* po = dsv + 256;
    const int e = tid % DV, part = tid / DV, d0 = part * ND;
    const bf16* P = (const bf16*)(kp->ws + WS_P); bf16* RAW = (bf16*)(kp->ws + WS_RAW) + (size_t)dir * MROWS * DM;
    float s[ND];
#pragma unroll
    for (int i = 0; i < ND; ++i) s[i] = 0.f;
    const int qcol = (MODE == 0 ? CA_Q : MODE == 1 ? CB_Q : CD_Q) + hd * 128;
    const int kcol = (MODE == 0 ? (dir ? CA_FB : CA_FF) : MODE == 1 ? CB_K : CD_K) + hd * 128;
    const int vcol = (MODE == 0 ? CA_I : MODE == 1 ? CB_V : CD_V) + hd * DV;
    const int ocol = (MODE == 0 ? 0 : MODE == 1 ? 1024 : 3072) + hd * DV;
    const int d = tid & 127;
    float lbv = 0.f, bias = 0.f, gam = 0.f, frq = 0.f, wg[16];
#pragma unroll
    for (int r = 0; r < 16; ++r) wg[r] = 0.f;
    if (tid < 128) {
        if (MODE == 0) { if (layer == 1) { const float* lbl = kp->in[8]; lbv = 1.0f / (1.0f + expf(-(lbl[(2 + dir) * 1024 + hd * 128 + d] - lbl[dir * 1024 + hd * 128 + d]))); } }
        if (MODE == 1) { const float* w = kp->in[10] + (size_t)(layer * 2 + dir) * 16 * 512 + hd * 128 + d;
#pragma unroll
            for (int r = 0; r < 16; ++r) wg[r] = w[r * 512];
            bias = kp->in[11][(layer * 2 + dir) * 512 + hd * 128 + d]; }
        if (MODE == 2) { gam = 1.0f / (1.0f + expf(-kp->in[23][(layer * 2 + dir) * 4 + hd])); frq = exp2f(-(float)(d & 31) * (13.287712379549449f / 32.0f)); }
    }
    for (int p = 0; p < LTOT; ++p) {
        const int l = dir ? flip_pos(p) : p; const size_t row = (size_t)b * LTOT + l; const bf16* pr = P + row * NP; const int buf = (p & 1) * 128;
        if (tid < 128) {
            float q, key, dec;
            if (MODE == 0) { q = bf2f(pr[qcol + d]); const float z = bf2f(pr[kcol + d]); const float sg = 1.0f / (1.0f + __expf(-z)), sgn = 1.0f / (1.0f + __expf(z));
                dec = fmaxf(lbv + (1.0f - lbv) * sg, 1e-6f); key = (1.0f - lbv) * sgn; }
            if (MODE == 1) { q = bf2f(pr[qcol + d]) * 0.08838834764831845f; key = bf2f(pr[kcol + d]); float x = bias;
#pragma unroll
                for (int r = 0; r < 16; ++r) x += bf2f(pr[CB_LF + dir * 16 + r]) * wg[r];
                dec = __expf(log_sigmoidf_(x) * (1.0f / 16.0f)); }
            if (MODE == 2) { const int j = d & 63; const float q1 = bf2f(pr[qcol + j]), q2 = bf2f(pr[qcol + j + 64]), k1 = bf2f(pr[kcol + j]), k2 = bf2f(pr[kcol + j + 64]);
                float cs = 1.f, sn = 0.f;
                if (l >= NCTX) { const int t = l - NCTX; const float pos = (float)((j < 32) ? (t >> 6) : (t & 63)); sincos_acc(pos * frq, sn, cs); }
                q = ((d < 64) ? (q1 * cs - q2 * sn) : (q1 * sn + q2 * cs)) * 0.08838834764831845f; key = (d < 64) ? (k1 * cs - k2 * sn) : (k1 * sn + k2 * cs); dec = gam; }
            qs[buf + d] = q; ks[buf + d] = key; dsv[buf + d] = dec;
        }
        const float v = bf2f(pr[vcol + e]);
        __syncthreads();
        float acc = 0.f;
#pragma unroll
        for (int i = 0; i < ND; ++i) { s[i] = dsv[buf + d0 + i] * s[i] + ks[buf + d0 + i] * v; acc += s[i] * qs[buf + d0 + i]; }
        po[part * 256 + e] = acc;
        __syncthreads();
        if (part == 0) { float tot = 0.f;
#pragma unroll
            for (int pp = 0; pp < NPART; ++pp) tot += po[pp * 256 + e];
            RAW[row * DM + ocol + e] = (bf16)f2bf(tot); }
    }
    __syncthreads();
}
constexpr int S5_BUS = 132, S5_XS = 136, S5_WAVE_BYTES = 16 * S5_BUS * 4 + 16 * S5_XS * 2;
__device__ __forceinline__ void s5_coef(KP kp, int ld, int g, int p, float& lbr, float& lbi, float& cr, float& ci) {
    const float lre = fminf(kp->in[13][(ld * 64 + g) * 64 + p], -1e-4f), lim = kp->in[14][(ld * 64 + g) * 64 + p];
    const float dt = expf(kp->in[15][ld * 64 + g]);
    const float xr_ = lre * dt, ang = lim * dt;
    float sn, cs, snh, csh; sincos_acc(ang, sn, cs); sincos_acc(0.5f * ang, snh, csh);
    const float mag = expf(xr_), em1 = expm1f(xr_);
    lbr = mag * cs; lbi = mag * sn;
    const float nr = em1 * cs - 2.0f * snh * snh, ni = mag * sn;
    const float den = lre * lre + lim * lim;
    cr = (nr * lre + ni * lim) / den; ci = (ni * lre - nr * lim) / den;
}
__device__ __forceinline__ void s5_unit(KP kp, int layer, int b, int g, int dir, LAS unsigned char* wlds, int lane) {
    typedef short bf16x8_ __attribute__((ext_vector_type(8)));
    typedef float f32x2s __attribute__((ext_vector_type(2)));
    const int ld = layer * 2 + dir; const int ii = lane & 15, q = lane >> 4;
    LAS float* BU = (LAS float*)wlds; LAS bf16* X = (LAS bf16*)(wlds + 16 * S5_BUS * 4);
    float lbr, lbi;
    { float cr_, ci_; s5_coef(kp, ld, g, lane, lbr, lbi, cr_, ci_); }
    bf16x8_ bA[8];
    {
        const float* bre = kp->in[16] + (size_t)(ld * 64 + g) * 64 * 16; const float* bim = kp->in[17] + (size_t)(ld * 64 + g) * 64 * 16;
#pragma unroll
        for (int mt = 0; mt < 8; ++mt) { const int p = 8 * mt + (ii >> 1); float l0, l1, cr, ci; s5_coef(kp, ld, g, p, l0, l1, cr, ci);
#pragma unroll
            for (int j = 0; j < 8; ++j) { const int h = 8 * (q & 1) + j; const float br = bre[p * 16 + h], bi = bim[p * 16 + h];
                const float v = (ii & 1) ? (cr * bi + ci * br) : (cr * br - ci * bi);
                const unsigned hv = f2bf(v); const unsigned lv = f2bf(v - __builtin_bit_cast(float, hv << 16));
                bA[mt][j] = (short)(q < 2 ? hv : lv); } }
    }
    bf16x8_ cA[4];
    {
        const float* cre = kp->in[18] + (size_t)(ld * 64 + g) * 16 * 64 + ii * 64; const float* cim = kp->in[19] + (size_t)(ld * 64 + g) * 16 * 64 + ii * 64;
#pragma unroll
        for (int ks = 0; ks < 4; ++ks)
#pragma unroll
            for (int j = 0; j < 8; ++j) { const int p = 16 * ks + 4 * q + (j >> 1); const float v = (j & 1) ? -cim[p] : cre[p]; cA[ks][j] = (short)f2bf(v); }
    }
    const bf16* P = (const bf16*)(kp->ws + WS_P); bf16* RAW = (bf16*)(kp->ws + WS_RAW) + (size_t)dir * MROWS * DM;
    float xr = 0.f, xi = 0.f;
    v4u ua, un;
#define S5_LOADA(dst, ti_) do { const int ps_ = 16 * (ti_) + ii; const int l_ = dir ? flip_pos(ps_) : ps_; dst = *(const v4u*)(P + p_off((size_t)b * LTOT + l_, CC_U + g * 16 + 8 * (q & 1))); } while (0)
    v4u un2;
    S5_LOADA(ua, 0); S5_LOADA(un, 1); un2 = un;
    for (int ti = 0; ti < LTOT / 16; ++ti) {
        if (ti + 2 < LTOT / 16) S5_LOADA(un2, ti + 2);
        const bf16x8_ uf = __builtin_bit_cast(bf16x8_, ua);
#pragma unroll
        for (int mt = 0; mt < 8; ++mt) { const f32x4 c4 = __builtin_amdgcn_mfma_f32_16x16x32_bf16(bA[mt], uf, ((f32x4){0.f, 0.f, 0.f, 0.f}), 0, 0, 0);
            *(LAS f32x4*)(BU + ii * S5_BUS + 16 * mt + 4 * q) = c4; }
        asm volatile("s_waitcnt lgkmcnt(0)" ::: "memory");
        f32x2s bu[16];
#pragma unroll
        for (int t = 0; t < 16; ++t) bu[t] = *(const LAS f32x2s*)(BU + t * S5_BUS + 2 * lane);
#pragma unroll
        for (int t = 0; t < 16; ++t) { const float nxr = lbr * xr - lbi * xi + bu[t].x, nxi = lbr * xi + lbi * xr + bu[t].y; xr = nxr; xi = nxi;
            *(LAS unsigned*)(X + t * S5_XS + 2 * lane) = cvtpk(xr, xi); }
        asm volatile("s_waitcnt lgkmcnt(0)" ::: "memory");
        f32x4 y = (f32x4){0.f, 0.f, 0.f, 0.f};
#pragma unroll
        for (int ks = 0; ks < 4; ++ks) { const bf16x8_ xb_ = *(const LAS bf16x8_*)(X + ii * S5_XS + 32 * ks + 8 * q); y = __builtin_amdgcn_mfma_f32_16x16x32_bf16(cA[ks], xb_, y, 0, 0, 0); }
        {
            const int ps_ = 16 * ti + ii; const int l_ = dir ? flip_pos(ps_) : ps_;
            v2u ov; ov.x = cvtpk(y.x, y.y); ov.y = cvtpk(y.z, y.w);
            *(v2u*)(RAW + ((size_t)b * LTOT + l_) * DM + 2048 + g * 16 + 4 * q) = ov;
        }
        asm volatile("s_waitcnt lgkmcnt(0)" ::: "memory");
        ua = un; un = un2;
    }
#undef S5_LOADA
}
typedef short bf16x8 __attribute__((ext_vector_type(8)));
#define MFMA16(a, b, c) __builtin_amdgcn_mfma_f32_16x16x32_bf16((a), (b), (c), 0, 0, 0)
constexpr int LA_SQ = 136, LA_SJ = 72;
constexpr int LA_QT = 0, LA_KT = LA_QT + 64 * LA_SQ * 2, LA_VR = LA_KT + 64 * LA_SQ * 2, LA_SB = LA_VR + 64 * LA_SQ * 2,
              LA_STT = LA_SB + 64 * LA_SJ * 2, LA_VEC = LA_STT + 128 * LA_SQ * 2, LA_AUX = LA_VEC + 256 * 4, LA_END = LA_AUX + 2 * 64 * 33 * 4;
static_assert(LA_END <= LDSCTL_OFF, "LA LDS map");
typedef short s16x4 __attribute__((ext_vector_type(4)));

__device__ __forceinline__ bf16x8 trfrag(const LAS bf16* base, int stride, int k0, int c0, int lane) {
    const LAS bf16* a = base + (k0 + 8 * (lane >> 4) + ((lane & 15) >> 2)) * stride + c0 + 4 * (lane & 3);
    const s16x4 lo = __builtin_amdgcn_ds_read_tr16_b64_v4i16((LAS s16x4*)a), hi = __builtin_amdgcn_ds_read_tr16_b64_v4i16((LAS s16x4*)(a + 4 * stride));
    return __builtin_shufflevector(lo, hi, 0, 1, 2, 3, 4, 5, 6, 7);
}
__device__ __forceinline__ bf16x8 ldfrag(const LAS bf16* base, int stride, int row0, int k0, int lane) {
    return *(const LAS bf16x8*)(base + (row0 + (lane & 15)) * stride + k0 + 8 * (lane >> 4));
}
template <int MODE>
__device__ __forceinline__ void la_unit(KP kp, int layer, int b, int hd, int dir, int half, LAS unsigned char* lds, int tid, int lane, int w) {
    LAS bf16* QT = (LAS bf16*)(lds + LA_QT); LAS bf16* KT = (LAS bf16*)(lds + LA_KT); LAS bf16* Vr = (LAS bf16*)(lds + LA_VR);
    LAS bf16* Sb = (LAS bf16*)(lds + LA_SB); LAS bf16* Stt = (LAS bf16*)(lds + LA_STT);
    LAS float* eref = (LAS float*)(lds + LA_VEC); LAS float* elast = eref + 128;
    LAS float* aux = (LAS float*)(lds + LA_AUX);
    const bf16* P = (const bf16*)(kp->ws + WS_P); bf16* RAW = (bf16*)(kp->ws + WS_RAW) + (size_t)dir * MROWS * DM;
    const int qcol = (MODE == 0 ? CA_Q : MODE == 1 ? CB_Q : CD_Q) + hd * 128;
    const int kcol = (MODE == 0 ? (dir ? CA_FB : CA_FF) : MODE == 1 ? CB_K : CD_K) + hd * 128;
    const int vcol = (MODE == 0 ? CA_I + hd * 128 : (MODE == 1 ? CB_V : CD_V) + hd * 256 + half * 128) + 16 * w;
    const int ocol = (MODE == 0 ? hd * 128 : (MODE == 1 ? 1024 : 3072) + hd * 256 + half * 128);
    const int c0 = 16 * w;
    const int j0 = 16 * (w & 3);
    float lg = 0.f;
    bf16x8 wA = (bf16x8){0, 0, 0, 0, 0, 0, 0, 0}; f32x4 bias4 = (f32x4){0.f, 0.f, 0.f, 0.f};
    if (MODE == 0) { const float* lbl = kp->in[8];
        if (tid < 128) { float v = 0.f; if (layer == 1) v = 1.0f / (1.0f + expf(-(lbl[(2 + dir) * 1024 + hd * 128 + tid] - lbl[dir * 1024 + hd * 128 + tid]))); aux[tid] = v; aux[128 + tid] = 1.0f - v; } }
    if (MODE == 1) { const float* wg = kp->in[10] + (size_t)(layer * 2 + dir) * 16 * 512 + hd * 128 + c0 + (lane & 15); const float* bg = kp->in[11] + (layer * 2 + dir) * 512 + hd * 128 + c0 + 4 * (lane >> 4);
        const int q_ = lane >> 4;
#pragma unroll
        for (int j = 0; j < 8; ++j) { const float wf = wg[(8 * (q_ & 1) + j) * 512]; const unsigned hi = f2bf(wf); const unsigned lo = f2bf(wf - __builtin_bit_cast(float, hi << 16)); wA[j] = (short)(q_ < 2 ? hi : lo); }
        bias4 = (f32x4){bg[0], bg[1], bg[2], bg[3]}; }
    if (MODE == 2) { lg = log_sigmoidf_(kp->in[23][(layer * 2 + dir) * 4 + hd]);
        for (int i = tid; i < 64 * 32; i += 512) { const int pos = i >> 5, jj = i & 31; float sn, cs; sincos_acc((float)pos * exp2f(-(float)jj * (13.287712379549449f / 32.0f)), sn, cs); aux[pos * 33 + jj] = cs; aux[64 * 33 + pos * 33 + jj] = sn; }
        if (tid < 128) { eref[tid] = expf(32.f * lg); elast[tid] = expf(32.f * lg); } }
    f32x4 st[8];
#pragma unroll
    for (int e = 0; e < 8; ++e) st[e] = (f32x4){0.f, 0.f, 0.f, 0.f};
    v4u pa[2], pb[2], pg[4], pv[2];
    pg[0] = pg[1] = pg[2] = pg[3] = (v4u){0u, 0u, 0u, 0u};
#define LA_PREFETCH(n) do { const int p_ = 64 * (n) + lane; const int l_ = dir ? flip_pos(p_) : p_; const bf16* pr_ = P + ((size_t)b * LTOT + l_) * NP; \
        if (MODE == 2) { const int xc_ = (w < 4 ? qcol : kcol) + j0; pa[0] = *(const v4u*)(pr_ + xc_); pa[1] = *(const v4u*)(pr_ + xc_ + 8); pb[0] = *(const v4u*)(pr_ + xc_ + 64); pb[1] = *(const v4u*)(pr_ + xc_ + 72); } \
        else { pa[0] = *(const v4u*)(pr_ + qcol + c0); pa[1] = *(const v4u*)(pr_ + qcol + c0 + 8); pb[0] = *(const v4u*)(pr_ + kcol + c0); pb[1] = *(const v4u*)(pr_ + kcol + c0 + 8); } \
        if (MODE == 1) { _Pragma("unroll") for (int nt_ = 0; nt_ < 4; ++nt_) { const int p2_ = 64 * (n) + 16 * nt_ + (lane & 15); const int l2_ = dir ? flip_pos(p2_) : p2_; \
            pg[nt_] = *(const v4u*)(P + ((size_t)b * LTOT + l2_) * NP + CB_LF + dir * 16 + 8 * ((lane >> 4) & 1)); } } \
        pv[0] = *(const v4u*)(pr_ + vcol); pv[1] = *(const v4u*)(pr_ + vcol + 8); } while (0)
    LA_PREFETCH(0);
    __syncthreads();
    const int it = w >> 1;
    for (int n = 0; n < LTOT / 64; ++n) {
        {
            float xa[16], xb[16];
            unpack8(pa[0], xa); unpack8(pa[1], xa + 8); unpack8(pb[0], xb); unpack8(pb[1], xb + 8);
            if (MODE == 2) {
                const int p_ = 64 * n + lane; const int l_ = dir ? flip_pos(p_) : p_;
                const bool lat = l_ >= NCTX; const int t_ = l_ - NCTX; const int pos = (j0 < 32) ? (t_ >> 6) : (t_ & 63);
                const float dq = (w < 4) ? __expf((float)(lane - 31) * lg) * 0.08838834764831845f : __expf((float)(31 - lane) * lg);
                float o1[16], o2[16];
#pragma unroll
                for (int c = 0; c < 16; ++c) { float cs = 1.f, sn = 0.f; if (lat) { cs = aux[pos * 33 + ((j0 + c) & 31)]; sn = aux[64 * 33 + pos * 33 + ((j0 + c) & 31)]; }
                    o1[c] = (xa[c] * cs - xb[c] * sn) * dq; o2[c] = (xa[c] * sn + xb[c] * cs) * dq; }
                LAS bf16* T = (w < 4) ? QT : KT;
                *(LAS v4u*)(T + lane * LA_SQ + j0) = pack8c(o1); *(LAS v4u*)(T + lane * LA_SQ + j0 + 8) = pack8c(o1 + 8);
                *(LAS v4u*)(T + lane * LA_SQ + 64 + j0) = pack8c(o2); *(LAS v4u*)(T + lane * LA_SQ + 64 + j0 + 8) = pack8c(o2 + 8);
            } else {
                float g[16];
                if (MODE == 0) {
#pragma unroll
                    for (int c = 0; c < 16; ++c) { const float z = xb[c]; const float e = __expf(-fabsf(z)); const float r = __builtin_amdgcn_rcpf(1.0f + e);
                        const float sp = z >= 0.f ? r : e * r, sn = z >= 0.f ? e * r : r;
                        const float lb_ = aux[c0 + c], om_ = aux[128 + c0 + c];
                        g[c] = __logf(fmaxf(lb_ + om_ * sp, 1e-6f)); xb[c] = om_ * sn; }
                } else {
                    LAS float* XL = (LAS float*)(lds + LA_STT);
#pragma unroll
                    for (int nt = 0; nt < 4; ++nt) { f32x4 x = MFMA16(wA, __builtin_bit_cast(bf16x8, pg[nt]), ((f32x4){0.f, 0.f, 0.f, 0.f})); x = x + bias4;
                        f32x4 gg; gg.x = (fminf(x.x, 0.f) - __logf(1.0f + __expf(-fabsf(x.x)))) * (1.0f / 16.0f); gg.y = (fminf(x.y, 0.f) - __logf(1.0f + __expf(-fabsf(x.y)))) * (1.0f / 16.0f);
                        gg.z = (fminf(x.z, 0.f) - __logf(1.0f + __expf(-fabsf(x.z)))) * (1.0f / 16.0f); gg.w = (fminf(x.w, 0.f) - __logf(1.0f + __expf(-fabsf(x.w)))) * (1.0f / 16.0f);
                        *(LAS f32x4*)(XL + (16 * nt + (lane & 15)) * 132 + c0 + 4 * (lane >> 4)) = gg; }
                    asm volatile("s_waitcnt lgkmcnt(0)" ::: "memory");
#pragma unroll
                    for (int c4 = 0; c4 < 4; ++c4) { const f32x4 t = *(const LAS f32x4*)(XL + lane * 132 + c0 + 4 * c4); g[4 * c4] = t.x; g[4 * c4 + 1] = t.y; g[4 * c4 + 2] = t.z; g[4 * c4 + 3] = t.w; }
#pragma unroll
                    for (int c = 0; c < 16; ++c) xa[c] *= 0.08838834764831845f;
                }
#pragma unroll
                for (int c = 0; c < 16; ++c) { const float bc = lane_scan(g[c], lane); const float br = __shfl(bc, 31), bl = __shfl(bc, 63);
                    xa[c] = xa[c] * __expf(bc - br); xb[c] = xb[c] * __expf(br - bc);
                    if (lane == 0) { eref[c0 + c] = __expf(br); elast[c0 + c] = __expf(bl - br); } }
                *(LAS v4u*)(QT + lane * LA_SQ + c0) = pack8c(xa); *(LAS v4u*)(QT + lane * LA_SQ + c0 + 8) = pack8c(xa + 8);
                *(LAS v4u*)(KT + lane * LA_SQ + c0) = pack8c(xb); *(LAS v4u*)(KT + lane * LA_SQ + c0 + 8) = pack8c(xb + 8);
            }
            *(LAS v4u*)(Vr + lane * LA_SQ + 16 * w) = pv[0]; *(LAS v4u*)(Vr + lane * LA_SQ + 16 * w + 8) = pv[1];
        }
        __syncthreads();
        bf16x8 qa[4];
        {
            const f32x4 er = *(const LAS f32x4*)(eref + 16 * w + 4 * (lane >> 4));
#pragma unroll
            for (int e = 0; e < 8; ++e) { st[e] = st[e] * er;
                v2u o; o.x = cvtpk(st[e].x, st[e].y); o.y = cvtpk(st[e].z, st[e].w);
                *(LAS v2u*)(Stt + (16 * e + (lane & 15)) * LA_SQ + 16 * w + 4 * (lane >> 4)) = o; }
#pragma unroll
            for (int ks = 0; ks < 4; ++ks) qa[ks] = ldfrag(QT, LA_SQ, 16 * it, 32 * ks, lane);
#pragma unroll
            for (int t = 0; t < 2; ++t) { const int jt = 2 * (w & 1) + t; f32x4 s = (f32x4){0.f, 0.f, 0.f, 0.f};
                if (jt <= it) {
#pragma unroll
                    for (int ks = 0; ks < 4; ++ks) s = MFMA16(ldfrag(KT, LA_SQ, 16 * jt, 32 * ks, lane), qa[ks], s); }
                const int i = 16 * it + (lane & 15), jb = 16 * jt + 4 * (lane >> 4);
                v2u o; o.x = cvtpk(jb <= i ? s.x : 0.f, jb + 1 <= i ? s.y : 0.f); o.y = cvtpk(jb + 2 <= i ? s.z : 0.f, jb + 3 <= i ? s.w : 0.f);
                *(LAS v2u*)(Sb + i * LA_SJ + jb) = o; }
        }
        __syncthreads();
        if (n + 1 < LTOT / 64) LA_PREFETCH(n + 1);
        {
            const bf16x8 sb0 = ldfrag(Sb, LA_SJ, 16 * it, 0, lane), sb1 = ldfrag(Sb, LA_SJ, 16 * it, 32, lane);
            const int p_ = 64 * n + 16 * it + (lane & 15); const int l_ = dir ? flip_pos(p_) : p_;
            bf16* orow = RAW + ((size_t)b * LTOT + l_) * DM + ocol + 4 * (lane >> 4);
#pragma unroll
            for (int t = 0; t < 4; ++t) { const int et = 4 * (w & 1) + t; f32x4 o = (f32x4){0.f, 0.f, 0.f, 0.f};
                o = MFMA16(trfrag(Vr, LA_SQ, 0, 16 * et, lane), sb0, o);
                if (it >= 2) o = MFMA16(trfrag(Vr, LA_SQ, 32, 16 * et, lane), sb1, o);
#pragma unroll
                for (int ks = 0; ks < 4; ++ks) o = MFMA16(ldfrag(Stt, LA_SQ, 16 * et, 32 * ks, lane), qa[ks], o);
                v2u ov; ov.x = cvtpk(o.x, o.y); ov.y = cvtpk(o.z, o.w);
                *(v2u*)(orow + 16 * et) = ov; }
            const bf16x8 ka0 = trfrag(KT, LA_SQ, 0, 16 * w, lane), ka1 = trfrag(KT, LA_SQ, 32, 16 * w, lane);
            const f32x4 el = *(const LAS f32x4*)(elast + 16 * w + 4 * (lane >> 4));
#pragma unroll
            for (int e = 0; e < 8; ++e) { st[e] = MFMA16(ka0, trfrag(Vr, LA_SQ, 0, 16 * e, lane), st[e]); st[e] = MFMA16(ka1, trfrag(Vr, LA_SQ, 32, 16 * e, lane), st[e]); st[e] = st[e] * el; }
        }
        __syncthreads();
    }
#undef LA_PREFETCH
}
constexpr int L2_IMG = 64 * LA_SQ * 2;
constexpr int L2_BUF = 3 * L2_IMG;
constexpr int L2_SB = 2 * L2_BUF, L2_VEC = L2_SB + 64 * LA_SJ * 2, L2_AUX = L2_VEC + 2 * 256 * 4, L2_END = L2_AUX + 4 * 64 * 20 * 4;
static_assert(L2_END <= LDSCTL_OFF && 2 * 64 * 33 * 4 <= 4 * 64 * 20 * 4, "LA2 LDS map");
constexpr float LOG2E_F = 1.4426950408889634f;
__device__ __forceinline__ float ex2(float x) { return __builtin_amdgcn_exp2f(x); }
__device__ __forceinline__ float lg2(float x) { return __builtin_amdgcn_logf(x); }
__device__ __forceinline__ float rdlane(float x, int l) { return __builtin_bit_cast(float, __builtin_amdgcn_readlane(__builtin_bit_cast(int, x), l)); }
#define L2_BAR() do { asm volatile("s_waitcnt lgkmcnt(0)" ::: "memory"); __builtin_amdgcn_s_barrier(); asm volatile("" ::: "memory"); } while (0)

template <int MODE>
__device__ __forceinline__ void la_unit2(KP kp, int layer, int b, int hd, int dir, int half, LAS unsigned char* lds, int tid, int lane, int w) {
    LAS bf16* Sb = (LAS bf16*)(lds + L2_SB);
    LAS float* vec = (LAS float*)(lds + L2_VEC);
    LAS float* aux = (LAS float*)(lds + L2_AUX);
    const bf16* P = (const bf16*)(kp->ws + WS_P); bf16* RAW = (bf16*)(kp->ws + WS_RAW) + (size_t)dir * MROWS * DM;
    const bf16* Pb = P + (size_t)((MODE == 0 ? 0 : MODE == 1 ? 10 : 20) + hd) * P_BLK_ELEMS;
    const int qcol = 0;
    const int kcol = (MODE == 0 ? (dir ? 256 : 128) : 128);
    const int vcol0 = (MODE == 0 ? 384 : 256 + half * 128);
    const int ocol = (MODE == 0 ? hd * 128 : (MODE == 1 ? 1024 : 3072) + hd * 256 + half * 128);
    const int NCH = LTOT / 64;
    float lg = 0.f;
    if (MODE == 0) { const float* lbl = kp->in[8];
        if (tid < 128) { float v = 0.f; if (layer == 1) v = 1.0f / (1.0f + expf(-(lbl[(2 + dir) * 1024 + hd * 128 + tid] - lbl[dir * 1024 + hd * 128 + tid]))); aux[tid] = v; aux[128 + tid] = 1.0f - v; } }
    if (MODE == 2) { lg = log_sigmoidf_(kp->in[23][(layer * 2 + dir) * 4 + hd]) * LOG2E_F;
        for (int i = tid; i < 64 * 32; i += 512) { const int pos = i >> 5, jj = i & 31; float sn, cs; sincos_acc((float)pos * exp2f(-(float)jj * (13.287712379549449f / 32.0f)), sn, cs); aux[pos * 33 + jj] = cs; aux[64 * 33 + pos * 33 + jj] = sn; }
        if (tid < 256) { vec[tid] = exp2f(32.f * lg); vec[256 + tid] = exp2f(32.f * lg); } }
    __syncthreads();
    if (w < 4) {
        const int pw = w;
        const int cbase = 32 * pw;
        const int isk = pw >> 1, jb = 32 * (pw & 1);
        bf16x8 wA[2]; f32x4 bias4[2];
        wA[0] = wA[1] = (bf16x8){0, 0, 0, 0, 0, 0, 0, 0}; bias4[0] = bias4[1] = (f32x4){0.f, 0.f, 0.f, 0.f};
        if (MODE == 1) {
#pragma unroll
            for (int grp = 0; grp < 2; ++grp) { const int c0 = cbase + 16 * grp;
                const float* wg = kp->in[10] + (size_t)(layer * 2 + dir) * 16 * 512 + hd * 128 + c0 + (lane & 15); const float* bg = kp->in[11] + (layer * 2 + dir) * 512 + hd * 128 + c0 + 4 * (lane >> 4);
                const int q_ = lane >> 4;
#pragma unroll
                for (int j = 0; j < 8; ++j) { const float wf = wg[(8 * (q_ & 1) + j) * 512]; const unsigned hi = f2bf(wf); const unsigned lo = f2bf(wf - __builtin_bit_cast(float, hi << 16)); wA[grp][j] = (short)(q_ < 2 ? hi : lo); }
                bias4[grp] = (f32x4){bg[0], bg[1], bg[2], bg[3]}; }
        }
        v4u pa[4], pb[4], pv[4], pg[4], na[4], nb_[4], nv[4], ng[4];
        pg[0] = pg[1] = pg[2] = pg[3] = (v4u){0u, 0u, 0u, 0u}; ng[0] = ng[1] = ng[2] = ng[3] = (v4u){0u, 0u, 0u, 0u};
#define L2_PREFETCH(n, pa, pb, pv, pg) do { const int p_ = 64 * (n) + lane; const int l_ = dir ? flip_pos(p_) : p_; const bf16* pr_ = Pb + ((size_t)b * LTOT + l_) * 512; \
            const int ac_ = (MODE == 2) ? ((isk ? kcol : qcol) + jb) : (qcol + cbase); const int bc_ = (MODE == 2) ? ac_ + 64 : (kcol + cbase); \
            _Pragma("unroll") for (int k_ = 0; k_ < 4; ++k_) { pa[k_] = *(const v4u*)(pr_ + ac_ + 8 * k_); pb[k_] = *(const v4u*)(pr_ + bc_ + 8 * k_); pv[k_] = *(const v4u*)(pr_ + vcol0 + 32 * pw + 8 * k_); } \
            if (MODE == 1) { _Pragma("unroll") for (int nt_ = 0; nt_ < 4; ++nt_) { const int p2_ = 64 * (n) + 16 * nt_ + (lane & 15); const int l2_ = dir ? flip_pos(p2_) : p2_; \
                pg[nt_] = *(const v4u*)(P + P_LRB_OFF + ((size_t)b * LTOT + l2_) * 32 + dir * 16 + 8 * ((lane >> 4) & 1)); } } } while (0)
#define L2_GROUP(n, bi, grp) do { \
            LAS bf16* QT_ = (LAS bf16*)(lds + (bi) * L2_BUF); LAS bf16* KT_ = QT_ + 64 * LA_SQ; LAS float* ev_ = vec + (bi) * 256; \
            float xa[16], xb[16]; unpack8(pa[2 * (grp)], xa); unpack8(pa[2 * (grp) + 1], xa + 8); unpack8(pb[2 * (grp)], xb); unpack8(pb[2 * (grp) + 1], xb + 8); \
            if (MODE == 2) { \
                const int p_ = 64 * (n) + lane; const int l_ = dir ? flip_pos(p_) : p_; const bool lat = l_ >= NCTX; const int t_ = l_ - NCTX; const int pos = (jb < 32) ? (t_ >> 6) : (t_ & 63); \
                const float dq = isk ? ex2((float)(31 - lane) * lg) : ex2((float)(lane - 31) * lg) * 0.08838834764831845f; \
                const int j0_ = jb + 16 * (grp); float o1[16], o2[16]; \
                _Pragma("unroll") for (int c = 0; c < 16; ++c) { float cs = 1.f, sn = 0.f; if (lat) { cs = aux[pos * 33 + ((j0_ + c) & 31)]; sn = aux[64 * 33 + pos * 33 + ((j0_ + c) & 31)]; } \
                    o1[c] = (xa[c] * cs - xb[c] * sn) * dq; o2[c] = (xa[c] * sn + xb[c] * cs) * dq; } \
                LAS bf16* T_ = isk ? KT_ : QT_; \
                *(LAS v4u*)(T_ + lane * LA_SQ + j0_) = pack8c(o1); *(LAS v4u*)(T_ + lane * LA_SQ + j0_ + 8) = pack8c(o1 + 8); \
                *(LAS v4u*)(T_ + lane * LA_SQ + 64 + j0_) = pack8c(o2); *(LAS v4u*)(T_ + lane * LA_SQ + 64 + j0_ + 8) = pack8c(o2 + 8); \
            } else { \
                const int c0_ = cbase + 16 * (grp); float g[16]; \
                if (MODE == 0) { \
                    _Pragma("unroll") for (int c = 0; c < 16; ++c) { const float r = __builtin_amdgcn_rcpf(1.0f + ex2(-LOG2E_F * xb[c]));        \
                        const float lb_ = aux[c0_ + c], om_ = aux[128 + c0_ + c]; \
                        g[c] = lg2(fmaxf(fmaf(om_, r, lb_), 1e-6f)); xb[c] = fmaf(-om_, r, om_); }                                          \
                } else { \
                    LAS float* XL = aux + pw * (64 * 20);                 \
                    _Pragma("unroll") for (int nt = 0; nt < 4; ++nt) { f32x4 x = MFMA16(wA[grp], __builtin_bit_cast(bf16x8, pg[nt]), ((f32x4){0.f, 0.f, 0.f, 0.f})); x = x + bias4[grp]; \
                        f32x4 gg; gg.x = (fminf(x.x, 0.f) * LOG2E_F - lg2(1.0f + ex2(-LOG2E_F * fabsf(x.x)))) * (1.0f / 16.0f); gg.y = (fminf(x.y, 0.f) * LOG2E_F - lg2(1.0f + ex2(-LOG2E_F * fabsf(x.y)))) * (1.0f / 16.0f); \
                        gg.z = (fminf(x.z, 0.f) * LOG2E_F - lg2(1.0f + ex2(-LOG2E_F * fabsf(x.z)))) * (1.0f / 16.0f); gg.w = (fminf(x.w, 0.f) * LOG2E_F - lg2(1.0f + ex2(-LOG2E_F * fabsf(x.w)))) * (1.0f / 16.0f); \
                        *(LAS f32x4*)(XL + (16 * nt + (lane & 15)) * 20 + 4 * (lane >> 4)) = gg; } \
                    asm volatile("s_waitcnt lgkmcnt(0)" ::: "memory"); \
                    _Pragma("unroll") for (int c4 = 0; c4 < 4; ++c4) { const f32x4 t = *(const LAS f32x4*)(XL + lane * 20 + 4 * c4); g[4 * c4] = t.x; g[4 * c4 + 1] = t.y; g[4 * c4 + 2] = t.z; g[4 * c4 + 3] = t.w; } \
                    asm volatile("s_waitcnt lgkmcnt(0)" ::: "memory"); \
                    _Pragma("unroll") for (int c = 0; c < 16; ++c) xa[c] *= 0.08838834764831845f; \
                } \
                float vr_ = 0.f, vl_ = 0.f;                                \
                _Pragma("unroll") for (int c = 0; c < 16; ++c) g[c] += dpp_f<0x111, 0xf>(g[c]);        \
                _Pragma("unroll") for (int c = 0; c < 16; ++c) g[c] += dpp_f<0x112, 0xf>(g[c]); \
                _Pragma("unroll") for (int c = 0; c < 16; ++c) g[c] += dpp_f<0x114, 0xf>(g[c]); \
                _Pragma("unroll") for (int c = 0; c < 16; ++c) g[c] += dpp_f<0x118, 0xf>(g[c]); \
                _Pragma("unroll") for (int c = 0; c < 16; ++c) g[c] += dpp_f<0x142, 0xa>(g[c]); \
                _Pragma("unroll") for (int c = 0; c < 16; ++c) g[c] += dpp_f<0x143, 0xc>(g[c]); \
                _Pragma("unroll") for (int c = 0; c < 16; ++c) { const float bc = g[c]; const float br = rdlane(bc, 31), bl = rdlane(bc, 63); \
                    xa[c] = xa[c] * ex2(bc - br); xb[c] = xb[c] * ex2(br - bc); vr_ = (lane == c) ? br : vr_; vl_ = (lane == c) ? (bl - br) : vl_; } \
                if (lane < 16) { ev_[c0_ + lane] = ex2(vr_); ev_[128 + c0_ + lane] = ex2(vl_); } \
                *(LAS v4u*)(QT_ + lane * LA_SQ + c0_) = pack8c(xa); *(LAS v4u*)(QT_ + lane * LA_SQ + c0_ + 8) = pack8c(xa + 8); \
                *(LAS v4u*)(KT_ + lane * LA_SQ + c0_) = pack8c(xb); *(LAS v4u*)(KT_ + lane * LA_SQ + c0_ + 8) = pack8c(xb + 8); \
            } } while (0)
#define L2_VALUES(bi) do { LAS bf16* VR_ = (LAS bf16*)(lds + (bi) * L2_BUF) + 2 * 64 * LA_SQ; \
            _Pragma("unroll") for (int k_ = 0; k_ < 4; ++k_) *(LAS v4u*)(VR_ + lane * LA_SQ + 32 * pw + 8 * k_) = pv[k_]; } while (0)
        L2_PREFETCH(0, pa, pb, pv, pg);
        L2_PREFETCH(1, na, nb_, nv, ng);
        L2_GROUP(0, 0, 0); L2_GROUP(0, 0, 1); L2_VALUES(0);
#define L2_ROTATE() do { _Pragma("unroll") for (int k_ = 0; k_ < 4; ++k_) { pa[k_] = na[k_]; pb[k_] = nb_[k_]; pv[k_] = nv[k_]; pg[k_] = ng[k_]; } } while (0)
        L2_ROTATE();
        L2_PREFETCH(2, na, nb_, nv, ng);
        L2_BAR();
        for (int n = 0; n < NCH; ++n) {
            const int nb = (n + 1) & 1;
            if (n + 1 < NCH) { L2_GROUP(n + 1, nb, 0); }
            L2_BAR();
            if (n + 1 < NCH) { L2_GROUP(n + 1, nb, 1); L2_VALUES(nb); }
            L2_ROTATE();
            if (n + 3 < NCH) L2_PREFETCH(n + 3, na, nb_, nv, ng);
            L2_BAR();
        }
#undef L2_ROTATE
#undef L2_PREFETCH
#undef L2_GROUP
#undef L2_VALUES
    } else {
        const int cw = w - 4; const int q = lane >> 4, ii = lane & 15;
        f32x4 st[2][8];
#pragma unroll
        for (int et = 0; et < 2; ++et)
#pragma unroll
            for (int dt = 0; dt < 8; ++dt) st[et][dt] = (f32x4){0.f, 0.f, 0.f, 0.f};
        v2u ovb[8]; bf16* oaddr[4];
#pragma unroll
        for (int t = 0; t < 8; ++t) ovb[t] = (v2u){0u, 0u};
#pragma unroll
        for (int t = 0; t < 4; ++t) oaddr[t] = RAW;
        L2_BAR();
        for (int n = 0; n < NCH; ++n) {
            const int bi = n & 1;
            const LAS bf16* QT = (const LAS bf16*)(lds + bi * L2_BUF); const LAS bf16* KT = QT + 64 * LA_SQ; const LAS bf16* Vr = KT + 64 * LA_SQ; const LAS float* ev = vec + bi * 256;
            {
                bf16x8 qa[4];
#pragma unroll
                for (int ks = 0; ks < 4; ++ks) qa[ks] = ldfrag(QT, LA_SQ, 16 * cw, 32 * ks, lane);
#pragma unroll
                for (int jt = 0; jt < 4; ++jt) { f32x4 s = (f32x4){0.f, 0.f, 0.f, 0.f};
                    if (jt <= cw) {
#pragma unroll
                        for (int ks = 0; ks < 4; ++ks) s = MFMA16(ldfrag(KT, LA_SQ, 16 * jt, 32 * ks, lane), qa[ks], s); }
                    const int i = 16 * cw + ii, jbb = 16 * jt + 4 * q;
                    v2u o; o.x = cvtpk(jbb <= i ? s.x : 0.f, jbb + 1 <= i ? s.y : 0.f); o.y = cvtpk(jbb + 2 <= i ? s.z : 0.f, jbb + 3 <= i ? s.w : 0.f);
                    *(LAS v2u*)(Sb + i * LA_SJ + jbb) = o; }
            }
            f32x4 o[2][4];
#pragma unroll
            for (int et = 0; et < 2; ++et)
#pragma unroll
                for (int t = 0; t < 4; ++t) o[et][t] = (f32x4){0.f, 0.f, 0.f, 0.f};
#pragma unroll
            for (int ks = 0; ks < 4; ++ks) {
                const f32x4 e0 = *(const LAS f32x4*)(ev + 32 * ks + 4 * q), e1 = *(const LAS f32x4*)(ev + 32 * ks + 16 + 4 * q);
                bf16x8 sa[2];
#pragma unroll
                for (int et = 0; et < 2; ++et) { st[et][2 * ks] = st[et][2 * ks] * e0; st[et][2 * ks + 1] = st[et][2 * ks + 1] * e1;
                    v4u pk_; pk_.x = cvtpk(st[et][2 * ks].x, st[et][2 * ks].y); pk_.y = cvtpk(st[et][2 * ks].z, st[et][2 * ks].w); pk_.z = cvtpk(st[et][2 * ks + 1].x, st[et][2 * ks + 1].y); pk_.w = cvtpk(st[et][2 * ks + 1].z, st[et][2 * ks + 1].w);
                    sa[et] = __builtin_bit_cast(bf16x8, pk_); }
#pragma unroll
                for (int t = 0; t < 4; ++t) { const LAS bf16* qp = QT + (16 * t + ii) * LA_SQ + 32 * ks + 4 * q;
                    const v2u lo = *(const LAS v2u*)qp, hi = *(const LAS v2u*)(qp + 16);
                    v4u bq; bq.x = lo.x; bq.y = lo.y; bq.z = hi.x; bq.w = hi.y;
                    const bf16x8 qb = __builtin_bit_cast(bf16x8, bq);
                    o[0][t] = MFMA16(sa[0], qb, o[0][t]); o[1][t] = MFMA16(sa[1], qb, o[1][t]); }
            }
            L2_BAR();
            bf16x8 va[2][2];
#pragma unroll
            for (int et = 0; et < 2; ++et)
#pragma unroll
                for (int ks = 0; ks < 2; ++ks) {
                    const LAS bf16* a_ = Vr + (32 * ks + 8 * (lane >> 4) + ((lane & 15) >> 2)) * LA_SQ + 32 * cw + 8 * (lane & 3) + 4 * et;
                    const s16x4 lo_ = __builtin_amdgcn_ds_read_tr16_b64_v4i16((LAS s16x4*)a_), hi_ = __builtin_amdgcn_ds_read_tr16_b64_v4i16((LAS s16x4*)(a_ + 4 * LA_SQ));
                    va[et][ks] = __builtin_shufflevector(lo_, hi_, 0, 1, 2, 3, 4, 5, 6, 7); }
#pragma unroll
            for (int t = 0; t < 4; ++t) {
                const bf16x8 s0 = ldfrag(Sb, LA_SJ, 16 * t, 0, lane);
                o[0][t] = MFMA16(va[0][0], s0, o[0][t]); o[1][t] = MFMA16(va[1][0], s0, o[1][t]);
                if (t >= 2) { const bf16x8 s1 = ldfrag(Sb, LA_SJ, 16 * t, 32, lane); o[0][t] = MFMA16(va[0][1], s1, o[0][t]); o[1][t] = MFMA16(va[1][1], s1, o[1][t]); }
            }
#pragma unroll
            for (int t = 0; t < 4; ++t) { asm volatile("" :: "v"(ovb[2 * t]), "v"(ovb[2 * t + 1]), "v"(oaddr[t])); }
#pragma unroll
            for (int t = 0; t < 4; ++t) {
                const int p_ = 64 * n + 16 * t + ii; const int l_ = dir ? flip_pos(p_) : p_;
                oaddr[t] = RAW + ((size_t)b * LTOT + l_) * DM + ocol + 32 * cw + 8 * q;
                ovb[2 * t].x = cvtpk(o[0][t].x, o[0][t].y); ovb[2 * t].y = cvtpk(o[0][t].z, o[0][t].w);
                ovb[2 * t + 1].x = cvtpk(o[1][t].x, o[1][t].y); ovb[2 * t + 1].y = cvtpk(o[1][t].z, o[1][t].w);
                { v4u w4; w4.x = ovb[2 * t].x; w4.y = ovb[2 * t].y; w4.z = ovb[2 * t + 1].x; w4.w = ovb[2 * t + 1].y; *(v4u*)oaddr[t] = w4; }
            }
#pragma unroll
            for (int dt = 0; dt < 8; ++dt) {
                const bf16x8 k0 = trfrag(KT, LA_SQ, 0, 16 * dt, lane), k1 = trfrag(KT, LA_SQ, 32, 16 * dt, lane);
                const f32x4 el = *(const LAS f32x4*)(ev + 128 + 16 * dt + 4 * q);
#pragma unroll
                for (int et = 0; et < 2; ++et) { st[et][dt] = MFMA16(k0, va[et][0], st[et][dt]); st[et][dt] = MFMA16(k1, va[et][1], st[et][dt]); st[et][dt] = st[et][dt] * el; }
            }
            L2_BAR();
        }
    }
    __syncthreads();
}

#define LA_TIDS() int t2 = threadIdx.x; asm volatile("" : "+v"(t2)); const int ln2 = t2 & 63, wv2 = __builtin_amdgcn_readfirstlane(t2 >> 6)
__device__ __forceinline__ void phase_d(int layer, LAS unsigned char* lds, int bid, int G) {
    for (int u0 = bid; u0 < 256; u0 += G) {
        int u = u0; asm volatile("" : "+s"(u));
        if (u < 64) { LA_TIDS(); la_unit2<0>(KARGS(), layer, u >> 4, (u >> 1) & 7, u & 1, 0, lds, t2, ln2, wv2); }
        else if (u < 128) { LA_TIDS(); const int v = u - 64; la_unit2<1>(KARGS(), layer, v >> 4, (v >> 2) & 3, (v >> 1) & 1, v & 1, lds, t2, ln2, wv2); }
        else if (u < 192) { LA_TIDS(); const int v = u - 128; la_unit2<2>(KARGS(), layer, v >> 4, (v >> 2) & 3, (v >> 1) & 1, v & 1, lds, t2, ln2, wv2); }
        else { LA_TIDS(); const int wu = (u - 192) * 8 + wv2; s5_unit(KARGS(), layer, wu >> 7, (wu >> 1) & 63, wu & 1, lds + wv2 * S5_WAVE_BYTES, ln2); }
    }
}

__device__ __forceinline__ float row16_sum(float x) {
    x += dpp_f<0xB1, 0xf>(x); x += dpp_f<0x4E, 0xf>(x); x += dpp_f<0x141, 0xf>(x); x += dpp_f<0x140, 0xf>(x); return x;
}
__device__ __forceinline__ float row32_sum(float x) { x = row16_sum(x); return x + __shfl_xor(x, 16); }
__device__ __forceinline__ void phase_e(KP kp, int layer, int lane, int wave, int bid, int G) {
    unsigned char* ws = kp->ws;
    const bf16* P = (const bf16*)(ws + WS_P); const bf16* RF = (const bf16*)(ws + WS_RAW); const bf16* RB = RF + (size_t)MROWS * DM;
    bf16* O = (bf16*)(ws + WS_O); bf16* Z = (bf16*)(ws + WS_Z);
    float ga[8], gb[8], gd[8], sd0[8], sd1[8];
    {
        const float* pa_ = kp->in[9] + layer * 128 + 8 * (lane & 15); const float* pb_ = kp->in[12] + layer * 256 + 8 * (lane & 31); const float* pd_ = kp->in[24] + layer * 256 + 8 * (lane & 31);
        const float* ps_ = kp->in[20] + layer * 1024 + 8 * lane;
#pragma unroll
        for (int e = 0; e < 8; ++e) { ga[e] = pa_[e]; gb[e] = pb_[e]; gd[e] = pd_[e]; sd0[e] = ps_[e]; sd1[e] = ps_[512 + e]; }
    }
    const int gw = bid * 8 + wave, NGW = G * 8;
    for (int row = gw; row < MROWS; row += NGW) {
        if (layer == 1 && (row % LTOT) < NCTX) continue;
        const bf16* pr = P + (size_t)row * 512 + 8 * lane; const bf16* rf = RF + (size_t)row * DM + 8 * lane; const bf16* rb = RB + (size_t)row * DM + 8 * lane;
        bf16* orow = O + (size_t)row * DM + 8 * lane; bf16* zrow = Z + (size_t)row * 1024 + 8 * lane;
        v4u f_[8], b_[8], g_[8];
#pragma unroll
        for (int pt = 0; pt < 4; ++pt)
#pragma unroll
            for (int h = 0; h < 2; ++h) { f_[2 * pt + h] = *(const v4u*)(rf + 1024 * pt + 512 * h); b_[2 * pt + h] = *(const v4u*)(rb + 1024 * pt + 512 * h); }
#pragma unroll
        for (int h = 0; h < 2; ++h) { g_[h] = *(const v4u*)(pr + ((CA_G >> 9) + h) * P_BLK_ELEMS); g_[2 + h] = *(const v4u*)(pr + ((CB_G >> 9) + h) * P_BLK_ELEMS); g_[4 + h] = *(const v4u*)(pr + ((CC_U >> 9) + h) * P_BLK_ELEMS); g_[6 + h] = *(const v4u*)(pr + ((CD_G >> 9) + h) * P_BLK_ELEMS); }
#pragma unroll
        for (int h = 0; h < 2; ++h) {
            float x[8], y[8], gt[8];
            unpack8(f_[h], x); unpack8(b_[h], y); unpack8(g_[h], gt);
            float s = 0.f;
#pragma unroll
            for (int e = 0; e < 8; ++e) { x[e] += y[e]; s += x[e] * x[e]; }
            float r = 1.0f / sqrtf(row16_sum(s) * (1.0f / 128.0f) + EPSN);
#pragma unroll
            for (int e = 0; e < 8; ++e) x[e] = x[e] * r * ga[e] * siluf_(gt[e]);
            *(v4u*)(orow + 512 * h) = pack8c(x);
            unpack8(f_[2 + h], x); unpack8(b_[2 + h], y); unpack8(g_[2 + h], gt);
            s = 0.f;
#pragma unroll
            for (int e = 0; e < 8; ++e) { x[e] += y[e]; s += x[e] * x[e]; }
            r = 1.0f / sqrtf(row32_sum(s) * (1.0f / 256.0f) + EPSN);
#pragma unroll
            for (int e = 0; e < 8; ++e) x[e] = x[e] * r * gb[e] * siluf_(gt[e]);
            *(v4u*)(orow + 1024 + 512 * h) = pack8c(x);
            unpack8(f_[6 + h], x); unpack8(b_[6 + h], y); unpack8(g_[6 + h], gt);
            s = 0.f;
#pragma unroll
            for (int e = 0; e < 8; ++e) { x[e] += y[e]; s += x[e]; }
            const float mu = row32_sum(s) * (1.0f / 256.0f);
            s = 0.f;
#pragma unroll
            for (int e = 0; e < 8; ++e) { x[e] -= mu; s += x[e] * x[e]; }
            r = 1.0f / sqrtf(row32_sum(s) * (1.0f / 256.0f) + EPSN);
#pragma unroll
            for (int e = 0; e < 8; ++e) x[e] = x[e] * r * gd[e] * siluf_(gt[e]);
            *(v4u*)(orow + 3072 + 512 * h) = pack8c(x);
            unpack8(f_[4 + h], x); unpack8(b_[4 + h], y); unpack8(g_[4 + h], gt);
#pragma unroll
            for (int e = 0; e < 8; ++e) x[e] = gelu_tanhf_(x[e] + y[e] + (h ? sd1[e] : sd0[e]) * gt[e]);
            *(v4u*)(zrow + 512 * h) = pack8c(x);
        }
    }
}

__device__ __forceinline__ void phase_h(KP kp, int lane, int wave, int bid, int G) {
    const float* fg = kp->in[26]; float* out = kp->out; const float* x = kp->in[0];
    const bf16* D0 = (const bf16*)(kp->ws + WS_HL); const bf16* D1 = D0 + (size_t)NBATCH * SEQ * DM;
    const int gw = bid * 8 + wave, NGW = G * 8;
    for (int row = gw; row < NBATCH * SEQ; row += NGW) {
        const float* xrow = x + (size_t)row * DM; const bf16* d0 = D0 + (size_t)row * DM; const bf16* d1 = D1 + (size_t)row * DM; float* orow = out + (size_t)row * DM;
        f32x4 v[16]; float s = 0.f;
#pragma unroll
        for (int j = 0; j < 16; ++j) { const int col = 4 * (lane + 64 * j); const v2u a2 = *(const v2u*)(d0 + col), b2 = *(const v2u*)(d1 + col);
            v[j] = *(const f32x4*)(xrow + col) + ((f32x4){lo_bf(a2.x), hi_bf(a2.x), lo_bf(a2.y), hi_bf(a2.y)} + (f32x4){lo_bf(b2.x), hi_bf(b2.x), lo_bf(b2.y), hi_bf(b2.y)});
            s += (v[j].x * v[j].x + v[j].y * v[j].y) + (v[j].z * v[j].z + v[j].w * v[j].w); }
        s = wave_sum(s);
        const float rstd = 1.0f / sqrtf(s * (1.0f / DM) + EPSN);
#pragma unroll
        for (int j = 0; j < 16; ++j) { const int col = 4 * (lane + 64 * j); const f32x4 g4 = *(const f32x4*)(fg + col); *(f32x4*)(orow + col) = v[j] * rstd * g4; }
    }
}

constexpr int N_PHASES = 15;
__global__ void __launch_bounds__(512, 2) fwd(Args a) {
    extern __shared__ __attribute__((aligned(16))) unsigned char lds_raw[];
    LAS unsigned char* lds = (LAS unsigned char*)lds_raw;
    const int bid = blockIdx.x, G = gridDim.x;
#define TIDS() int tid = threadIdx.x; asm volatile("" : "+v"(tid)); const int lane = tid & 63, wave = __builtin_amdgcn_readfirstlane(tid >> 6); (void)lane; (void)wave
    volatile LAS unsigned* MISC = (volatile LAS unsigned*)(lds + MISC_OFF);
    for (int u = threadIdx.x; u < (LDS_BYTES - LDSCTL_OFF) / 4; u += 512) ((LAS unsigned*)(lds + LDSCTL_OFF))[u] = 0u;
    __syncthreads();
    unsigned* ctl = (unsigned*)(a.ws + WS_CTL);
    const int lo = a.ph_lo, hi = a.ph_hi;
    XcdBarrier bar; bar.bar = ctl + CW_BAR; bar.x = 0; bar.st = nullptr;
    if (hi - lo > 1) bar = xcd_barrier_post(ctl + CW_BAR, MISC + 8);
#define IN(k) (lo <= (k) && (k) < hi)
#define SEAM(k) do { if (IN(k) && IN((k) + 1)) xcd_barrier(bar); } while (0)
    for (int layer = 0; layer < 2; ++layer) {
        const int pb = layer * 7;
        if (IN(pb + 0)) { TIDS(); phase_a(KARGS(), layer, lds, tid, lane, wave, bid, G); }
        SEAM(pb + 0);
        if (IN(pb + 1)) { TIDS(); phase_b(KARGS(), layer, lds, lane, wave, bid, G); }
        SEAM(pb + 1);
        if (IN(pb + 2)) { KP kp = KARGS(); unsigned char* ws = kp->ws;
            pg8::Gemm g{(const bf16*)(ws + WS_HN), (const bf16*)(ws + WS_WIN), DM, NPG, DM};
            RowOrder S; S.init(NPG, G, bid, 0);
            EpiStoreBf16 E{(bf16*)(ws + WS_P), NP};
            pg8::gemm_phase<EpiStoreBf16, RowOrder, true, true>(lds, g, S, E);
        }
        SEAM(pb + 2);
        if (IN(pb + 3)) { phase_d(layer, lds, bid, G); }
        SEAM(pb + 3);
        if (IN(pb + 4)) { TIDS(); phase_e(KARGS(), layer, lane, wave, bid, G); }
        SEAM(pb + 4);
        if (IN(pb + 5)) { KP kp = KARGS(); unsigned char* ws = kp->ws;
            pg8::Gemm g{(const bf16*)(ws + WS_Z), (const bf16*)(ws + WS_WGLU) + (size_t)layer * 1024 * 1024, 1024, 1024, 1024};
            RowOrder S; S.init(1024, G, bid, layer == 1 ? 1 : 0);
            EpiGlu E{(const bf16*)(ws + WS_Z), (const bf16*)(ws + WS_P), (bf16*)(ws + WS_O), kp->in[22] + layer * 1024};
            pg8::gemm_phase<EpiGlu, RowOrder, true, true>(lds, g, S, E);
        }
        SEAM(pb + 5);
        if (IN(pb + 6)) { KP kp = KARGS(); unsigned char* ws = kp->ws;
            pg8::Gemm g{(const bf16*)(ws + WS_O), (const bf16*)(ws + WS_WOUT) + (size_t)layer * DM * DM, DM, DM, DM};
            const bool split = (layer == 0 && G == 256);
            RowOrder S; S.init(DM, G, bid, (layer == 1 || split) ? 1 : 0);
            EpiDelta E{(bf16*)(ws + WS_HL) + (size_t)layer * NBATCH * SEQ * DM, (bf16*)(ws + WS_HC), (const float*)(ws + WS_MOD) + (size_t)layer * 5 * 12288};
            pg8::gemm_phase<EpiDelta, RowOrder, true, true>(lds, g, S, E);
            if (split) {
                const int kq = bid & 3;
                pg8::Gemm g2{(const bf16*)(ws + WS_O) + kq * 1024, (const bf16*)(ws + WS_WOUT) + kq * 1024, DM, DM, 1024};
                CtxSplitOrder S2{bid};
                EpiCtxPart E2{(float*)(ws + WS_CPART) + (size_t)kq * NBATCH * NCTX * DM};
                pg8::gemm_phase<EpiCtxPart, CtxSplitOrder, false, true>(lds, g2, S2, E2);
            }
        }
        SEAM(pb + 6);
    }
    if (IN(14)) { TIDS(); phase_h(KARGS(), lane, wave, bid, G); }
#undef IN
#undef SEAM
#undef TIDS
}

extern "C" void kernel_launch(void* const* d_in, const int* in_sizes, int n_in, void* d_out, int out_size, void* d_ws, size_t ws_size, hipStream_t stream) {
    static int grid = 0;
    if (grid == 0) {
        if (n_in != 27 || out_size != NBATCH * SEQ * DM || ws_size < WS_END) { fprintf(stderr, "kernel_launch: unexpected problem (n_in %d out %d ws %zu need %zu); nothing launched\n", n_in, out_size, ws_size, (size_t)WS_END); grid = -1; return; }
        int dev = 0, cus = 0;
        if (hipGetDevice(&dev) != hipSuccess || hipDeviceGetAttribute(&cus, hipDeviceAttributeMultiprocessorCount, dev) != hipSuccess) { grid = -1; return; }
        if (hipFuncSetAttribute((const void*)fwd, hipFuncAttributeMaxDynamicSharedMemorySize, LDS_BYTES) != hipSuccess) { fprintf(stderr, "kernel_launch: hipFuncSetAttribute failed\n"); grid = -1; return; }
        (void)hipGetLastError();
        grid = cus;
    }
    if (grid < 0) return;
    (void)hipMemsetAsync((char*)d_ws + WS_CTL, 0, CTL_BYTES, stream);
    Args a{};
    for (int i = 0; i < 27; ++i) a.in[i] = (const float*)d_in[i];
    a.out = (float*)d_out; a.ws = (unsigned char*)d_ws;
#ifndef ONE_LAUNCH
    for (int ph = 0; ph < N_PHASES; ++ph) { a.ph_lo = ph; a.ph_hi = ph + 1; hipLaunchKernelGGL(fwd, dim3(grid), dim3(512), LDS_BYTES, stream, a); }
#else
    a.ph_lo = 0; a.ph_hi = N_PHASES; hipLaunchKernelGGL(fwd, dim3(grid), dim3(512), LDS_BYTES, stream, a);
#endif
}
```

```cpp
#include <hip/hip_runtime.h>
#include <cstdio>
#include <cstdint>
#define ONE_LAUNCH 1
namespace pg8 {
#define PG8_LAS __attribute__((address_space(3)))
typedef unsigned short bf16_t;
typedef short bf16x8 __attribute__((ext_vector_type(8)));
typedef float f32x4 __attribute__((ext_vector_type(4)));
typedef unsigned u32x4 __attribute__((ext_vector_type(4)));
constexpr int BM = 256, BK = 64, HALF = 128, HTB = HALF * BK * 2  , STAGE_BYTES = 8 * HTB, NXCD = 8, WGM = 8;

__host__ __device__ __forceinline__ int lds_byte(int r, int c) { const int st = (r >> 4) * 2 + (c >> 5), rr = r & 15, cc = c & 31, ob = rr * 64 + cc * 2; return st * 1024 + (ob ^ (((ob >> 9) & 1) << 5)); }
__host__ __device__ __forceinline__ void stage_rc(int b, int& R, int& C) { const int st = b / 1024, sb = b % 1024, swz = sb ^ (((sb >> 9) & 1) << 5); R = (st >> 1) * 16 + swz / 64; C = (st & 1) * 32 + (swz % 64) / 2; }
__host__ __device__ __forceinline__ int perm32(int rho) { const int n = rho >> 4, i = rho & 15; return 8 * (i >> 2) + 4 * n + (i & 3); }

struct Unit { int pm, pn; };
struct Gemm { const bf16_t* A; const bf16_t* Bt; int ld, N, K; };

struct StaticOrder {
    int nM, nN, nwg, G, c;
    __host__ __device__ void init(int M, int N, int G_, int c_) { nM = M / BM; nN = N / BM; nwg = nM * nN; G = G_; c = c_; }
    __host__ __device__ bool next(int i, Unit& u) const {
        const long L = (long)i * G + c; if (L >= nwg) return false;
        int wgid = (int)L; { const int q = nwg / NXCD, r = nwg % NXCD, xcd = wgid % NXCD, off = wgid / NXCD; wgid = (xcd < r ? xcd * (q + 1) : r * (q + 1) + (xcd - r) * q) + off; }
        const int nig = WGM * nN, gid = wgid / nig, fm = gid * WGM, gsz = (nM - fm) < WGM ? (nM - fm) : WGM;
        u.pm = fm + ((wgid % nig) % gsz); u.pn = (wgid % nig) / gsz; return true;
    }
    __device__ __forceinline__ void a_ready(const Unit&) const {}
    __device__ __forceinline__ void done(const Unit&) const {}
};

__device__ __forceinline__ unsigned cvt_pk_bf16(float lo, float hi) { unsigned r; asm volatile("v_cvt_pk_bf16_f32 %0, %1, %2" : "=v"(r) : "v"(lo), "v"(hi)); return r; }
typedef float f32x2 __attribute__((ext_vector_type(2)));
__device__ __forceinline__ f32x2 gelu_pk(f32x2 v) {
    const f32x2 av = __builtin_elementwise_abs(v), d = av * 0.2316418882f + 1.0f;
    f32x2 t; t.x = __builtin_amdgcn_rcpf(d.x); t.y = __builtin_amdgcn_rcpf(d.y);
    f32x2 q = t * 0.5307027145f + (-0.7265760135f); q = q * t + 0.7107068705f; q = q * t + (-0.142248368f); q = q * t + 0.127414796f; q = q * t;
    const f32x2 s = (v * v) * (-0.72134752044f);
    f32x2 e; e.x = __builtin_amdgcn_exp2f(s.x); e.y = __builtin_amdgcn_exp2f(s.y);
    const f32x2 m = v * (q * e), r = v - m;
    f32x2 o; o.x = v.x < 0.f ? m.x : r.x; o.y = v.y < 0.f ? m.y : r.y; return o;
}

template <class Epi, class Sched, bool ALIGN_EPI = false, bool SP2 = false>
__device__ __forceinline__ void gemm_phase(PG8_LAS unsigned char* lds, const Gemm g, const Sched& S, const Epi& E) {
    int tid_l = threadIdx.x; asm volatile("" : "+v"(tid_l));
    const int tid = tid_l, wid = __builtin_amdgcn_readfirstlane(tid >> 6), lane = tid & 63, wr = wid >> 2, wc = wid & 3, fr = lane & 15, fq = lane >> 4;
    const int K = g.K, LD = g.ld, nt = K / BK;
    unsigned voffA[2], voffB[2];
#pragma unroll
    for (int i = 0; i < 2; ++i) { int R, C; stage_rc(tid * 16 + i * 8192, R, C); const int Rb = Epi::PERM ? ((R & ~31) + perm32(R & 31)) : R;
        voffA[i] = (unsigned)(R * LD + C) * 2u; voffB[i] = (unsigned)(Rb * LD + C) * 2u; }
    const size_t kstep = (size_t)(BK * 2);
    const size_t hstep = (size_t)HALF * LD * 2;
    const size_t tstep = 2 * hstep;
    const unsigned ldsw = (unsigned)wid * 1024u;
    const int aoff = lds_byte(wr * 64 + fr, fq * 8), boff = lds_byte(wc * 32 + fr, fq * 8);
#define PG8_SA(b, h) (((b) * 2 + (h)) * HTB)
#define PG8_SB(b, h) ((4 + (b) * 2 + (h)) * HTB)
#define PG8_STAGE(bufoff, gbase, voff) do { _Pragma("unroll") for (int _i = 0; _i < 2; ++_i) \
        __builtin_amdgcn_global_load_lds((const unsigned*)((const char*)(gbase) + (voff)[_i]), (PG8_LAS unsigned*)(lds + (bufoff) + ldsw + _i * 8192), 16, 0, 0); } while (0)
#define PG8_LDA(dst, b, h) do { _Pragma("unroll") for (int m = 0; m < 4; ++m) _Pragma("unroll") for (int k = 0; k < 2; ++k) dst[m][k] = *(const PG8_LAS bf16x8*)(lds + PG8_SA(b, h) + aoff + m * 2048 + k * 1024); } while (0)
#define PG8_LDB(dst, b, h) do { _Pragma("unroll") for (int n = 0; n < 2; ++n) _Pragma("unroll") for (int k = 0; k < 2; ++k) dst[n][k] = *(const PG8_LAS bf16x8*)(lds + PG8_SB(b, h) + boff + n * 2048 + k * 1024); } while (0)
#define PG8_MMA(ai, bj, At, Bt) do { __builtin_amdgcn_s_setprio(1); _Pragma("unroll") for (int m = 0; m < 4; ++m) _Pragma("unroll") for (int n = 0; n < 2; ++n) _Pragma("unroll") for (int k = 0; k < 2; ++k) \
        acc[ai][bj][m][n] = __builtin_amdgcn_mfma_f32_16x16x32_bf16(Bt[n][k], At[m][k], acc[ai][bj][m][n], 0, 0, 0); __builtin_amdgcn_s_setprio(0); } while (0)
#define PG8_WAIT_V(n) asm volatile("s_waitcnt vmcnt(" #n ")" ::: "memory")
#define PG8_WAIT_L(n) asm volatile("s_waitcnt lgkmcnt(" #n ")" ::: "memory")
#define PG8_BAR __builtin_amdgcn_s_barrier()
#define PG8_SCHED __builtin_amdgcn_sched_barrier(0)
    Unit cur, nxt; int ui = 0;
    if (!S.next(0, cur)) return;
    f32x4 acc[2][2][4][2];
#pragma unroll
    for (int a = 0; a < 2; ++a)
#pragma unroll
        for (int b = 0; b < 2; ++b)
#pragma unroll
            for (int m = 0; m < 4; ++m)
#pragma unroll
                for (int n = 0; n < 2; ++n) acc[a][b][m][n] = (f32x4){0.f, 0.f, 0.f, 0.f};
    bf16x8 At[4][2], B0[2][2], B1[2][2];
    const char* cA = (const char*)g.A + (size_t)cur.pm * tstep; const char* cB = (const char*)g.Bt + (size_t)cur.pn * tstep;
    S.a_ready(cur);
    if constexpr (SP2) {
        PG8_STAGE(PG8_SB(0, 0), cB, voffB); PG8_STAGE(PG8_SB(0, 1), cB + hstep, voffB); PG8_STAGE(PG8_SA(0, 0), cA, voffA); PG8_STAGE(PG8_SA(0, 1), cA + hstep, voffA);
        if (wr == 1) PG8_BAR;
        PG8_WAIT_V(2); PG8_BAR;
        PG8_STAGE(PG8_SB(1, 0), cB + kstep, voffB); PG8_STAGE(PG8_SA(1, 0), cA + kstep, voffA); PG8_STAGE(PG8_SB(1, 1), cB + hstep + kstep, voffB);
        PG8_WAIT_V(6); PG8_BAR;
    } else {
        PG8_STAGE(PG8_SB(0, 0), cB, voffB); PG8_STAGE(PG8_SA(0, 0), cA, voffA); PG8_STAGE(PG8_SB(0, 1), cB + hstep, voffB); PG8_STAGE(PG8_SA(0, 1), cA + hstep, voffA);
        if (wr == 1) PG8_BAR;
        PG8_WAIT_V(4); PG8_BAR;
        PG8_STAGE(PG8_SB(1, 0), cB + kstep, voffB); PG8_STAGE(PG8_SA(1, 0), cA + kstep, voffA); PG8_STAGE(PG8_SB(1, 1), cB + hstep + kstep, voffB);
        PG8_WAIT_V(6); PG8_BAR;
    }
    for (;;) {
        const bool has_next = S.next(ui + 1, nxt);
        const char* nA = has_next ? (const char*)g.A + (size_t)nxt.pm * tstep : cA; const char* nB = has_next ? (const char*)g.Bt + (size_t)nxt.pn * tstep : cB;
        for (int t = 0; t < nt; t += 2) {
            const bool last = (t == nt - 2);
            const char* a1 = cA + (size_t)(t + 1) * kstep;
            const char* a2 = last ? nA : cA + (size_t)(t + 2) * kstep; const char* b2 = last ? nB : cB + (size_t)(t + 2) * kstep;
            const char* a3 = a2 + kstep; const char* b3 = b2 + kstep;
            if (last && has_next) S.a_ready(nxt);
            if constexpr (SP2) {
            PG8_LDB(B0, 0, 0); PG8_LDB(B1, 0, 1); PG8_SCHED; PG8_LDA(At, 0, 0); PG8_STAGE(PG8_SA(1, 1), a1 + hstep, voffA);
            PG8_WAIT_V(8); PG8_WAIT_L(0); PG8_BAR; PG8_MMA(0, 0, At, B0); PG8_MMA(0, 1, At, B1); PG8_BAR; PG8_SCHED;
            PG8_LDA(At, 0, 1); PG8_STAGE(PG8_SB(0, 0), b2, voffB); PG8_STAGE(PG8_SB(0, 1), b2 + hstep, voffB); PG8_STAGE(PG8_SA(0, 0), a2, voffA);
            PG8_WAIT_V(8); PG8_WAIT_L(0); PG8_BAR; PG8_MMA(1, 0, At, B0); PG8_MMA(1, 1, At, B1); PG8_BAR; PG8_SCHED;
            PG8_LDB(B0, 1, 0); PG8_LDB(B1, 1, 1); PG8_SCHED; PG8_LDA(At, 1, 0); PG8_STAGE(PG8_SA(0, 1), a2 + hstep, voffA);
            PG8_WAIT_V(8); PG8_WAIT_L(0); PG8_BAR; PG8_MMA(0, 0, At, B0); PG8_MMA(0, 1, At, B1); PG8_BAR; PG8_SCHED;
            PG8_LDA(At, 1, 1); PG8_STAGE(PG8_SB(1, 0), b3, voffB); PG8_STAGE(PG8_SB(1, 1), b3 + hstep, voffB); PG8_STAGE(PG8_SA(1, 0), a3, voffA);
            PG8_WAIT_V(8); PG8_WAIT_L(0); PG8_BAR; PG8_MMA(1, 0, At, B0); PG8_MMA(1, 1, At, B1); PG8_BAR; PG8_SCHED;
            } else {
            PG8_LDB(B0, 0, 0); PG8_SCHED; PG8_LDA(At, 0, 0); PG8_STAGE(PG8_SA(1, 1), a1 + hstep, voffA);
            PG8_WAIT_L(8); PG8_BAR; PG8_WAIT_L(0); PG8_MMA(0, 0, At, B0); PG8_BAR; PG8_SCHED;
            PG8_LDB(B1, 0, 1); PG8_STAGE(PG8_SB(0, 0), b2, voffB);
            PG8_BAR; PG8_WAIT_L(0); PG8_MMA(0, 1, At, B1); PG8_BAR;
            PG8_LDA(At, 0, 1); PG8_STAGE(PG8_SA(0, 0), a2, voffA);
            PG8_BAR; PG8_WAIT_L(0); PG8_MMA(1, 0, At, B0); PG8_BAR; PG8_SCHED;
            PG8_STAGE(PG8_SB(0, 1), b2 + hstep, voffB);
            PG8_WAIT_V(6); PG8_BAR; PG8_MMA(1, 1, At, B1); PG8_BAR;
            PG8_LDB(B0, 1, 0); PG8_SCHED; PG8_LDA(At, 1, 0); PG8_STAGE(PG8_SA(0, 1), a2 + hstep, voffA);
            PG8_WAIT_L(8); PG8_BAR; PG8_WAIT_L(0); PG8_MMA(0, 0, At, B0); PG8_BAR; PG8_SCHED;
            PG8_LDB(B1, 1, 1); PG8_STAGE(PG8_SB(1, 0), b3, voffB);
            PG8_BAR; PG8_WAIT_L(0); PG8_MMA(0, 1, At, B1); PG8_BAR;
            PG8_LDA(At, 1, 1); PG8_STAGE(PG8_SA(1, 0), a3, voffA);
            PG8_BAR; PG8_WAIT_L(0); PG8_MMA(1, 0, At, B0); PG8_BAR; PG8_SCHED;
            PG8_STAGE(PG8_SB(1, 1), b3 + hstep, voffB);
            PG8_WAIT_V(6); PG8_BAR; PG8_MMA(1, 1, At, B1); PG8_BAR;
            }
        }
        if constexpr (ALIGN_EPI) { if (wr == 0) PG8_BAR; }
        if constexpr (!Epi::AFTER_DRAIN) { E(acc, cur, wr, wc, fr, fq); S.done(cur); }
        if (!has_next) break;
#pragma unroll
        for (int a = 0; a < 2; ++a)
#pragma unroll
            for (int b = 0; b < 2; ++b)
#pragma unroll
                for (int m = 0; m < 4; ++m)
#pragma unroll
                    for (int n = 0; n < 2; ++n) acc[a][b][m][n] = (f32x4){0.f, 0.f, 0.f, 0.f};
        cur = nxt; cA = nA; cB = nB; ++ui;
        if constexpr (ALIGN_EPI) { if (wr == 1) PG8_BAR; }
    }
    PG8_WAIT_V(0);
    if constexpr (!ALIGN_EPI) { if (wr == 0) PG8_BAR; }
    PG8_BAR;
    if constexpr (Epi::AFTER_DRAIN) { E.fused(acc, cur, wr, wc, fr, fq, lds, wid, lane); S.done(cur); }
#undef PG8_SA
#undef PG8_SB
#undef PG8_STAGE
#undef PG8_LDA
#undef PG8_LDB
#undef PG8_MMA
#undef PG8_WAIT_V
#undef PG8_WAIT_L
#undef PG8_BAR
#undef PG8_SCHED
}
}
#define XB_TMO      128
#define XB_XCNT(j)  (256  + 64 * (j))
#define XB_XSUB(j)  (1280 + 64 * (j))
#define XB_XGEN(j)  (2304 + 64 * (j))
#define XB_TOP      3328
#define XB_TOPGEN   3392
#define XCD_BAR_WORDS 3456
#define XB_SPIN_CAP (1u << 18)
#define LAS __attribute__((address_space(3)))

__device__ __forceinline__ unsigned xb_ld(unsigned* p)              { return __hip_atomic_load(p, __ATOMIC_RELAXED, __HIP_MEMORY_SCOPE_AGENT); }
__device__ __forceinline__ unsigned xb_add(unsigned* p, unsigned v) { return __hip_atomic_fetch_add(p, v, __ATOMIC_RELAXED, __HIP_MEMORY_SCOPE_AGENT); }
__device__ __forceinline__ unsigned xb_xcc_id() { return (unsigned)__builtin_amdgcn_s_getreg((3 << 11) | 20) & 0xFu; }
#define XB_SPIN(cond, bar) do { unsigned _sp = 0; while (cond) { __builtin_amdgcn_s_sleep(1); \
    if ((++_sp & 255u) == 0u) { if (xb_ld(&(bar)[XB_TMO])) break; if (_sp > XB_SPIN_CAP) { atomicAdd(&(bar)[XB_TMO], 1u); break; } } } } while (0)

struct XcdBarrier {
    unsigned* bar; unsigned x;
    volatile LAS unsigned* st;
};

__device__ __forceinline__ XcdBarrier xcd_barrier_post(unsigned* bar, volatile LAS unsigned* st) {
    XcdBarrier b; b.bar = bar; b.x = xb_xcc_id(); b.st = st;
    if (threadIdx.x == 0) (void)xb_add(&bar[XB_XCNT(b.x)], 1u);
    return b;
}
__device__ __forceinline__ void xcd_barrier_complete(unsigned* bar, unsigned x, unsigned& nloc, unsigned& nx) {
    const unsigned G = gridDim.x * gridDim.y * gridDim.z;
    unsigned sum, cnt, mine, sp = 0u;
    for (;;) {
        sum = 0u; cnt = 0u; mine = 0u;
#pragma unroll
        for (unsigned j = 0; j < 16; ++j) { const unsigned c = xb_ld(&bar[XB_XCNT(j)]); sum += c; cnt += (c > 0u) ? 1u : 0u; mine = (j == x) ? c : mine; }
        if (sum == G) break;
        __builtin_amdgcn_s_sleep(1);
        if ((++sp & 255u) == 0u) { if (xb_ld(&bar[XB_TMO])) break; if (sp > XB_SPIN_CAP) { atomicAdd(&bar[XB_TMO], 1u); break; } }
    }
    nloc = mine > 0u ? mine : 1u; nx = cnt > 0u ? cnt : 1u;
}

__device__ __forceinline__ void xcd_barrier(const XcdBarrier& b) {
    asm volatile("s_waitcnt vmcnt(0)" ::: "memory");
    __syncthreads();
    if (threadIdx.x == 0) {
        unsigned* bar = b.bar;
        __builtin_amdgcn_s_waitcnt(0);
        unsigned nloc = b.st[0], nx = b.st[1];
        if (nloc == 0u) { xcd_barrier_complete(bar, b.x, nloc, nx); b.st[0] = nloc; b.st[1] = nx; }
        const unsigned old = xb_add(&bar[XB_XSUB(b.x)], 1u);
        const unsigned gen = old / nloc;
        if (old + 1u == (gen + 1u) * nloc) {
            __builtin_amdgcn_fence(__ATOMIC_RELEASE, "agent");
            asm volatile("s_waitcnt vmcnt(0)" ::: "memory");
            const unsigned og = xb_add(&bar[XB_TOP], 1u);
            const unsigned tg = og / nx;
            if (og + 1u == (tg + 1u) * nx) xb_add(&bar[XB_TOPGEN], 1u);
            else XB_SPIN(xb_ld(&bar[XB_TOPGEN]) == tg, bar);
            __builtin_amdgcn_fence(__ATOMIC_ACQUIRE, "agent");
            xb_add(&bar[XB_XGEN(b.x)], 1u);
            asm volatile("s_waitcnt vmcnt(0)" ::: "memory");
        } else {
            XB_SPIN(xb_ld(&bar[XB_XGEN(b.x)]) == gen, bar);
            __builtin_amdgcn_fence(__ATOMIC_ACQUIRE, "agent");
            asm volatile("s_waitcnt vmcnt(0)" ::: "memory");
        }
    }
    __syncthreads();
}

#define GAS __attribute__((address_space(1)))
typedef unsigned short bf16;
typedef unsigned v4u __attribute__((ext_vector_type(4)));
typedef unsigned v2u __attribute__((ext_vector_type(2)));
typedef float f32x4 __attribute__((ext_vector_type(4)));
#define LDS_WAIT() asm volatile("s_waitcnt lgkmcnt(0)" ::: "memory")

constexpr int DM = 4096, NBATCH = 4, SEQ = 4096, NCTX = 256, LTOT = NCTX + SEQ, MROWS = NBATCH * LTOT;
constexpr int NIN = 13344, NP = 13568, NPG = 13312;
constexpr int CA_Q = 0, CA_FF = 1024, CA_FB = 2048, CA_I = 3072, CA_G = 4096;
constexpr int CB_Q = 5120, CB_K = 5632, CB_V = 6144, CB_G = 7168;
constexpr int CC_U = 8192, CC_G = 9216;
constexpr int CD_Q = 10240, CD_K = 10752, CD_V = 11264, CD_G = 12288;
constexpr int CB_LF = 13312, CB_LB = 13328;
constexpr float EPSN = 1e-6f;
constexpr size_t P_BLK_ELEMS = (size_t)NBATCH * (NCTX + SEQ) * 512;
constexpr size_t P_LRB_OFF = (size_t)26 * P_BLK_ELEMS;
__device__ __forceinline__ size_t p_off(size_t row, int col) { return (size_t)(col >> 9) * P_BLK_ELEMS + row * 512 + (col & 511); }

constexpr size_t WS_CTL = 0, CTL_BYTES = 1u << 20;
constexpr size_t WS_WIN = WS_CTL + CTL_BYTES;
constexpr size_t WS_WOUT = WS_WIN + (size_t)NP * DM * 2;
constexpr size_t WS_WGLU = WS_WOUT + (size_t)2 * DM * DM * 2;
constexpr size_t WS_WLR = WS_WGLU + (size_t)2 * 1024 * 1024 * 2;
constexpr size_t WS_MOD = WS_WLR + (size_t)32 * DM * 2;
constexpr size_t WS_HN = WS_MOD + (size_t)2 * 5 * 12288 * 4;
constexpr size_t WS_P = WS_HN + (size_t)MROWS * DM * 2;
constexpr size_t WS_HC = WS_P + (size_t)MROWS * NP * 2;
constexpr size_t WS_HL = WS_HC + (size_t)NBATCH * NCTX * DM * 4;
constexpr size_t WS_O = WS_HL + (size_t)NBATCH * SEQ * DM * 4;
constexpr size_t WS_Z = WS_O + (size_t)MROWS * DM * 2;
constexpr size_t WS_RAW = WS_Z + (size_t)MROWS * 1024 * 2;
constexpr size_t WS_CPART = WS_RAW + (size_t)2 * MROWS * DM * 2;
constexpr size_t WS_END = WS_CPART + (size_t)4 * NBATCH * NCTX * DM * 4;

constexpr int RING_BYTES = 131072, LDSCTL_OFF = 146944, MISC_OFF = LDSCTL_OFF + 320, LDS_BYTES = 147456;
constexpr int CW_BAR = 1024;

struct Args { const float* in[27]; float* out; unsigned char* ws; int ph_lo, ph_hi; };
typedef const __attribute__((address_space(4))) Args* KP;
#define KARGS() ({ KP _p = (KP)__builtin_amdgcn_kernarg_segment_ptr(); asm volatile("" : "+s"(_p)); _p; })

__device__ __forceinline__ float bf2f(bf16 v) { return __builtin_bit_cast(float, (unsigned)v << 16); }
__device__ __forceinline__ unsigned f2bf(float f) { unsigned u = __builtin_bit_cast(unsigned, f); return (u + 0x7fffu + ((u >> 16) & 1u)) >> 16; }
__device__ __forceinline__ unsigned pk2(float lo, float hi) { return f2bf(lo) | (f2bf(hi) << 16); }
typedef float f32x2_ __attribute__((ext_vector_type(2)));
typedef __bf16 bf16x2_ __attribute__((ext_vector_type(2)));
__device__ __forceinline__ unsigned cvtpk(float lo, float hi) { const f32x2_ v = {lo, hi}; return __builtin_bit_cast(unsigned, __builtin_convertvector(v, bf16x2_)); }
template <int CTRL, int ROW_MASK> __device__ __forceinline__ float dpp_f(float x) {
    return __builtin_bit_cast(float, __builtin_amdgcn_update_dpp(0, __builtin_bit_cast(int, x), CTRL, ROW_MASK, 0xf, true));
}
__device__ __forceinline__ float lane_scan(float x, int lane) {
    (void)lane;
    x += dpp_f<0x111, 0xf>(x);
    x += dpp_f<0x112, 0xf>(x);
    x += dpp_f<0x114, 0xf>(x);
    x += dpp_f<0x118, 0xf>(x);
    x += dpp_f<0x142, 0xa>(x);
    x += dpp_f<0x143, 0xc>(x);
    return x;
}

__device__ __forceinline__ float lo_bf(unsigned w) { return __builtin_bit_cast(float, w << 16); }
__device__ __forceinline__ float hi_bf(unsigned w) { return __builtin_bit_cast(float, w & 0xffff0000u); }
__device__ __forceinline__ void unpack8(const v4u w, float* f) {
    f[0] = lo_bf(w.x); f[1] = hi_bf(w.x); f[2] = lo_bf(w.y); f[3] = hi_bf(w.y); f[4] = lo_bf(w.z); f[5] = hi_bf(w.z); f[6] = lo_bf(w.w); f[7] = hi_bf(w.w);
}
__device__ __forceinline__ v4u pack8(const float* f) { v4u w; w.x = pk2(f[0], f[1]); w.y = pk2(f[2], f[3]); w.z = pk2(f[4], f[5]); w.w = pk2(f[6], f[7]); return w; }
__device__ __forceinline__ v4u pack8c(const float* f) { v4u w; w.x = cvtpk(f[0], f[1]); w.y = cvtpk(f[2], f[3]); w.z = cvtpk(f[4], f[5]); w.w = cvtpk(f[6], f[7]); return w; }
__device__ __forceinline__ float wave_sum(float v) {
    const float s = lane_scan(v, 0);
    return __builtin_bit_cast(float, __builtin_amdgcn_readlane(__builtin_bit_cast(int, s), 63));
}
__device__ __forceinline__ float sigmoidf_(float x) { return __builtin_amdgcn_rcpf(1.0f + __builtin_amdgcn_exp2f(-1.4426950408889634f * x)); }
__device__ __forceinline__ float siluf_(float x) { return x * __builtin_amdgcn_rcpf(1.0f + __builtin_amdgcn_exp2f(-1.4426950408889634f * x)); }
__device__ __forceinline__ float log_sigmoidf_(float x) { return fminf(x, 0.f) - log1pf(__expf(-fabsf(x))); }
__device__ __forceinline__ float gelu_tanhf_(float y) { const float t = 0.7978845608028654f * (y + 0.044715f * y * y * y); const float e = __expf(2.f * t); return 0.5f * y * (1.f + (1.f - 2.f / (e + 1.f))); }
__device__ __forceinline__ void sincos_acc(float x, float& s, float& c) {
    const float k = rintf(x * 0.63661977236758134f);
    float r = fmaf(-k, 1.57079637050628662109375f, x);
    r = fmaf(-k, -4.37113882867379e-8f, r);
    const int q = ((int)k) & 3;
    const float r2 = r * r;
    const float sp = r + r * r2 * (-1.6666654611e-1f + r2 * (8.3321608736e-3f + r2 * (-1.9515295891e-4f)));
    const float cp = 1.0f - 0.5f * r2 + r2 * r2 * (4.166664568298827e-2f + r2 * (-1.388731625493765e-3f + r2 * 2.443315711809948e-5f));
    s = (q == 0) ? sp : (q == 1) ? cp : (q == 2) ? -sp : -cp;
    c = (q == 0) ? cp : (q == 1) ? -sp : (q == 2) ? -cp : sp;
}
__device__ __forceinline__ int flip_pos(int p) { return p < NCTX ? (NCTX - 1 - p) : (LTOT + NCTX - 1 - p); }

struct EpiStoreBf16 {
    static constexpr bool PERM = true, AFTER_DRAIN = false;
    bf16* O; int ldc;
    __device__ __forceinline__ void operator()(const pg8::f32x4 (&acc)[2][2][4][2], const pg8::Unit& u, int wr, int wc, int fr, int fq) const {
        const int row0 = u.pm * 256 + wr * 64 + fr, col0 = u.pn * 256 + wc * 32 + 8 * fq;
#pragma unroll
        for (int ai = 0; ai < 2; ++ai)
#pragma unroll
            for (int m = 0; m < 4; ++m) { bf16* rowp = O + p_off((size_t)(row0 + ai * 128 + m * 16), col0);
#pragma unroll
                for (int bj = 0; bj < 2; ++bj) { const pg8::f32x4 v0 = acc[ai][bj][m][0], v1 = acc[ai][bj][m][1];
                    pg8::u32x4 w; w.x = pg8::cvt_pk_bf16(v0[0], v0[1]); w.y = pg8::cvt_pk_bf16(v0[2], v0[3]); w.z = pg8::cvt_pk_bf16(v1[0], v1[1]); w.w = pg8::cvt_pk_bf16(v1[2], v1[3]);
                    __builtin_nontemporal_store(w, (pg8::u32x4*)(rowp + bj * 128)); } }
    }
};
struct EpiGlu {
    static constexpr bool PERM = true, AFTER_DRAIN = false;
    const bf16* Z; const bf16* P; bf16* O; const float* bias;
    __device__ __forceinline__ void operator()(const pg8::f32x4 (&acc)[2][2][4][2], const pg8::Unit& u, int wr, int wc, int fr, int fq) const {
        const int row0 = u.pm * 256 + wr * 64 + fr, col0 = u.pn * 256 + wc * 32 + 8 * fq;
#pragma unroll
        for (int ai = 0; ai < 2; ++ai)
#pragma unroll
            for (int m = 0; m < 4; ++m) { const size_t row = (size_t)(row0 + ai * 128 + m * 16);
#pragma unroll
                for (int bj = 0; bj < 2; ++bj) { const int col = col0 + bj * 128;
                    const pg8::u32x4 z8 = *(const pg8::u32x4*)(Z + row * 1024 + col), g8 = *(const pg8::u32x4*)(P + p_off(row, CC_G + col));
                    const pg8::f32x4 b0 = *(const pg8::f32x4*)(bias + col), b1 = *(const pg8::f32x4*)(bias + col + 4);
                    const pg8::f32x4 v0 = acc[ai][bj][m][0] + b0, v1 = acc[ai][bj][m][1] + b1;
                    float o[8];
                    o[0] = lo_bf(z8.x) * sigmoidf_(v0[0]) * siluf_(lo_bf(g8.x)); o[1] = hi_bf(z8.x) * sigmoidf_(v0[1]) * siluf_(hi_bf(g8.x));
                    o[2] = lo_bf(z8.y) * sigmoidf_(v0[2]) * siluf_(lo_bf(g8.y)); o[3] = hi_bf(z8.y) * sigmoidf_(v0[3]) * siluf_(hi_bf(g8.y));
                    o[4] = lo_bf(z8.z) * sigmoidf_(v1[0]) * siluf_(lo_bf(g8.z)); o[5] = hi_bf(z8.z) * sigmoidf_(v1[1]) * siluf_(hi_bf(g8.z));
                    o[6] = lo_bf(z8.w) * sigmoidf_(v1[2]) * siluf_(lo_bf(g8.w)); o[7] = hi_bf(z8.w) * sigmoidf_(v1[3]) * siluf_(hi_bf(g8.w));
                    pg8::u32x4 w; w.x = pg8::cvt_pk_bf16(o[0], o[1]); w.y = pg8::cvt_pk_bf16(o[2], o[3]); w.z = pg8::cvt_pk_bf16(o[4], o[5]); w.w = pg8::cvt_pk_bf16(o[6], o[7]);
                    *(pg8::u32x4*)(O + row * DM + 2048 + col) = w; } }
    }
};
struct EpiOut {
    static constexpr bool PERM = false, AFTER_DRAIN = false;
    const float* src_ctx; const float* src_lat; float* dst_ctx; float* dst_lat; const float* modl;
    __device__ __forceinline__ void operator()(const pg8::f32x4 (&acc)[2][2][4][2], const pg8::Unit& u, int wr, int wc, int fr, int fq) const {
        const int b = u.pm / 17, t = u.pm % 17;
        const float* gt = modl + (size_t)(t == 0 ? 4 : b) * 12288 + 8192;
        const size_t rbase = (t == 0) ? (size_t)b * NCTX : (size_t)b * SEQ + (size_t)(t - 1) * 256;
        const float* src = (t == 0) ? src_ctx : src_lat; float* dst = (t == 0) ? dst_ctx : dst_lat;
        const int rr0 = wr * 64 + fr, col0 = u.pn * 256 + wc * 32 + 4 * fq;
        pg8::f32x4 gv[2][2];
#pragma unroll
        for (int bj = 0; bj < 2; ++bj)
#pragma unroll
            for (int n = 0; n < 2; ++n) gv[bj][n] = *(const pg8::f32x4*)(gt + col0 + bj * 128 + n * 16);
#pragma unroll
        for (int ai = 0; ai < 2; ++ai)
#pragma unroll
            for (int m = 0; m < 4; ++m) { const size_t off = (rbase + rr0 + ai * 128 + m * 16) * DM + col0;
#pragma unroll
                for (int bj = 0; bj < 2; ++bj)
#pragma unroll
                    for (int n = 0; n < 2; ++n) { const pg8::f32x4 s = *(const pg8::f32x4*)(src + off + bj * 128 + n * 16);
                        *(pg8::f32x4*)(dst + off + bj * 128 + n * 16) = s + gv[bj][n] * acc[ai][bj][m][n]; } }
    }
};
struct EpiDelta {
    static constexpr bool PERM = true, AFTER_DRAIN = false;
    bf16* dlat; bf16* dctx; const float* modl;
    __device__ __forceinline__ void operator()(const pg8::f32x4 (&acc)[2][2][4][2], const pg8::Unit& u, int wr, int wc, int fr, int fq) const {
        const int b = u.pm / 17, t = u.pm % 17;
        const float* gt = modl + (size_t)(t == 0 ? 4 : b) * 12288 + 8192;
        bf16* dst = (t == 0) ? dctx + (size_t)b * NCTX * DM : dlat + ((size_t)b * SEQ + (size_t)(t - 1) * 256) * DM;
        const int rr0 = wr * 64 + fr, col0 = u.pn * 256 + wc * 32 + 8 * fq;
        pg8::f32x4 gv[2][2];
#pragma unroll
        for (int bj = 0; bj < 2; ++bj)
#pragma unroll
            for (int n = 0; n < 2; ++n) gv[bj][n] = *(const pg8::f32x4*)(gt + col0 + bj * 128 + 4 * n);
#pragma unroll
        for (int ai = 0; ai < 2; ++ai)
#pragma unroll
            for (int m = 0; m < 4; ++m) { bf16* rowp = dst + (size_t)(rr0 + ai * 128 + m * 16) * DM + col0;
#pragma unroll
                for (int bj = 0; bj < 2; ++bj) { const pg8::f32x4 v0 = gv[bj][0] * acc[ai][bj][m][0], v1 = gv[bj][1] * acc[ai][bj][m][1];
                    pg8::u32x4 w; w.x = cvtpk(v0[0], v0[1]); w.y = cvtpk(v0[2], v0[3]); w.z = cvtpk(v1[0], v1[1]); w.w = cvtpk(v1[2], v1[3]);
                    *(pg8::u32x4*)(rowp + bj * 128) = w; } }
    }
};
struct EpiCtxPart {
    static constexpr bool PERM = false, AFTER_DRAIN = false;
    float* part;
    __device__ __forceinline__ void operator()(const pg8::f32x4 (&acc)[2][2][4][2], const pg8::Unit& u, int wr, int wc, int fr, int fq) const {
        const int b = u.pm / 17; const size_t rbase = (size_t)b * NCTX; const int rr0 = wr * 64 + fr, col0 = u.pn * 256 + wc * 32 + 4 * fq;
#pragma unroll
        for (int ai = 0; ai < 2; ++ai)
#pragma unroll
            for (int m = 0; m < 4; ++m) { float* rowp = part + (rbase + rr0 + ai * 128 + m * 16) * DM + col0;
#pragma unroll
                for (int bj = 0; bj < 2; ++bj)
#pragma unroll
                    for (int n = 0; n < 2; ++n) *(pg8::f32x4*)(rowp + bj * 128 + n * 16) = acc[ai][bj][m][n]; }
    }
};
struct CtxSplitOrder {
    int c;
    __device__ __forceinline__ bool next(int i, pg8::Unit& u) const { if (i > 0 || c >= 256) return false; u.pm = (c >> 6) * 17; u.pn = (c >> 2) & 15; return true; }
    __device__ __forceinline__ void a_ready(const pg8::Unit&) const {}
    __device__ __forceinline__ void done(const pg8::Unit&) const {}
};
struct RowOrder {
    pg8::StaticOrder S; int lat;
    __device__ __forceinline__ void init(int N, int G, int c, int lat_) { lat = lat_; S.init(lat_ ? 64 * 256 : MROWS, N, G, c); }
    __device__ __forceinline__ bool next(int i, pg8::Unit& u) const { if (!S.next(i, u)) return false; if (lat) u.pm = (u.pm >> 4) * 17 + 1 + (u.pm & 15); return true; }
    __device__ __forceinline__ void a_ready(const pg8::Unit&) const {}
    __device__ __forceinline__ void done(const pg8::Unit&) const {}
};

__device__ __forceinline__ void transpose_item(const float* W, int K, int Nsrc, int nsrc0, int k0, bf16* WT, int ndst0, LAS float* scr, int lane, float scale = 1.0f) {
    if (nsrc0 >= 0) {
#pragma unroll 8
        for (int i = 0; i < 32; ++i) { const int kk = 2 * i + (lane >> 5); scr[kk * 33 + (lane & 31)] = W[(size_t)(k0 + kk) * Nsrc + nsrc0 + (lane & 31)]; }
    } else {
#pragma unroll 8
        for (int i = 0; i < 32; ++i) { const int kk = 2 * i + (lane >> 5); scr[kk * 33 + (lane & 31)] = 0.f; }
    }
    LDS_WAIT(); asm volatile("" ::: "memory");
    const int c = lane & 7;
#pragma unroll
    for (int j = 0; j < 4; ++j) { const int n = (lane >> 3) + 8 * j; const LAS float* s = scr + (8 * c) * 33 + n;
        v4u o; o.x = pk2(s[0 * 33] * scale, s[1 * 33] * scale); o.y = pk2(s[2 * 33] * scale, s[3 * 33] * scale); o.z = pk2(s[4 * 33] * scale, s[5 * 33] * scale); o.w = pk2(s[6 * 33] * scale, s[7 * 33] * scale);
        *(v4u*)(WT + (size_t)(ndst0 + n) * K + k0 + 8 * c) = o; }
    LDS_WAIT(); asm volatile("" ::: "memory");
}

__device__ __forceinline__ void phase_a(KP kp, int layer, LAS unsigned char* lds, int tid, int lane, int wave, int bid, int G) {
    unsigned char* ws = kp->ws;
    float* mod = (float*)(ws + WS_MOD);
    {
        LAS float* sc = (LAS float*)lds;
        LAS float* red = (LAS float*)(lds + 81920);
        const float* cin = kp->in[1]; const float* cctx = kp->in[3]; const float* wada = kp->in[5] + (size_t)layer * DM * 12288; const float* bada = kp->in[6] + (size_t)layer * 12288;
        bool have = false;
        for (int u = bid; u < 192; u += G) {
            if (!have) {
                for (int i = tid; i < 5 * DM; i += 512) { const int bi = i / DM, k = i % DM; const float v = bi < 4 ? cin[bi * DM + k] : cctx[k]; sc[i] = v / (1.0f + expf(-v)); }
                __syncthreads(); have = true;
            }
            const float* W = wada + u * 64 + lane;
            float acc0 = 0.f, acc1 = 0.f, acc2 = 0.f, acc3 = 0.f, acc4 = 0.f;
            const int k0 = wave * 512;
#pragma unroll 8
            for (int k = 0; k < 512; ++k) { const float w = W[(size_t)(k0 + k) * 12288];
                acc0 += sc[0 * DM + k0 + k] * w; acc1 += sc[1 * DM + k0 + k] * w; acc2 += sc[2 * DM + k0 + k] * w; acc3 += sc[3 * DM + k0 + k] * w; acc4 += sc[4 * DM + k0 + k] * w; }
            red[(wave * 5 + 0) * 64 + lane] = acc0; red[(wave * 5 + 1) * 64 + lane] = acc1; red[(wave * 5 + 2) * 64 + lane] = acc2; red[(wave * 5 + 3) * 64 + lane] = acc3; red[(wave * 5 + 4) * 64 + lane] = acc4;
            __syncthreads();
            if (tid < 320) { const int bi = tid / 64, cl = tid % 64; float s = 0.f;
#pragma unroll
                for (int w = 0; w < 8; ++w) s += red[(w * 5 + bi) * 64 + cl];
                mod[(size_t)(layer * 5 + bi) * 12288 + u * 64 + cl] = s + bada[u * 64 + cl]; }
            __syncthreads();
        }
        __syncthreads();
    }
    {
        LAS float* scr = (LAS float*)(lds + wave * 16384);
        const int gw = bid * 8 + wave, NGW = G * 8;
        const float* win = kp->in[7] + (size_t)layer * DM * NIN; const float* wout = kp->in[25] + (size_t)layer * DM * DM; const float* wglu = kp->in[21] + (size_t)layer * 1024 * 1024;
        bf16* WIN = (bf16*)(ws + WS_WIN); bf16* WOUT = (bf16*)(ws + WS_WOUT) + (size_t)layer * DM * DM; bf16* WGLU = (bf16*)(ws + WS_WGLU) + (size_t)layer * 1024 * 1024;
        constexpr int I_IN = 64 * (NIN / 32), I_OUT = 64 * (DM / 32), I_GLU = 16 * 32;
        for (int it = gw; it < I_IN + I_OUT + I_GLU; it += NGW) {
            int r = it;
            if (r < I_IN) { const int kb = r / (NIN / 32), nb = r % (NIN / 32), nd = nb * 32;
                if (nd < NPG) { int ns;
                    if (nd < 4096) { const int h = nd >> 9, r = nd & 511; ns = (r >> 7) * 1024 + h * 128 + (r & 127); }
                    else if (nd < 5120) ns = nd;
                    else if (nd < 7168) { const int h = (nd - 5120) >> 9, r = (nd - 5120) & 511; ns = r < 128 ? 5120 + h * 128 + r : r < 256 ? 5632 + h * 128 + (r - 128) : 6144 + h * 256 + (r - 256); }
                    else if (nd < 10240) ns = nd + 32;
                    else if (nd < 12288) { const int h = (nd - 10240) >> 9, r = (nd - 10240) & 511; ns = r < 128 ? 10272 + h * 128 + r : r < 256 ? 10784 + h * 128 + (r - 128) : 11296 + h * 256 + (r - 256); }
                    else ns = nd + 32;
                    const float scl = (nd >= 5120 && nd < 7168 && ((nd - 5120) & 511) < 128) ? 0.08838834764831845f : (nd < 4096 && (nd & 511) >= 128 && (nd & 511) < 384) ? -1.4426950408889634f : 1.0f;
                    transpose_item(win, DM, NIN, ns, kb * 64, WIN, nd, scr, lane, scl); }
                else transpose_item(win, DM, NIN, 7168, kb * 64, (bf16*)(ws + WS_WLR), 0, scr, lane);
                continue; }
            r -= I_IN;
            if (r < I_OUT) { const int kb = r / (DM / 32), nb = r % (DM / 32); transpose_item(wout, DM, DM, nb * 32, kb * 64, WOUT, nb * 32, scr, lane); continue; }
            r -= I_OUT;
            { const int kb = r / 32, nb = r % 32; transpose_item(wglu, 1024, 1024, nb * 32, kb * 64, WGLU, nb * 32, scr, lane); }
        }
    }
}

__device__ __forceinline__ void phase_b(KP kp, int layer, LAS unsigned char* lds, int lane, int wave, int bid, int G) {
    typedef short bf16x8_ __attribute__((ext_vector_type(8)));
    unsigned char* ws = kp->ws;
    const float* src_ctx = kp->in[2];
    const float* src_lat = kp->in[0];
    const float* mod = (const float*)(ws + WS_MOD) + (size_t)layer * 5 * 12288;
    const float* ng = kp->in[4] + (size_t)layer * DM;
    bf16* HN = (bf16*)(ws + WS_HN); bf16* P = (bf16*)(ws + WS_P); const bf16* WLR = (const bf16*)(ws + WS_WLR);
    LAS unsigned char* T = lds;
    LAS f32x4* red = (LAS f32x4*)(lds + 131072);
    const int q = lane >> 4, ii = lane & 15;
    for (int grp = bid; grp < MROWS / 16; grp += G) {
#pragma unroll
        for (int rr = 0; rr < 2; ++rr) {
            const int rl = 2 * wave + rr, row = grp * 16 + rl;
            const int b = row / LTOT, l = row % LTOT;
            const float* hrow = l < NCTX ? src_ctx + ((size_t)b * NCTX + l) * DM : src_lat + ((size_t)b * SEQ + (l - NCTX)) * DM;
            const float* md = mod + (size_t)(l < NCTX ? 4 : b) * 12288;
            f32x4 v[16]; float s = 0.f;
            const bool asm_ctx = (layer == 1 && G == 256 && l < NCTX);
            if (asm_ctx) { const float* crow = kp->in[2] + ((size_t)b * NCTX + l) * DM; const float* prow = (const float*)(ws + WS_CPART) + ((size_t)b * NCTX + l) * DM;
                const float* gt0 = (const float*)(ws + WS_MOD) + (size_t)4 * 12288 + 8192; const size_t qs = (size_t)NBATCH * NCTX * DM;
#pragma unroll
                for (int j = 0; j < 16; ++j) { const int col = 4 * (lane + 64 * j);
                    const f32x4 p4 = (*(const f32x4*)(prow + col) + *(const f32x4*)(prow + qs + col)) + (*(const f32x4*)(prow + 2 * qs + col) + *(const f32x4*)(prow + 3 * qs + col));
                    v[j] = *(const f32x4*)(crow + col) + *(const f32x4*)(gt0 + col) * p4; s += (v[j].x * v[j].x + v[j].y * v[j].y) + (v[j].z * v[j].z + v[j].w * v[j].w); }
            } else if (layer == 1) {
                const bf16* drow = l < NCTX ? (const bf16*)(ws + WS_HC) + ((size_t)b * NCTX + l) * DM : (const bf16*)(ws + WS_HL) + ((size_t)b * SEQ + (l - NCTX)) * DM;
#pragma unroll
                for (int j = 0; j < 16; ++j) { const int col = 4 * (lane + 64 * j); const v2u d2 = *(const v2u*)(drow + col);
                    v[j] = *(const f32x4*)(hrow + col) + (f32x4){lo_bf(d2.x), hi_bf(d2.x), lo_bf(d2.y), hi_bf(d2.y)}; s += (v[j].x * v[j].x + v[j].y * v[j].y) + (v[j].z * v[j].z + v[j].w * v[j].w); }
            } else {
#pragma unroll
                for (int j = 0; j < 16; ++j) { v[j] = *(const f32x4*)(hrow + 4 * (lane + 64 * j)); s += (v[j].x * v[j].x + v[j].y * v[j].y) + (v[j].z * v[j].z + v[j].w * v[j].w); }
            }
            s = wave_sum(s);
            const float rstd = 1.0f / sqrtf(s * (1.0f / DM) + EPSN);
#pragma unroll
            for (int j = 0; j < 16; ++j) { const int col = 4 * (lane + 64 * j);
                const f32x4 g4 = *(const f32x4*)(ng + col), sh = *(const f32x4*)(md + col), sc = *(const f32x4*)(md + DM + col);
                const f32x4 y = v[j] * rstd * g4 * (sc + 1.0f) + sh;
                v2u o; o.x = cvtpk(y.x, y.y); o.y = cvtpk(y.z, y.w);
                *(v2u*)(HN + (size_t)row * DM + col) = o;
                *(LAS v2u*)(T + rl * 8192 + ((((col >> 3) ^ rl) & 511) << 4) + ((col & 7) << 1)) = o; }
        }
        __syncthreads();
        f32x4 acc0 = (f32x4){0.f, 0.f, 0.f, 0.f}, acc1 = (f32x4){0.f, 0.f, 0.f, 0.f};
#pragma unroll 8
        for (int ks = 0; ks < 16; ++ks) { const int k0 = 512 * wave + 32 * ks + 8 * q;
            const bf16x8_ a = *(const LAS bf16x8_*)(T + ii * 8192 + ((((k0 >> 3) ^ ii) & 511) << 4));
            const bf16x8_ b0 = *(const bf16x8_*)(WLR + (size_t)ii * DM + k0), b1 = *(const bf16x8_*)(WLR + (size_t)(16 + ii) * DM + k0);
            acc0 = __builtin_amdgcn_mfma_f32_16x16x32_bf16(a, b0, acc0, 0, 0, 0); acc1 = __builtin_amdgcn_mfma_f32_16x16x32_bf16(a, b1, acc1, 0, 0, 0); }
        if (wave > 0) { red[((wave - 1) * 2 + 0) * 64 + lane] = acc0; red[((wave - 1) * 2 + 1) * 64 + lane] = acc1; }
        __syncthreads();
        if (wave == 0) {
#pragma unroll
            for (int w2 = 0; w2 < 7; ++w2) { acc0 = acc0 + red[(w2 * 2 + 0) * 64 + lane]; acc1 = acc1 + red[(w2 * 2 + 1) * 64 + lane]; }
            bf16* pr = P + P_LRB_OFF + (size_t)(grp * 16 + 4 * q) * 32 + ii;
            pr[0] = (bf16)f2bf(acc0.x); pr[32] = (bf16)f2bf(acc0.y); pr[64] = (bf16)f2bf(acc0.z); pr[96] = (bf16)f2bf(acc0.w);
            pr[16] = (bf16)f2bf(acc1.x); pr[48] = (bf16)f2bf(acc1.y); pr[80] = (bf16)f2bf(acc1.z); pr[112] = (bf16)f2bf(acc1.w);
        }
    }
    __syncthreads();
}

template <int MODE>
__device__ __forceinline__ void naive_lin_unit(KP kp, int layer, int b, int hd, int dir, LAS unsigned char* lds, int tid) {
    constexpr int DV = MODE == 0 ? 128 : 256, NPART = 512 / DV, ND = 128 / NPART;
    LAS float* qs = (LAS float*)lds; LAS float* ks = qs + 256; LAS float* dsv = ks + 256; LAS float* po = dsv + 256;
    const int e = tid % DV, part = tid / DV, d0 = part * ND;
    const bf16* P = (const bf16*)(kp->ws + WS_P); bf16* RAW = (bf16*)(kp->ws + WS_RAW) + (size_t)dir * MROWS * DM;
    float s[ND];
#pragma unroll
    for (int i = 0; i < ND; ++i) s[i] = 0.f;
    const int qcol = (MODE == 0 ? CA_Q : MODE == 1 ? CB_Q : CD_Q) + hd * 128;
    const int kcol = (MODE == 0 ? (dir ? CA_FB : CA_FF) : MODE == 1 ? CB_K : CD_K) + hd * 128;
    const int vcol = (MODE == 0 ? CA_I : MODE == 1 ? CB_V : CD_V) + hd * DV;
    const int ocol = (MODE == 0 ? 0 : MODE == 1 ? 1024 : 3072) + hd * DV;
    const int d = tid & 127;
    float lbv = 0.f, bias = 0.f, gam = 0.f, frq = 0.f, wg[16];
#pragma unroll
    for (int r = 0; r < 16; ++r) wg[r] = 0.f;
    if (tid < 128) {
        if (MODE == 0) { if (layer == 1) { const float* lbl = kp->in[8]; lbv = 1.0f / (1.0f + expf(-(lbl[(2 + dir) * 1024 + hd * 128 + d] - lbl[dir * 1024 + hd * 128 + d]))); } }
        if (MODE == 1) { const float* w = kp->in[10] + (size_t)(layer * 2 + dir) * 16 * 512 + hd * 128 + d;
#pragma unroll
            for (int r = 0; r < 16; ++r) wg[r] = w[r * 512];
            bias = kp->in[11][(layer * 2 + dir) * 512 + hd * 128 + d]; }
        if (MODE == 2) { gam = 1.0f / (1.0f + expf(-kp->in[23][(layer * 2 + dir) * 4 + hd])); frq = exp2f(-(float)(d & 31) * (13.287712379549449f / 32.0f)); }
    }
    for (int p = 0; p < LTOT; ++p) {
        const int l = dir ? flip_pos(p) : p; const size_t row = (size_t)b * LTOT + l; const bf16* pr = P + row * NP; const int buf = (p & 1) * 128;
        if (tid < 128) {
            float q, key, dec;
            if (MODE == 0) { q = bf2f(pr[qcol + d]); const float z = bf2f(pr[kcol + d]); const float sg = 1.0f / (1.0f + __expf(-z)), sgn = 1.0f / (1.0f + __expf(z));
                dec = fmaxf(lbv + (1.0f - lbv) * sg, 1e-6f); key = (1.0f - lbv) * sgn; }
            if (MODE == 1) { q = bf2f(pr[qcol + d]) * 0.08838834764831845f; key = bf2f(pr[kcol + d]); float x = bias;
#pragma unroll
                for (int r = 0; r < 16; ++r) x += bf2f(pr[CB_LF + dir * 16 + r]) * wg[r];
                dec = __expf(log_sigmoidf_(x) * (1.0f / 16.0f)); }
            if (MODE == 2) { const int j = d & 63; const float q1 = bf2f(pr[qcol + j]), q2 = bf2f(pr[qcol + j + 64]), k1 = bf2f(pr[kcol + j]), k2 = bf2f(pr[kcol + j + 64]);
                float cs = 1.f, sn = 0.f;
                if (l >= NCTX) { const int t = l - NCTX; const float pos = (float)((j < 32) ? (t >> 6) : (t & 63)); sincos_acc(pos * frq, sn, cs); }
                q = ((d < 64) ? (q1 * cs - q2 * sn) : (q1 * sn + q2 * cs)) * 0.08838834764831845f; key = (d < 64) ? (k1 * cs - k2 * sn) : (k1 * sn + k2 * cs); dec = gam; }
            qs[buf + d] = q; ks[buf + d] = key; dsv[buf + d] = dec;
        }
        const float v = bf2f(pr[vcol + e]);
        __syncthreads();
        float acc = 0.f;
#pragma unroll
        for (int i = 0; i < ND; ++i) { s[i] = dsv[buf + d0 + i] * s[i] + ks[buf + d0 + i] * v; acc += s[i] * qs[buf + d0 + i]; }
        po[part * 256 + e] = acc;
        __syncthreads();
        if (part == 0) { float tot = 0.f;
#pragma unroll
            for (int pp = 0; pp < NPART; ++pp) tot += po[pp * 256 + e];
            RAW[row * DM + ocol + e] = (bf16)f2bf(tot); }
    }
    __syncthreads();
}
constexpr int S5_BUS = 132, S5_XS = 136, S5_WAVE_BYTES = 16 * S5_BUS * 4 + 16 * S5_XS * 2;
__device__ __forceinline__ void s5_coef(KP kp, int ld, int g, int p, float& lbr, float& lbi, float& cr, float& ci) {
    const float lre = fminf(kp->in[13][(ld * 64 + g) * 64 + p], -1e-4f), lim = kp->in[14][(ld * 64 + g) * 64 + p];
    const float dt = expf(kp->in[15][ld * 64 + g]);
    const float xr_ = lre * dt, ang = lim * dt;
    float sn, cs, snh, csh; sincos_acc(ang, sn, cs); sincos_acc(0.5f * ang, snh, csh);
    const float mag = expf(xr_), em1 = expm1f(xr_);
    lbr = mag * cs; lbi = mag * sn;
    const float nr = em1 * cs - 2.0f * snh * snh, ni = mag * sn;
    const float den = lre * lre + lim * lim;
    cr = (nr * lre + ni * lim) / den; ci = (ni * lre - nr * lim) / den;
}
__device__ __forceinline__ void s5_unit(KP kp, int layer, int b, int g, int dir, LAS unsigned char* wlds, int lane) {
    typedef short bf16x8_ __attribute__((ext_vector_type(8)));
    typedef float f32x2s __attribute__((ext_vector_type(2)));
    const int ld = layer * 2 + dir; const int ii = lane & 15, q = lane >> 4;
    LAS float* BU = (LAS float*)wlds; LAS bf16* X = (LAS bf16*)(wlds + 16 * S5_BUS * 4);
    float lbr, lbi;
    { float cr_, ci_; s5_coef(kp, ld, g, lane, lbr, lbi, cr_, ci_); }
    bf16x8_ bA[8];
    {
        const float* bre = kp->in[16] + (size_t)(ld * 64 + g) * 64 * 16; const float* bim = kp->in[17] + (size_t)(ld * 64 + g) * 64 * 16;
#pragma unroll
        for (int mt = 0; mt < 8; ++mt) { const int p = 8 * mt + (ii >> 1); float l0, l1, cr, ci; s5_coef(kp, ld, g, p, l0, l1, cr, ci);
#pragma unroll
            for (int j = 0; j < 8; ++j) { const int h = 8 * (q & 1) + j; const float br = bre[p * 16 + h], bi = bim[p * 16 + h];
                const float v = (ii & 1) ? (cr * bi + ci * br) : (cr * br - ci * bi);
                const unsigned hv = f2bf(v); const unsigned lv = f2bf(v - __builtin_bit_cast(float, hv << 16));
                bA[mt][j] = (short)(q < 2 ? hv : lv); } }
    }
    bf16x8_ cA[4];
    {
        const float* cre = kp->in[18] + (size_t)(ld * 64 + g) * 16 * 64 + ii * 64; const float* cim = kp->in[19] + (size_t)(ld * 64 + g) * 16 * 64 + ii * 64;
#pragma unroll
        for (int ks = 0; ks < 4; ++ks)
#pragma unroll
            for (int j = 0; j < 8; ++j) { const int p = 16 * ks + 4 * q + (j >> 1); const float v = (j & 1) ? -cim[p] : cre[p]; cA[ks][j] = (short)f2bf(v); }
    }
    const bf16* P = (const bf16*)(kp->ws + WS_P); bf16* RAW = (bf16*)(kp->ws + WS_RAW) + (size_t)dir * MROWS * DM;
    float xr = 0.f, xi = 0.f;
    v4u ua, un;
#define S5_LOADA(dst, ti_) do { const int ps_ = 16 * (ti_) + ii; const int l_ = dir ? flip_pos(ps_) : ps_; dst = *(const v4u*)(P + p_off((size_t)b * LTOT + l_, CC_U + g * 16 + 8 * (q & 1))); } while (0)
    v4u un2;
    S5_LOADA(ua, 0); S5_LOADA(un, 1); un2 = un;
    for (int ti = 0; ti < LTOT / 16; ++ti) {
        if (ti + 2 < LTOT / 16) S5_LOADA(un2, ti + 2);
        const bf16x8_ uf = __builtin_bit_cast(bf16x8_, ua);
#pragma unroll
        for (int mt = 0; mt < 8; ++mt) { const f32x4 c4 = __builtin_amdgcn_mfma_f32_16x16x32_bf16(bA[mt], uf, ((f32x4){0.f, 0.f, 0.f, 0.f}), 0, 0, 0);
            *(LAS f32x4*)(BU + ii * S5_BUS + 16 * mt + 4 * q) = c4; }
        asm volatile("s_waitcnt lgkmcnt(0)" ::: "memory");
        f32x2s bu[16];
#pragma unroll
        for (int t = 0; t < 16; ++t) bu[t] = *(const LAS f32x2s*)(BU + t * S5_BUS + 2 * lane);
#pragma unroll
        for (int t = 0; t < 16; ++t) { const float nxr = lbr * xr - lbi * xi + bu[t].x, nxi = lbr * xi + lbi * xr + bu[t].y; xr = nxr; xi = nxi;
            *(LAS unsigned*)(X + t * S5_XS + 2 * lane) = cvtpk(xr, xi); }
        asm volatile("s_waitcnt lgkmcnt(0)" ::: "memory");
        f32x4 y = (f32x4){0.f, 0.f, 0.f, 0.f};
#pragma unroll
        for (int ks = 0; ks < 4; ++ks) { const bf16x8_ xb_ = *(const LAS bf16x8_*)(X + ii * S5_XS + 32 * ks + 8 * q); y = __builtin_amdgcn_mfma_f32_16x16x32_bf16(cA[ks], xb_, y, 0, 0, 0); }
        {
            const int ps_ = 16 * ti + ii; const int l_ = dir ? flip_pos(ps_) : ps_;
            v2u ov; ov.x = cvtpk(y.x, y.y); ov.y = cvtpk(y.z, y.w);
            *(v2u*)(RAW + ((size_t)b * LTOT + l_) * DM + 2048 + g * 16 + 4 * q) = ov;
        }
        asm volatile("s_waitcnt lgkmcnt(0)" ::: "memory");
        ua = un; un = un2;
    }
#undef S5_LOADA
}
typedef short bf16x8 __attribute__((ext_vector_type(8)));
#define MFMA16(a, b, c) __builtin_amdgcn_mfma_f32_16x16x32_bf16((a), (b), (c), 0, 0, 0)
constexpr int LA_SQ = 136, LA_SJ = 72;
constexpr int LA_QT = 0, LA_KT = LA_QT + 64 * LA_SQ * 2, LA_VR = LA_KT + 64 * LA_SQ * 2, LA_SB = LA_VR + 64 * LA_SQ * 2,
              LA_STT = LA_SB + 64 * LA_SJ * 2, LA_VEC = LA_STT + 128 * LA_SQ * 2, LA_AUX = LA_VEC + 256 * 4, LA_END = LA_AUX + 2 * 64 * 33 * 4;
static_assert(LA_END <= LDSCTL_OFF, "LA LDS map");
typedef short s16x4 __attribute__((ext_vector_type(4)));

__device__ __forceinline__ bf16x8 trfrag(const LAS bf16* base, int stride, int k0, int c0, int lane) {
    const LAS bf16* a = base + (k0 + 8 * (lane >> 4) + ((lane & 15) >> 2)) * stride + c0 + 4 * (lane & 3);
    const s16x4 lo = __builtin_amdgcn_ds_read_tr16_b64_v4i16((LAS s16x4*)a), hi = __builtin_amdgcn_ds_read_tr16_b64_v4i16((LAS s16x4*)(a + 4 * stride));
    return __builtin_shufflevector(lo, hi, 0, 1, 2, 3, 4, 5, 6, 7);
}
__device__ __forceinline__ bf16x8 ldfrag(const LAS bf16* base, int stride, int row0, int k0, int lane) {
    return *(const LAS bf16x8*)(base + (row0 + (lane & 15)) * stride + k0 + 8 * (lane >> 4));
}
template <int MODE>
__device__ __forceinline__ void la_unit(KP kp, int layer, int b, int hd, int dir, int half, LAS unsigned char* lds, int tid, int lane, int w) {
    LAS bf16* QT = (LAS bf16*)(lds + LA_QT); LAS bf16* KT = (LAS bf16*)(lds + LA_KT); LAS bf16* Vr = (LAS bf16*)(lds + LA_VR);
    LAS bf16* Sb = (LAS bf16*)(lds + LA_SB); LAS bf16* Stt = (LAS bf16*)(lds + LA_STT);
    LAS float* eref = (LAS float*)(lds + LA_VEC); LAS float* elast = eref + 128;
    LAS float* aux = (LAS float*)(lds + LA_AUX);
    const bf16* P = (const bf16*)(kp->ws + WS_P); bf16* RAW = (bf16*)(kp->ws + WS_RAW) + (size_t)dir * MROWS * DM;
    const int qcol = (MODE == 0 ? CA_Q : MODE == 1 ? CB_Q : CD_Q) + hd * 128;
    const int kcol = (MODE == 0 ? (dir ? CA_FB : CA_FF) : MODE == 1 ? CB_K : CD_K) + hd * 128;
    const int vcol = (MODE == 0 ? CA_I + hd * 128 : (MODE == 1 ? CB_V : CD_V) + hd * 256 + half * 128) + 16 * w;
    const int ocol = (MODE == 0 ? hd * 128 : (MODE == 1 ? 1024 : 3072) + hd * 256 + half * 128);
    const int c0 = 16 * w;
    const int j0 = 16 * (w & 3);
    float lg = 0.f;
    bf16x8 wA = (bf16x8){0, 0, 0, 0, 0, 0, 0, 0}; f32x4 bias4 = (f32x4){0.f, 0.f, 0.f, 0.f};
    if (MODE == 0) { const float* lbl = kp->in[8];
        if (tid < 128) { float v = 0.f; if (layer == 1) v = 1.0f / (1.0f + expf(-(lbl[(2 + dir) * 1024 + hd * 128 + tid] - lbl[dir * 1024 + hd * 128 + tid]))); aux[tid] = v; aux[128 + tid] = 1.0f - v; } }
    if (MODE == 1) { const float* wg = kp->in[10] + (size_t)(layer * 2 + dir) * 16 * 512 + hd * 128 + c0 + (lane & 15); const float* bg = kp->in[11] + (layer * 2 + dir) * 512 + hd * 128 + c0 + 4 * (lane >> 4);
        const int q_ = lane >> 4;
#pragma unroll
        for (int j = 0; j < 8; ++j) { const float wf = wg[(8 * (q_ & 1) + j) * 512]; const unsigned hi = f2bf(wf); const unsigned lo = f2bf(wf - __builtin_bit_cast(float, hi << 16)); wA[j] = (short)(q_ < 2 ? hi : lo); }
        bias4 = (f32x4){bg[0], bg[1], bg[2], bg[3]}; }
    if (MODE == 2) { lg = log_sigmoidf_(kp->in[23][(layer * 2 + dir) * 4 + hd]);
        for (int i = tid; i < 64 * 32; i += 512) { const int pos = i >> 5, jj = i & 31; float sn, cs; sincos_acc((float)pos * exp2f(-(float)jj * (13.287712379549449f / 32.0f)), sn, cs); aux[pos * 33 + jj] = cs; aux[64 * 33 + pos * 33 + jj] = sn; }
        if (tid < 128) { eref[tid] = expf(32.f * lg); elast[tid] = expf(32.f * lg); } }
    f32x4 st[8];
#pragma unroll
    for (int e = 0; e < 8; ++e) st[e] = (f32x4){0.f, 0.f, 0.f, 0.f};
    v4u pa[2], pb[2], pg[4], pv[2];
    pg[0] = pg[1] = pg[2] = pg[3] = (v4u){0u, 0u, 0u, 0u};
#define LA_PREFETCH(n) do { const int p_ = 64 * (n) + lane; const int l_ = dir ? flip_pos(p_) : p_; const bf16* pr_ = P + ((size_t)b * LTOT + l_) * NP; \
        if (MODE == 2) { const int xc_ = (w < 4 ? qcol : kcol) + j0; pa[0] = *(const v4u*)(pr_ + xc_); pa[1] = *(const v4u*)(pr_ + xc_ + 8); pb[0] = *(const v4u*)(pr_ + xc_ + 64); pb[1] = *(const v4u*)(pr_ + xc_ + 72); } \
        else { pa[0] = *(const v4u*)(pr_ + qcol + c0); pa[1] = *(const v4u*)(pr_ + qcol + c0 + 8); pb[0] = *(const v4u*)(pr_ + kcol + c0); pb[1] = *(const v4u*)(pr_ + kcol + c0 + 8); } \
        if (MODE == 1) { _Pragma("unroll") for (int nt_ = 0; nt_ < 4; ++nt_) { const int p2_ = 64 * (n) + 16 * nt_ + (lane & 15); const int l2_ = dir ? flip_pos(p2_) : p2_; \
            pg[nt_] = *(const v4u*)(P + ((size_t)b * LTOT + l2_) * NP + CB_LF + dir * 16 + 8 * ((lane >> 4) & 1)); } } \
        pv[0] = *(const v4u*)(pr_ + vcol); pv[1] = *(const v4u*)(pr_ + vcol + 8); } while (0)
    LA_PREFETCH(0);
    __syncthreads();
    const int it = w >> 1;
    for (int n = 0; n < LTOT / 64; ++n) {
        {
            float xa[16], xb[16];
            unpack8(pa[0], xa); unpack8(pa[1], xa + 8); unpack8(pb[0], xb); unpack8(pb[1], xb + 8);
            if (MODE == 2) {
                const int p_ = 64 * n + lane; const int l_ = dir ? flip_pos(p_) : p_;
                const bool lat = l_ >= NCTX; const int t_ = l_ - NCTX; const int pos = (j0 < 32) ? (t_ >> 6) : (t_ & 63);
                const float dq = (w < 4) ? __expf((float)(lane - 31) * lg) * 0.08838834764831845f : __expf((float)(31 - lane) * lg);
                float o1[16], o2[16];
#pragma unroll
                for (int c = 0; c < 16; ++c) { float cs = 1.f, sn = 0.f; if (lat) { cs = aux[pos * 33 + ((j0 + c) & 31)]; sn = aux[64 * 33 + pos * 33 + ((j0 + c) & 31)]; }
                    o1[c] = (xa[c] * cs - xb[c] * sn) * dq; o2[c] = (xa[c] * sn + xb[c] * cs) * dq; }
                LAS bf16* T = (w < 4) ? QT : KT;
                *(LAS v4u*)(T + lane * LA_SQ + j0) = pack8c(o1); *(LAS v4u*)(T + lane * LA_SQ + j0 + 8) = pack8c(o1 + 8);
                *(LAS v4u*)(T + lane * LA_SQ + 64 + j0) = pack8c(o2); *(LAS v4u*)(T + lane * LA_SQ + 64 + j0 + 8) = pack8c(o2 + 8);
            } else {
                float g[16];
                if (MODE == 0) {
#pragma unroll
                    for (int c = 0; c < 16; ++c) { const float z = xb[c]; const float e = __expf(-fabsf(z)); const float r = __builtin_amdgcn_rcpf(1.0f + e);
                        const float sp = z >= 0.f ? r : e * r, sn = z >= 0.f ? e * r : r;
                        const float lb_ = aux[c0 + c], om_ = aux[128 + c0 + c];
                        g[c] = __logf(fmaxf(lb_ + om_ * sp, 1e-6f)); xb[c] = om_ * sn; }
                } else {
                    LAS float* XL = (LAS float*)(lds + LA_STT);
#pragma unroll
                    for (int nt = 0; nt < 4; ++nt) { f32x4 x = MFMA16(wA, __builtin_bit_cast(bf16x8, pg[nt]), ((f32x4){0.f, 0.f, 0.f, 0.f})); x = x + bias4;
                        f32x4 gg; gg.x = (fminf(x.x, 0.f) - __logf(1.0f + __expf(-fabsf(x.x)))) * (1.0f / 16.0f); gg.y = (fminf(x.y, 0.f) - __logf(1.0f + __expf(-fabsf(x.y)))) * (1.0f / 16.0f);
                        gg.z = (fminf(x.z, 0.f) - __logf(1.0f + __expf(-fabsf(x.z)))) * (1.0f / 16.0f); gg.w = (fminf(x.w, 0.f) - __logf(1.0f + __expf(-fabsf(x.w)))) * (1.0f / 16.0f);
                        *(LAS f32x4*)(XL + (16 * nt + (lane & 15)) * 132 + c0 + 4 * (lane >> 4)) = gg; }
                    asm volatile("s_waitcnt lgkmcnt(0)" ::: "memory");
#pragma unroll
                    for (int c4 = 0; c4 < 4; ++c4) { const f32x4 t = *(const LAS f32x4*)(XL + lane * 132 + c0 + 4 * c4); g[4 * c4] = t.x; g[4 * c4 + 1] = t.y; g[4 * c4 + 2] = t.z; g[4 * c4 + 3] = t.w; }
#pragma unroll
                    for (int c = 0; c < 16; ++c) xa[c] *= 0.08838834764831845f;
                }
#pragma unroll
                for (int c = 0; c < 16; ++c) { const float bc = lane_scan(g[c], lane); const float br = __shfl(bc, 31), bl = __shfl(bc, 63);
                    xa[c] = xa[c] * __expf(bc - br); xb[c] = xb[c] * __expf(br - bc);
                    if (lane == 0) { eref[c0 + c] = __expf(br); elast[c0 + c] = __expf(bl - br); } }
                *(LAS v4u*)(QT + lane * LA_SQ + c0) = pack8c(xa); *(LAS v4u*)(QT + lane * LA_SQ + c0 + 8) = pack8c(xa + 8);
                *(LAS v4u*)(KT + lane * LA_SQ + c0) = pack8c(xb); *(LAS v4u*)(KT + lane * LA_SQ + c0 + 8) = pack8c(xb + 8);
            }
            *(LAS v4u*)(Vr + lane * LA_SQ + 16 * w) = pv[0]; *(LAS v4u*)(Vr + lane * LA_SQ + 16 * w + 8) = pv[1];
        }
        __syncthreads();
        bf16x8 qa[4];
        {
            const f32x4 er = *(const LAS f32x4*)(eref + 16 * w + 4 * (lane >> 4));
#pragma unroll
            for (int e = 0; e < 8; ++e) { st[e] = st[e] * er;
                v2u o; o.x = cvtpk(st[e].x, st[e].y); o.y = cvtpk(st[e].z, st[e].w);
                *(LAS v2u*)(Stt + (16 * e + (lane & 15)) * LA_SQ + 16 * w + 4 * (lane >> 4)) = o; }
#pragma unroll
            for (int ks = 0; ks < 4; ++ks) qa[ks] = ldfrag(QT, LA_SQ, 16 * it, 32 * ks, lane);
#pragma unroll
            for (int t = 0; t < 2; ++t) { const int jt = 2 * (w & 1) + t; f32x4 s = (f32x4){0.f, 0.f, 0.f, 0.f};
                if (jt <= it) {
#pragma unroll
                    for (int ks = 0; ks < 4; ++ks) s = MFMA16(ldfrag(KT, LA_SQ, 16 * jt, 32 * ks, lane), qa[ks], s); }
                const int i = 16 * it + (lane & 15), jb = 16 * jt + 4 * (lane >> 4);
                v2u o; o.x = cvtpk(jb <= i ? s.x : 0.f, jb + 1 <= i ? s.y : 0.f); o.y = cvtpk(jb + 2 <= i ? s.z : 0.f, jb + 3 <= i ? s.w : 0.f);
                *(LAS v2u*)(Sb + i * LA_SJ + jb) = o; }
        }
        __syncthreads();
        if (n + 1 < LTOT / 64) LA_PREFETCH(n + 1);
        {
            const bf16x8 sb0 = ldfrag(Sb, LA_SJ, 16 * it, 0, lane), sb1 = ldfrag(Sb, LA_SJ, 16 * it, 32, lane);
            const int p_ = 64 * n + 16 * it + (lane & 15); const int l_ = dir ? flip_pos(p_) : p_;
            bf16* orow = RAW + ((size_t)b * LTOT + l_) * DM + ocol + 4 * (lane >> 4);
#pragma unroll
            for (int t = 0; t < 4; ++t) { const int et = 4 * (w & 1) + t; f32x4 o = (f32x4){0.f, 0.f, 0.f, 0.f};
                o = MFMA16(trfrag(Vr, LA_SQ, 0, 16 * et, lane), sb0, o);
                if (it >= 2) o = MFMA16(trfrag(Vr, LA_SQ, 32, 16 * et, lane), sb1, o);
#pragma unroll
                for (int ks = 0; ks < 4; ++ks) o = MFMA16(ldfrag(Stt, LA_SQ, 16 * et, 32 * ks, lane), qa[ks], o);
                v2u ov; ov.x = cvtpk(o.x, o.y); ov.y = cvtpk(o.z, o.w);
                *(v2u*)(orow + 16 * et) = ov; }
            const bf16x8 ka0 = trfrag(KT, LA_SQ, 0, 16 * w, lane), ka1 = trfrag(KT, LA_SQ, 32, 16 * w, lane);
            const f32x4 el = *(const LAS f32x4*)(elast + 16 * w + 4 * (lane >> 4));
#pragma unroll
            for (int e = 0; e < 8; ++e) { st[e] = MFMA16(ka0, trfrag(Vr, LA_SQ, 0, 16 * e, lane), st[e]); st[e] = MFMA16(ka1, trfrag(Vr, LA_SQ, 32, 16 * e, lane), st[e]); st[e] = st[e] * el; }
        }
        __syncthreads();
    }
#undef LA_PREFETCH
}
constexpr int L2_IMG = 64 * LA_SQ * 2;
constexpr int L2_BUF = 3 * L2_IMG;
constexpr int L2_SB = 2 * L2_BUF, L2_VEC = L2_SB + 64 * LA_SJ * 2, L2_AUX = L2_VEC + 2 * 256 * 4, L2_TMP = L2_AUX + 4 * 64 * 20 * 4, L2_END = L2_TMP + 4 * 32 * 4;
static_assert(L2_END <= LDSCTL_OFF && 2 * 64 * 33 * 4 <= 4 * 64 * 20 * 4, "LA2 LDS map");
constexpr float LOG2E_F = 1.4426950408889634f;
__device__ __forceinline__ float ex2(float x) { return __builtin_amdgcn_exp2f(x); }
__device__ __forceinline__ float lg2(float x) { return __builtin_amdgcn_logf(x); }
__device__ __forceinline__ float mulA(float a, float b) { return a * b; }
__device__ __forceinline__ float mulB(float a, float b) { return __builtin_fmaf(a, b, 0.0f); }
__device__ __forceinline__ f32x4 mulx4(f32x4 a, f32x4 b) { return (f32x4){mulA(a.x, b.x), mulB(a.y, b.y), mulA(a.z, b.z), mulB(a.w, b.w)}; }
__device__ __forceinline__ float rdlane(float x, int l) { return __builtin_bit_cast(float, __builtin_amdgcn_readlane(__builtin_bit_cast(int, x), l)); }
#define L2_DPP1(n) "v_add_f32_dpp %" #n ", %" #n ", %" #n " "
#define L2_DPP16(g, ctl) asm volatile("s_nop 1\n" L2_DPP1(0) ctl "\n" L2_DPP1(1) ctl "\n" L2_DPP1(2) ctl "\n" L2_DPP1(3) ctl "\n" L2_DPP1(4) ctl "\n" L2_DPP1(5) ctl "\n" L2_DPP1(6) ctl "\n" L2_DPP1(7) ctl "\n" \
        L2_DPP1(8) ctl "\n" L2_DPP1(9) ctl "\n" L2_DPP1(10) ctl "\n" L2_DPP1(11) ctl "\n" L2_DPP1(12) ctl "\n" L2_DPP1(13) ctl "\n" L2_DPP1(14) ctl "\n" L2_DPP1(15) ctl "\n s_nop 1" \
        : "+v"(g[0]), "+v"(g[1]), "+v"(g[2]), "+v"(g[3]), "+v"(g[4]), "+v"(g[5]), "+v"(g[6]), "+v"(g[7]), "+v"(g[8]), "+v"(g[9]), "+v"(g[10]), "+v"(g[11]), "+v"(g[12]), "+v"(g[13]), "+v"(g[14]), "+v"(g[15]))
#define L2_TRANSPOSE16(x) asm volatile("s_nop 1\n\tv_permlane32_swap_b32 %0, %8\n\tv_permlane32_swap_b32 %4, %12\n\tv_permlane32_swap_b32 %1, %9\n\tv_permlane32_swap_b32 %5, %13\n\tv_permlane32_swap_b32 %2, %10\n\tv_permlane32_swap_b32 %6, %14\n\tv_permlane32_swap_b32 %3, %11\n\tv_permlane32_swap_b32 %7, %15\n\tv_permlane16_swap_b32 %0, %4\n\tv_permlane16_swap_b32 %8, %12\n\tv_permlane16_swap_b32 %1, %5\n\tv_permlane16_swap_b32 %9, %13\n\tv_permlane16_swap_b32 %2, %6\n\tv_permlane16_swap_b32 %10, %14\n\tv_permlane16_swap_b32 %3, %7\n\tv_permlane16_swap_b32 %11, %15\n\ts_nop 1" : "+v"(x[0][0]), "+v"(x[0][1]), "+v"(x[0][2]), "+v"(x[0][3]), "+v"(x[1][0]), "+v"(x[1][1]), "+v"(x[1][2]), "+v"(x[1][3]), "+v"(x[2][0]), "+v"(x[2][1]), "+v"(x[2][2]), "+v"(x[2][3]), "+v"(x[3][0]), "+v"(x[3][1]), "+v"(x[3][2]), "+v"(x[3][3]))
#define L2_BAR() do { asm volatile("s_waitcnt lgkmcnt(0)" ::: "memory"); __builtin_amdgcn_s_barrier(); asm volatile("" ::: "memory"); } while (0)

template <int MODE>
__device__ __forceinline__ void la_unit2(KP kp, int layer, int b, int hd, int dir, int half, LAS unsigned char* lds, int tid, int lane, int w) {
    LAS bf16* Sb = (LAS bf16*)(lds + L2_SB);
    LAS float* vec = (LAS float*)(lds + L2_VEC);
    LAS float* aux = (LAS float*)(lds + L2_AUX);
    const bf16* P = (const bf16*)(kp->ws + WS_P); bf16* RAW = (bf16*)(kp->ws + WS_RAW) + (size_t)dir * MROWS * DM;
    const bf16* Pb = P + (size_t)((MODE == 0 ? 0 : MODE == 1 ? 10 : 20) + hd) * P_BLK_ELEMS;
    const int qcol = 0;
    const int kcol = (MODE == 0 ? (dir ? 256 : 128) : 128);
    const int vcol0 = (MODE == 0 ? 384 : 256 + half * 128);
    const int ocol = (MODE == 0 ? hd * 128 : (MODE == 1 ? 1024 : 3072) + hd * 256 + half * 128);
    const int NCH = LTOT / 64;
    float lg = 0.f;
    if (MODE == 0) { const float* lbl = kp->in[8];
        if (tid < 128) { float v = 0.f; if (layer == 1) v = 1.0f / (1.0f + expf(-(lbl[(2 + dir) * 1024 + hd * 128 + tid] - lbl[dir * 1024 + hd * 128 + tid]))); aux[tid] = v; aux[128 + tid] = 1.0f - v; } }
    if (MODE == 2) { lg = log_sigmoidf_(kp->in[23][(layer * 2 + dir) * 4 + hd]) * LOG2E_F;
        for (int i = tid; i < 64 * 32; i += 512) { const int pos = i >> 5, jj = i & 31; float sn, cs; sincos_acc((float)pos * exp2f(-(float)jj * (13.287712379549449f / 32.0f)), sn, cs); aux[pos * 33 + jj] = cs; aux[64 * 33 + pos * 33 + jj] = sn; }
        if (tid < 256) { vec[tid] = exp2f(32.f * lg); vec[256 + tid] = exp2f(32.f * lg); } }
    __syncthreads();
    if (w < 4) {
        const int pw = w;
        const int cbase = 32 * pw;
        const int isk = pw >> 1, jb = 32 * (pw & 1);
        bf16x8 wA[2]; f32x4 bias4[2];
        wA[0] = wA[1] = (bf16x8){0, 0, 0, 0, 0, 0, 0, 0}; bias4[0] = bias4[1] = (f32x4){0.f, 0.f, 0.f, 0.f};
        if (MODE == 1) {
#pragma unroll
            for (int grp = 0; grp < 2; ++grp) { const int c0 = cbase + 16 * grp;
                const float* wg = kp->in[10] + (size_t)(layer * 2 + dir) * 16 * 512 + hd * 128 + c0 + (lane & 15); const float* bg = kp->in[11] + (layer * 2 + dir) * 512 + hd * 128 + c0 + 4 * (lane >> 4);
                const int q_ = lane >> 4;
#pragma unroll
                for (int j = 0; j < 8; ++j) { const float wf = wg[(8 * (q_ & 1) + j) * 512] * LOG2E_F;        const unsigned hi = f2bf(wf); const unsigned lo = f2bf(wf - __builtin_bit_cast(float, hi << 16)); wA[grp][j] = (short)(q_ < 2 ? hi : lo); }
                bias4[grp] = (f32x4){bg[0] * LOG2E_F, bg[1] * LOG2E_F, bg[2] * LOG2E_F, bg[3] * LOG2E_F}; }
        }
        v4u pa[4], pb[4], pv[4], pg[4], na[4], nb_[4], nv[4], ng[4];
        pg[0] = pg[1] = pg[2] = pg[3] = (v4u){0u, 0u, 0u, 0u}; ng[0] = ng[1] = ng[2] = ng[3] = (v4u){0u, 0u, 0u, 0u};
#define L2_PREFETCH(n, pa, pb, pv, pg) do { const int p_ = 64 * (n) + lane; const int l_ = dir ? flip_pos(p_) : p_; const bf16* pr_ = Pb + ((size_t)b * LTOT + l_) * 512; \
            const int ac_ = (MODE == 2) ? ((isk ? kcol : qcol) + jb) : (qcol + cbase); const int bc_ = (MODE == 2) ? ac_ + 64 : (kcol + cbase); \
            _Pragma("unroll") for (int k_ = 0; k_ < 4; ++k_) { pa[k_] = *(const v4u*)(pr_ + ac_ + 8 * k_); pb[k_] = *(const v4u*)(pr_ + bc_ + 8 * k_); pv[k_] = *(const v4u*)(pr_ + vcol0 + 32 * pw + 8 * k_); } \
            if (MODE == 1) { _Pragma("unroll") for (int nt_ = 0; nt_ < 4; ++nt_) { const int p2_ = 64 * (n) + 16 * nt_ + (lane & 15); const int l2_ = dir ? flip_pos(p2_) : p2_; \
                pg[nt_] = *(const v4u*)(P + P_LRB_OFF + ((size_t)b * LTOT + l2_) * 32 + dir * 16 + 8 * ((lane >> 4) & 1)); } } } while (0)
#define L2_GROUP(n, bi, grp) do { \
            LAS bf16* QT_ = (LAS bf16*)(lds + (bi) * L2_BUF); LAS bf16* KT_ = QT_ + 64 * LA_SQ; LAS float* ev_ = vec + (bi) * 256; \
            float xa[16], xb[16]; unpack8(pa[2 * (grp)], xa); unpack8(pa[2 * (grp) + 1], xa + 8); unpack8(pb[2 * (grp)], xb); unpack8(pb[2 * (grp) + 1], xb + 8); \
            if (MODE == 2) { \
                const int p_ = 64 * (n) + lane; const int l_ = dir ? flip_pos(p_) : p_; const bool lat = l_ >= NCTX; const int t_ = l_ - NCTX; const int pos = (jb < 32) ? (t_ >> 6) : (t_ & 63); \
                const float dq = isk ? ex2((float)(31 - lane) * lg) : ex2((float)(lane - 31) * lg) * 0.08838834764831845f; \
                const int j0_ = jb + 16 * (grp); float o1[16], o2[16]; \
                _Pragma("unroll") for (int c = 0; c < 16; ++c) { float cs = 1.f, sn = 0.f; if (lat) { cs = aux[pos * 33 + ((j0_ + c) & 31)]; sn = aux[64 * 33 + pos * 33 + ((j0_ + c) & 31)]; } \
                    o1[c] = (xa[c] * cs - xb[c] * sn) * dq; o2[c] = (xa[c] * sn + xb[c] * cs) * dq; } \
                LAS bf16* T_ = isk ? KT_ : QT_; \
                *(LAS v4u*)(T_ + lane * LA_SQ + j0_) = pack8c(o1); *(LAS v4u*)(T_ + lane * LA_SQ + j0_ + 8) = pack8c(o1 + 8); \
                *(LAS v4u*)(T_ + lane * LA_SQ + 64 + j0_) = pack8c(o2); *(LAS v4u*)(T_ + lane * LA_SQ + 64 + j0_ + 8) = pack8c(o2 + 8); \
            } else { \
                const int c0_ = cbase + 16 * (grp); float g[16]; \
                if (MODE == 0) { \
                    _Pragma("unroll") for (int c = 0; c < 16; ++c) { const float r = __builtin_amdgcn_rcpf(1.0f + ex2(xb[c]));        \
                        const float lb_ = aux[c0_ + c], om_ = aux[128 + c0_ + c]; \
                        g[c] = lg2(fmaxf(fmaf(om_, r, lb_), 1e-6f)); xb[c] = (c & 1) ? mulA(om_, 1.0f - r) : fmaf(-om_, r, om_); }                                          \
                } else { \
                    float gx[4][4];                                      \
                    _Pragma("unroll") for (int nt = 0; nt < 4; ++nt) { const f32x4 x = MFMA16(wA[grp], __builtin_bit_cast(bf16x8, pg[nt]), bias4[grp]);       \
                        gx[nt][0] = mulA(lg2(1.0f + ex2(-fmaxf(x.x, -100.0f))), -1.0f / 16.0f); gx[nt][1] = mulB(lg2(__builtin_fmaf(ex2(-fmaxf(x.y, -100.0f)), 1.0f, 1.0f)), -1.0f / 16.0f); \
                        gx[nt][2] = mulA(lg2(1.0f + ex2(-fmaxf(x.z, -100.0f))), -1.0f / 16.0f); gx[nt][3] = mulB(lg2(__builtin_fmaf(ex2(-fmaxf(x.w, -100.0f)), 1.0f, 1.0f)), -1.0f / 16.0f); } \
                      \
                    L2_TRANSPOSE16(gx); \
                    _Pragma("unroll") for (int c4 = 0; c4 < 4; ++c4) { g[4 * c4] = gx[c4][0]; g[4 * c4 + 1] = gx[c4][1]; g[4 * c4 + 2] = gx[c4][2]; g[4 * c4 + 3] = gx[c4][3]; } \
                } \
                _Pragma("unroll") for (int c = 0; c < 16; ++c) g[c] += dpp_f<0x111, 0xf>(g[c]);        \
                _Pragma("unroll") for (int c = 0; c < 16; ++c) g[c] += dpp_f<0x112, 0xf>(g[c]); \
                _Pragma("unroll") for (int c = 0; c < 16; ++c) g[c] += dpp_f<0x114, 0xf>(g[c]); \
                _Pragma("unroll") for (int c = 0; c < 16; ++c) g[c] += dpp_f<0x118, 0xf>(g[c]); \
                L2_DPP16(g, "row_bcast:15 row_mask:0xa bank_mask:0xf"); L2_DPP16(g, "row_bcast:31 row_mask:0xc bank_mask:0xf");     \
                LAS float* tp_ = (LAS float*)(lds + L2_TMP) + pw * 32;      \
                if ((lane & 31) == 31) { LAS float* t2_ = tp_ + (lane >> 5) * 16; \
                    *(LAS f32x4*)(t2_) = (f32x4){g[0], g[1], g[2], g[3]}; *(LAS f32x4*)(t2_ + 4) = (f32x4){g[4], g[5], g[6], g[7]}; *(LAS f32x4*)(t2_ + 8) = (f32x4){g[8], g[9], g[10], g[11]}; *(LAS f32x4*)(t2_ + 12) = (f32x4){g[12], g[13], g[14], g[15]}; } \
                _Pragma("unroll") for (int c = 0; c < 16; ++c) { const float d_ = g[c] - rdlane(g[c], 31); if (c & 1) { xa[c] = mulB(xa[c], ex2(d_)); xb[c] = mulB(xb[c], ex2(-d_)); } else { xa[c] = mulA(xa[c], ex2(d_)); xb[c] = mulA(xb[c], ex2(-d_)); } } \
                *(LAS v4u*)(QT_ + lane * LA_SQ + c0_) = pack8c(xa); *(LAS v4u*)(QT_ + lane * LA_SQ + c0_ + 8) = pack8c(xa + 8); \
                *(LAS v4u*)(KT_ + lane * LA_SQ + c0_) = pack8c(xb); *(LAS v4u*)(KT_ + lane * LA_SQ + c0_ + 8) = pack8c(xb + 8); \
                if (lane < 16) { const float br_ = tp_[lane], bl_ = tp_[16 + lane]; ev_[c0_ + lane] = ex2(br_); ev_[128 + c0_ + lane] = ex2(bl_ - br_); } \
            } } while (0)
#define L2_VALUES(bi) do { LAS bf16* VR_ = (LAS bf16*)(lds + (bi) * L2_BUF) + 2 * 64 * LA_SQ; \
            _Pragma("unroll") for (int k_ = 0; k_ < 4; ++k_) *(LAS v4u*)(VR_ + lane * LA_SQ + 32 * pw + 8 * k_) = pv[k_]; } while (0)
        L2_PREFETCH(0, pa, pb, pv, pg);
        L2_PREFETCH(1, na, nb_, nv, ng);
        L2_GROUP(0, 0, 0); L2_GROUP(0, 0, 1); L2_VALUES(0);
#define L2_ROTATE() do { _Pragma("unroll") for (int k_ = 0; k_ < 4; ++k_) { pa[k_] = na[k_]; pb[k_] = nb_[k_]; pv[k_] = nv[k_]; pg[k_] = ng[k_]; } } while (0)
        L2_ROTATE();
        L2_PREFETCH(2, na, nb_, nv, ng);
        L2_BAR();
        for (int n = 0; n < NCH; ++n) {
            const int nb = (n + 1) & 1;
            if (n + 1 < NCH) { L2_GROUP(n + 1, nb, 0); }
            L2_BAR();
            if (n + 1 < NCH) { L2_GROUP(n + 1, nb, 1); L2_VALUES(nb); }
            L2_ROTATE();
            if (n + 3 < NCH) L2_PREFETCH(n + 3, na, nb_, nv, ng);
            L2_BAR();
        }
#undef L2_ROTATE
#undef L2_PREFETCH
#undef L2_GROUP
#undef L2_VALUES
    } else {
        const int cw = w - 4; const int q = lane >> 4, ii = lane & 15;
        f32x4 st[2][8];
#pragma unroll
        for (int et = 0; et < 2; ++et)
#pragma unroll
            for (int dt = 0; dt < 8; ++dt) st[et][dt] = (f32x4){0.f, 0.f, 0.f, 0.f};
        v2u ovb[8]; bf16* oaddr[4];
#pragma unroll
        for (int t = 0; t < 8; ++t) ovb[t] = (v2u){0u, 0u};
#pragma unroll
        for (int t = 0; t < 4; ++t) oaddr[t] = RAW;
        L2_BAR();
        for (int n = 0; n < NCH; ++n) {
            const int bi = n & 1;
            const LAS bf16* QT = (const LAS bf16*)(lds + bi * L2_BUF); const LAS bf16* KT = QT + 64 * LA_SQ; const LAS bf16* Vr = KT + 64 * LA_SQ; const LAS float* ev = vec + bi * 256;
            {
                bf16x8 qa[4];
#pragma unroll
                for (int ks = 0; ks < 4; ++ks) qa[ks] = ldfrag(QT, LA_SQ, 16 * cw, 32 * ks, lane);
#pragma unroll
                for (int jt = 0; jt < 4; ++jt) { f32x4 s = (f32x4){0.f, 0.f, 0.f, 0.f};
                    if (jt <= cw) {
#pragma unroll
                        for (int ks = 0; ks < 4; ++ks) s = MFMA16(ldfrag(KT, LA_SQ, 16 * jt, 32 * ks, lane), qa[ks], s); }
                    const int i = 16 * cw + ii, jbb = 16 * jt + 4 * q;
                    v2u o; o.x = cvtpk(jbb <= i ? s.x : 0.f, jbb + 1 <= i ? s.y : 0.f); o.y = cvtpk(jbb + 2 <= i ? s.z : 0.f, jbb + 3 <= i ? s.w : 0.f);
                    *(LAS v2u*)(Sb + i * LA_SJ + jbb) = o; }
            }
            f32x4 o[2][4];
#pragma unroll
            for (int et = 0; et < 2; ++et)
#pragma unroll
                for (int t = 0; t < 4; ++t) o[et][t] = (f32x4){0.f, 0.f, 0.f, 0.f};
#pragma unroll
            for (int ks = 0; ks < 4; ++ks) {
                const f32x4 e0 = *(const LAS f32x4*)(ev + 32 * ks + 4 * q), e1 = *(const LAS f32x4*)(ev + 32 * ks + 16 + 4 * q);
                bf16x8 sa[2];
#pragma unroll
                for (int et = 0; et < 2; ++et) { st[et][2 * ks] = mulx4(st[et][2 * ks], e0); st[et][2 * ks + 1] = mulx4(st[et][2 * ks + 1], e1);
                    v4u pk_; pk_.x = cvtpk(st[et][2 * ks].x, st[et][2 * ks].y); pk_.y = cvtpk(st[et][2 * ks].z, st[et][2 * ks].w); pk_.z = cvtpk(st[et][2 * ks + 1].x, st[et][2 * ks + 1].y); pk_.w = cvtpk(st[et][2 * ks + 1].z, st[et][2 * ks + 1].w);
                    sa[et] = __builtin_bit_cast(bf16x8, pk_); }
#pragma unroll
                for (int t = 0; t < 4; ++t) { const LAS bf16* qp = QT + (16 * t + ii) * LA_SQ + 32 * ks + 4 * q;
                    const v2u lo = *(const LAS v2u*)qp, hi = *(const LAS v2u*)(qp + 16);
                    v4u bq; bq.x = lo.x; bq.y = lo.y; bq.z = hi.x; bq.w = hi.y;
                    const bf16x8 qb = __builtin_bit_cast(bf16x8, bq);
                    o[0][t] = MFMA16(sa[0], qb, o[0][t]); o[1][t] = MFMA16(sa[1], qb, o[1][t]); }
            }
            L2_BAR();
            bf16x8 va[2][2];
#pragma unroll
            for (int et = 0; et < 2; ++et)
#pragma unroll
                for (int ks = 0; ks < 2; ++ks) {
                    const LAS bf16* a_ = Vr + (32 * ks + 8 * (lane >> 4) + ((lane & 15) >> 2)) * LA_SQ + 32 * cw + 8 * (lane & 3) + 4 * et;
                    const s16x4 lo_ = __builtin_amdgcn_ds_read_tr16_b64_v4i16((LAS s16x4*)a_), hi_ = __builtin_amdgcn_ds_read_tr16_b64_v4i16((LAS s16x4*)(a_ + 4 * LA_SQ));
                    va[et][ks] = __builtin_shufflevector(lo_, hi_, 0, 1, 2, 3, 4, 5, 6, 7); }
#pragma unroll
            for (int t = 0; t < 4; ++t) {
                const bf16x8 s0 = ldfrag(Sb, LA_SJ, 16 * t, 0, lane);
                o[0][t] = MFMA16(va[0][0], s0, o[0][t]); o[1][t] = MFMA16(va[1][0], s0, o[1][t]);
                if (t >= 2) { const bf16x8 s1 = ldfrag(Sb, LA_SJ, 16 * t, 32, lane); o[0][t] = MFMA16(va[0][1], s1, o[0][t]); o[1][t] = MFMA16(va[1][1], s1, o[1][t]); }
            }
#pragma unroll
            for (int t = 0; t < 4; ++t) { asm volatile("" :: "v"(ovb[2 * t]), "v"(ovb[2 * t + 1]), "v"(oaddr[t])); }
#pragma unroll
            for (int t = 0; t < 4; ++t) {
                const int p_ = 64 * n + 16 * t + ii; const int l_ = dir ? flip_pos(p_) : p_;
                oaddr[t] = RAW + ((size_t)b * LTOT + l_) * DM + ocol + 32 * cw + 8 * q;
                ovb[2 * t].x = cvtpk(o[0][t].x, o[0][t].y); ovb[2 * t].y = cvtpk(o[0][t].z, o[0][t].w);
                ovb[2 * t + 1].x = cvtpk(o[1][t].x, o[1][t].y); ovb[2 * t + 1].y = cvtpk(o[1][t].z, o[1][t].w);
                { v4u w4; w4.x = ovb[2 * t].x; w4.y = ovb[2 * t].y; w4.z = ovb[2 * t + 1].x; w4.w = ovb[2 * t + 1].y; *(v4u*)oaddr[t] = w4; }
            }
#pragma unroll
            for (int dt = 0; dt < 8; ++dt) {
                const bf16x8 k0 = trfrag(KT, LA_SQ, 0, 16 * dt, lane), k1 = trfrag(KT, LA_SQ, 32, 16 * dt, lane);
                const f32x4 el = *(const LAS f32x4*)(ev + 128 + 16 * dt + 4 * q);
#pragma unroll
                for (int et = 0; et < 2; ++et) { st[et][dt] = MFMA16(k0, va[et][0], st[et][dt]); st[et][dt] = MFMA16(k1, va[et][1], st[et][dt]); st[et][dt] = mulx4(st[et][dt], el); }
            }
            L2_BAR();
        }
    }
    __syncthreads();
}

#define LA_TIDS() int t2 = threadIdx.x; asm volatile("" : "+v"(t2)); const int ln2 = t2 & 63, wv2 = __builtin_amdgcn_readfirstlane(t2 >> 6)
__device__ __forceinline__ void phase_d(int layer, LAS unsigned char* lds, int bid, int G) {
    for (int u0 = bid; u0 < 256; u0 += G) {
        int u = (G == 256) ? ((u0 & ~63) | ((u0 & 7) << 3) | ((u0 >> 3) & 7)) : u0; asm volatile("" : "+s"(u));
        if (u < 64) { LA_TIDS(); la_unit2<0>(KARGS(), layer, u >> 4, (u >> 1) & 7, u & 1, 0, lds, t2, ln2, wv2); }
        else if (u < 128) { LA_TIDS(); const int v = u - 64; la_unit2<1>(KARGS(), layer, v >> 4, (v >> 2) & 3, (v >> 1) & 1, v & 1, lds, t2, ln2, wv2); }
        else if (u < 192) { LA_TIDS(); const int v = u - 128; la_unit2<2>(KARGS(), layer, v >> 4, (v >> 2) & 3, (v >> 1) & 1, v & 1, lds, t2, ln2, wv2); }
        else { LA_TIDS(); const int wu = (u - 192) * 8 + wv2; s5_unit(KARGS(), layer, wu >> 7, (wu >> 1) & 63, wu & 1, lds + wv2 * S5_WAVE_BYTES, ln2); }
    }
}

__device__ __forceinline__ float row16_sum(float x) {
    x += dpp_f<0xB1, 0xf>(x); x += dpp_f<0x4E, 0xf>(x); x += dpp_f<0x141, 0xf>(x); x += dpp_f<0x140, 0xf>(x); return x;
}
__device__ __forceinline__ float row32_sum(float x) { x = row16_sum(x); return x + __shfl_xor(x, 16); }
__device__ __forceinline__ void phase_e(KP kp, int layer, int lane, int wave, int bid, int G) {
    unsigned char* ws = kp->ws;
    const bf16* P = (const bf16*)(ws + WS_P); const bf16* RF = (const bf16*)(ws + WS_RAW); const bf16* RB = RF + (size_t)MROWS * DM;
    bf16* O = (bf16*)(ws + WS_O); bf16* Z = (bf16*)(ws + WS_Z);
    float ga[8], gb[8], gd[8], sd0[8], sd1[8];
    {
        const float* pa_ = kp->in[9] + layer * 128 + 8 * (lane & 15); const float* pb_ = kp->in[12] + layer * 256 + 8 * (lane & 31); const float* pd_ = kp->in[24] + layer * 256 + 8 * (lane & 31);
        const float* ps_ = kp->in[20] + layer * 1024 + 8 * lane;
#pragma unroll
        for (int e = 0; e < 8; ++e) { ga[e] = pa_[e]; gb[e] = pb_[e]; gd[e] = pd_[e]; sd0[e] = ps_[e]; sd1[e] = ps_[512 + e]; }
    }
    const int gw = bid * 8 + wave, NGW = G * 8;
    for (int row = gw; row < MROWS; row += NGW) {
        if (layer == 1 && (row % LTOT) < NCTX) continue;
        const bf16* pr = P + (size_t)row * 512 + 8 * lane; const bf16* rf = RF + (size_t)row * DM + 8 * lane; const bf16* rb = RB + (size_t)row * DM + 8 * lane;
        bf16* orow = O + (size_t)row * DM + 8 * lane; bf16* zrow = Z + (size_t)row * 1024 + 8 * lane;
        v4u f_[8], b_[8], g_[8];
#pragma unroll
        for (int pt = 0; pt < 4; ++pt)
#pragma unroll
            for (int h = 0; h < 2; ++h) { f_[2 * pt + h] = *(const v4u*)(rf + 1024 * pt + 512 * h); b_[2 * pt + h] = *(const v4u*)(rb + 1024 * pt + 512 * h); }
#pragma unroll
        for (int h = 0; h < 2; ++h) { g_[h] = *(const v4u*)(pr + ((CA_G >> 9) + h) * P_BLK_ELEMS); g_[2 + h] = *(const v4u*)(pr + ((CB_G >> 9) + h) * P_BLK_ELEMS); g_[4 + h] = *(const v4u*)(pr + ((CC_U >> 9) + h) * P_BLK_ELEMS); g_[6 + h] = *(const v4u*)(pr + ((CD_G >> 9) + h) * P_BLK_ELEMS); }
#pragma unroll
        for (int h = 0; h < 2; ++h) {
            float x[8], y[8], gt[8];
            unpack8(f_[h], x); unpack8(b_[h], y); unpack8(g_[h], gt);
            float s = 0.f;
#pragma unroll
            for (int e = 0; e < 8; ++e) { x[e] += y[e]; s += x[e] * x[e]; }
            float r = 1.0f / sqrtf(row16_sum(s) * (1.0f / 128.0f) + EPSN);
#pragma unroll
            for (int e = 0; e < 8; ++e) x[e] = x[e] * r * ga[e] * siluf_(gt[e]);
            *(v4u*)(orow + 512 * h) = pack8c(x);
            unpack8(f_[2 + h], x); unpack8(b_[2 + h], y); unpack8(g_[2 + h], gt);
            s = 0.f;
#pragma unroll
            for (int e = 0; e < 8; ++e) { x[e] += y[e]; s += x[e] * x[e]; }
            r = 1.0f / sqrtf(row32_sum(s) * (1.0f / 256.0f) + EPSN);
#pragma unroll
            for (int e = 0; e < 8; ++e) x[e] = x[e] * r * gb[e] * siluf_(gt[e]);
            *(v4u*)(orow + 1024 + 512 * h) = pack8c(x);
            unpack8(f_[6 + h], x); unpack8(b_[6 + h], y); unpack8(g_[6 + h], gt);
            s = 0.f;
#pragma unroll
            for (int e = 0; e < 8; ++e) { x[e] += y[e]; s += x[e]; }
            const float mu = row32_sum(s) * (1.0f / 256.0f);
            s = 0.f;
#pragma unroll
            for (int e = 0; e < 8; ++e) { x[e] -= mu; s += x[e] * x[e]; }
            r = 1.0f / sqrtf(row32_sum(s) * (1.0f / 256.0f) + EPSN);
#pragma unroll
            for (int e = 0; e < 8; ++e) x[e] = x[e] * r * gd[e] * siluf_(gt[e]);
            *(v4u*)(orow + 3072 + 512 * h) = pack8c(x);
            unpack8(f_[4 + h], x); unpack8(b_[4 + h], y); unpack8(g_[4 + h], gt);
#pragma unroll
            for (int e = 0; e < 8; ++e) x[e] = gelu_tanhf_(x[e] + y[e] + (h ? sd1[e] : sd0[e]) * gt[e]);
            *(v4u*)(zrow + 512 * h) = pack8c(x);
        }
    }
}

__device__ __forceinline__ void phase_h(KP kp, int lane, int wave, int bid, int G) {
    const float* fg = kp->in[26]; float* out = kp->out; const float* x = kp->in[0];
    const bf16* D0 = (const bf16*)(kp->ws + WS_HL); const bf16* D1 = D0 + (size_t)NBATCH * SEQ * DM;
    const int gw = bid * 8 + wave, NGW = G * 8;
    for (int row = gw; row < NBATCH * SEQ; row += NGW) {
        const float* xrow = x + (size_t)row * DM; const bf16* d0 = D0 + (size_t)row * DM; const bf16* d1 = D1 + (size_t)row * DM; float* orow = out + (size_t)row * DM;
        f32x4 v[16]; float s = 0.f;
#pragma unroll
        for (int j = 0; j < 16; ++j) { const int col = 4 * (lane + 64 * j); const v2u a2 = *(const v2u*)(d0 + col), b2 = *(const v2u*)(d1 + col);
            v[j] = *(const f32x4*)(xrow + col) + ((f32x4){lo_bf(a2.x), hi_bf(a2.x), lo_bf(a2.y), hi_bf(a2.y)} + (f32x4){lo_bf(b2.x), hi_bf(b2.x), lo_bf(b2.y), hi_bf(b2.y)});
            s += (v[j].x * v[j].x + v[j].y * v[j].y) + (v[j].z * v[j].z + v[j].w * v[j].w); }
        s = wave_sum(s);
        const float rstd = 1.0f / sqrtf(s * (1.0f / DM) + EPSN);
#pragma unroll
        for (int j = 0; j < 16; ++j) { const int col = 4 * (lane + 64 * j); const f32x4 g4 = *(const f32x4*)(fg + col); *(f32x4*)(orow + col) = v[j] * rstd * g4; }
    }
}

constexpr int N_PHASES = 15;
__global__ void __launch_bounds__(512, 2) fwd(Args a) {
    extern __shared__ __attribute__((aligned(16))) unsigned char lds_raw[];
    LAS unsigned char* lds = (LAS unsigned char*)lds_raw;
    const int bid = blockIdx.x, G = gridDim.x;
#define TIDS() int tid = threadIdx.x; asm volatile("" : "+v"(tid)); const int lane = tid & 63, wave = __builtin_amdgcn_readfirstlane(tid >> 6); (void)lane; (void)wave
    volatile LAS unsigned* MISC = (volatile LAS unsigned*)(lds + MISC_OFF);
    for (int u = threadIdx.x; u < (LDS_BYTES - LDSCTL_OFF) / 4; u += 512) ((LAS unsigned*)(lds + LDSCTL_OFF))[u] = 0u;
    __syncthreads();
    unsigned* ctl = (unsigned*)(a.ws + WS_CTL);
    const int lo = a.ph_lo, hi = a.ph_hi;
    XcdBarrier bar; bar.bar = ctl + CW_BAR; bar.x = 0; bar.st = nullptr;
    if (hi - lo > 1) bar = xcd_barrier_post(ctl + CW_BAR, MISC + 8);
#define IN(k) (lo <= (k) && (k) < hi)
#define SEAM(k) do { if (IN(k) && IN((k) + 1)) xcd_barrier(bar); } while (0)
    for (int layer = 0; layer < 2; ++layer) {
        const int pb = layer * 7;
        if (IN(pb + 0)) { TIDS(); phase_a(KARGS(), layer, lds, tid, lane, wave, bid, G); }
        SEAM(pb + 0);
        if (IN(pb + 1)) { TIDS(); phase_b(KARGS(), layer, lds, lane, wave, bid, G); }
        SEAM(pb + 1);
        if (IN(pb + 2)) { KP kp = KARGS(); unsigned char* ws = kp->ws;
            pg8::Gemm g{(const bf16*)(ws + WS_HN), (const bf16*)(ws + WS_WIN), DM, NPG, DM};
            RowOrder S; S.init(NPG, G, bid, 0);
            EpiStoreBf16 E{(bf16*)(ws + WS_P), NP};
            pg8::gemm_phase<EpiStoreBf16, RowOrder, true, true>(lds, g, S, E);
        }
        SEAM(pb + 2);
        if (IN(pb + 3)) { phase_d(layer, lds, bid, G); }
        SEAM(pb + 3);
        if (IN(pb + 4)) { TIDS(); phase_e(KARGS(), layer, lane, wave, bid, G); }
        SEAM(pb + 4);
        if (IN(pb + 5)) { KP kp = KARGS(); unsigned char* ws = kp->ws;
            pg8::Gemm g{(const bf16*)(ws + WS_Z), (const bf16*)(ws + WS_WGLU) + (size_t)layer * 1024 * 1024, 1024, 1024, 1024};
            RowOrder S; S.init(1024, G, bid, layer == 1 ? 1 : 0);
            EpiGlu E{(const bf16*)(ws + WS_Z), (const bf16*)(ws + WS_P), (bf16*)(ws + WS_O), kp->in[22] + layer * 1024};
            pg8::gemm_phase<EpiGlu, RowOrder, true, true>(lds, g, S, E);
        }
        SEAM(pb + 5);
        if (IN(pb + 6)) { KP kp = KARGS(); unsigned char* ws = kp->ws;
            pg8::Gemm g{(const bf16*)(ws + WS_O), (const bf16*)(ws + WS_WOUT) + (size_t)layer * DM * DM, DM, DM, DM};
            const bool split = (layer == 0 && G == 256);
            RowOrder S; S.init(DM, G, bid, (layer == 1 || split) ? 1 : 0);
            EpiDelta E{(bf16*)(ws + WS_HL) + (size_t)layer * NBATCH * SEQ * DM, (bf16*)(ws + WS_HC), (const float*)(ws + WS_MOD) + (size_t)layer * 5 * 12288};
            pg8::gemm_phase<EpiDelta, RowOrder, true, true>(lds, g, S, E);
            if (split) {
                const int kq = bid & 3;
                pg8::Gemm g2{(const bf16*)(ws + WS_O) + kq * 1024, (const bf16*)(ws + WS_WOUT) + kq * 1024, DM, DM, 1024};
                CtxSplitOrder S2{bid};
                EpiCtxPart E2{(float*)(ws + WS_CPART) + (size_t)kq * NBATCH * NCTX * DM};
                pg8::gemm_phase<EpiCtxPart, CtxSplitOrder, false, true>(lds, g2, S2, E2);
            }
        }
        SEAM(pb + 6);
    }
    if (IN(14)) { TIDS(); phase_h(KARGS(), lane, wave, bid, G); }
#undef IN
#undef SEAM
#undef TIDS
}

extern "C" void kernel_launch(void* const* d_in, const int* in_sizes, int n_in, void* d_out, int out_size, void* d_ws, size_t ws_size, hipStream_t stream) {
    static int grid = 0;
    if (grid == 0) {
        if (n_in != 27 || out_size != NBATCH * SEQ * DM || ws_size < WS_END) { fprintf(stderr, "kernel_launch: unexpected problem (n_in %d out %d ws %zu need %zu); nothing launched\n", n_in, out_size, ws_size, (size_t)WS_END); grid = -1; return; }
        int dev = 0, cus = 0;
        if (hipGetDevice(&dev) != hipSuccess || hipDeviceGetAttribute(&cus, hipDeviceAttributeMultiprocessorCount, dev) != hipSuccess) { grid = -1; return; }
        if (hipFuncSetAttribute((const void*)fwd, hipFuncAttributeMaxDynamicSharedMemorySize, LDS_BYTES) != hipSuccess) { fprintf(stderr, "kernel_launch: hipFuncSetAttribute failed\n"); grid = -1; return; }
        (void)hipGetLastError();
        grid = cus;
    }
    if (grid < 0) return;
    (void)hipMemsetAsync((char*)d_ws + WS_CTL, 0, CTL_BYTES, stream);
    Args a{};
    for (int i = 0; i < 27; ++i) a.in[i] = (const float*)d_in[i];
    a.out = (float*)d_out; a.ws = (unsigned char*)d_ws;
#ifndef ONE_LAUNCH
    for (int ph = 0; ph < N_PHASES; ++ph) { a.ph_lo = ph; a.ph_hi = ph + 1; hipLaunchKernelGGL(fwd, dim3(grid), dim3(512), LDS_BYTES, stream, a); }
#else
    a.ph_lo = 0; a.ph_hi = N_PHASES; hipLaunchKernelGGL(fwd, dim3(grid), dim3(512), LDS_BYTES, stream, a);
#endif
}
```

```cpp
#include <hip/hip_runtime.h>
#include <cstdio>
#include <cstdint>
#define ONE_LAUNCH 1
namespace pg8 {
#define PG8_LAS __attribute__((address_space(3)))
typedef unsigned short bf16_t;
typedef short bf16x8 __attribute__((ext_vector_type(8)));
typedef float f32x4 __attribute__((ext_vector_type(4)));
typedef unsigned u32x4 __attribute__((ext_vector_type(4)));
constexpr int BM = 256, BK = 64, HALF = 128, HTB = HALF * BK * 2  , STAGE_BYTES = 8 * HTB, NXCD = 8, WGM = 8;

__host__ __device__ __forceinline__ int lds_byte(int r, int c) { const int st = (r >> 4) * 2 + (c >> 5), rr = r & 15, cc = c & 31, ob = rr * 64 + cc * 2; return st * 1024 + (ob ^ (((ob >> 9) & 1) << 5)); }
__host__ __device__ __forceinline__ void stage_rc(int b, int& R, int& C) { const int st = b / 1024, sb = b % 1024, swz = sb ^ (((sb >> 9) & 1) << 5); R = (st >> 1) * 16 + swz / 64; C = (st & 1) * 32 + (swz % 64) / 2; }
__host__ __device__ __forceinline__ int perm32(int rho) { const int n = rho >> 4, i = rho & 15; return 8 * (i >> 2) + 4 * n + (i & 3); }

struct Unit { int pm, pn; };
struct Gemm { const bf16_t* A; const bf16_t* Bt; int ld, N, K; };

struct StaticOrder {
    int nM, nN, nwg, G, c;
    __host__ __device__ void init(int M, int N, int G_, int c_) { nM = M / BM; nN = N / BM; nwg = nM * nN; G = G_; c = c_; }
    __host__ __device__ bool next(int i, Unit& u) const {
        const long L = (long)i * G + c; if (L >= nwg) return false;
        int wgid = (int)L; { const int q = nwg / NXCD, r = nwg % NXCD, xcd = wgid % NXCD, off = wgid / NXCD; wgid = (xcd < r ? xcd * (q + 1) : r * (q + 1) + (xcd - r) * q) + off; }
        const int nig = WGM * nN, gid = wgid / nig, fm = gid * WGM, gsz = (nM - fm) < WGM ? (nM - fm) : WGM;
        u.pm = fm + ((wgid % nig) % gsz); u.pn = (wgid % nig) / gsz; return true;
    }
    __device__ __forceinline__ void a_ready(const Unit&) const {}
    __device__ __forceinline__ void done(const Unit&) const {}
};

__device__ __forceinline__ unsigned cvt_pk_bf16(float lo, float hi) { unsigned r; asm volatile("v_cvt_pk_bf16_f32 %0, %1, %2" : "=v"(r) : "v"(lo), "v"(hi)); return r; }
typedef float f32x2 __attribute__((ext_vector_type(2)));
__device__ __forceinline__ f32x2 gelu_pk(f32x2 v) {
    const f32x2 av = __builtin_elementwise_abs(v), d = av * 0.2316418882f + 1.0f;
    f32x2 t; t.x = __builtin_amdgcn_rcpf(d.x); t.y = __builtin_amdgcn_rcpf(d.y);
    f32x2 q = t * 0.5307027145f + (-0.7265760135f); q = q * t + 0.7107068705f; q = q * t + (-0.142248368f); q = q * t + 0.127414796f; q = q * t;
    const f32x2 s = (v * v) * (-0.72134752044f);
    f32x2 e; e.x = __builtin_amdgcn_exp2f(s.x); e.y = __builtin_amdgcn_exp2f(s.y);
    const f32x2 m = v * (q * e), r = v - m;
    f32x2 o; o.x = v.x < 0.f ? m.x : r.x; o.y = v.y < 0.f ? m.y : r.y; return o;
}

template <class Epi, class Sched, bool ALIGN_EPI = false, bool SP2 = false>
__device__ __forceinline__ void gemm_phase(PG8_LAS unsigned char* lds, const Gemm g, const Sched& S, const Epi& E) {
    int tid_l = threadIdx.x; asm volatile("" : "+v"(tid_l));
    const int tid = tid_l, wid = __builtin_amdgcn_readfirstlane(tid >> 6), lane = tid & 63, wr = wid >> 2, wc = wid & 3, fr = lane & 15, fq = lane >> 4;
    const int K = g.K, LD = g.ld, nt = K / BK;
    unsigned voffA[2], voffB[2];
#pragma unroll
    for (int i = 0; i < 2; ++i) { int R, C; stage_rc(tid * 16 + i * 8192, R, C); const int Rb = Epi::PERM ? ((R & ~31) + perm32(R & 31)) : R;
        voffA[i] = (unsigned)(R * LD + C) * 2u; voffB[i] = (unsigned)(Rb * LD + C) * 2u; }
    const size_t kstep = (size_t)(BK * 2);
    const size_t hstep = (size_t)HALF * LD * 2;
    const size_t tstep = 2 * hstep;
    const unsigned ldsw = (unsigned)wid * 1024u;
    const int aoff = lds_byte(wr * 64 + fr, fq * 8), boff = lds_byte(wc * 32 + fr, fq * 8);
#define PG8_SA(b, h) (((b) * 2 + (h)) * HTB)
#define PG8_SB(b, h) ((4 + (b) * 2 + (h)) * HTB)
#define PG8_STAGE(bufoff, gbase, voff) do { _Pragma("unroll") for (int _i = 0; _i < 2; ++_i) \
        __builtin_amdgcn_global_load_lds((const unsigned*)((const char*)(gbase) + (voff)[_i]), (PG8_LAS unsigned*)(lds + (bufoff) + ldsw + _i * 8192), 16, 0, 0); } while (0)
#define PG8_LDA(dst, b, h) do { _Pragma("unroll") for (int m = 0; m < 4; ++m) _Pragma("unroll") for (int k = 0; k < 2; ++k) dst[m][k] = *(const PG8_LAS bf16x8*)(lds + PG8_SA(b, h) + aoff + m * 2048 + k * 1024); } while (0)
#define PG8_LDB(dst, b, h) do { _Pragma("unroll") for (int n = 0; n < 2; ++n) _Pragma("unroll") for (int k = 0; k < 2; ++k) dst[n][k] = *(const PG8_LAS bf16x8*)(lds + PG8_SB(b, h) + boff + n * 2048 + k * 1024); } while (0)
#define PG8_MMA(ai, bj, At, Bt) do { __builtin_amdgcn_s_setprio(1); _Pragma("unroll") for (int m = 0; m < 4; ++m) _Pragma("unroll") for (int n = 0; n < 2; ++n) _Pragma("unroll") for (int k = 0; k < 2; ++k) \
        acc[ai][bj][m][n] = __builtin_amdgcn_mfma_f32_16x16x32_bf16(Bt[n][k], At[m][k], acc[ai][bj][m][n], 0, 0, 0); __builtin_amdgcn_s_setprio(0); } while (0)
#define PG8_WAIT_V(n) asm volatile("s_waitcnt vmcnt(" #n ")" ::: "memory")
#define PG8_WAIT_L(n) asm volatile("s_waitcnt lgkmcnt(" #n ")" ::: "memory")
#define PG8_BAR __builtin_amdgcn_s_barrier()
#define PG8_SCHED __builtin_amdgcn_sched_barrier(0)
    Unit cur, nxt; int ui = 0;
    if (!S.next(0, cur)) return;
    f32x4 acc[2][2][4][2];
#pragma unroll
    for (int a = 0; a < 2; ++a)
#pragma unroll
        for (int b = 0; b < 2; ++b)
#pragma unroll
            for (int m = 0; m < 4; ++m)
#pragma unroll
                for (int n = 0; n < 2; ++n) acc[a][b][m][n] = (f32x4){0.f, 0.f, 0.f, 0.f};
    bf16x8 At[4][2], B0[2][2], B1[2][2];
    const char* cA = (const char*)g.A + (size_t)cur.pm * tstep; const char* cB = (const char*)g.Bt + (size_t)cur.pn * tstep;
    S.a_ready(cur);
    if constexpr (SP2) {
        PG8_STAGE(PG8_SB(0, 0), cB, voffB); PG8_STAGE(PG8_SB(0, 1), cB + hstep, voffB); PG8_STAGE(PG8_SA(0, 0), cA, voffA); PG8_STAGE(PG8_SA(0, 1), cA + hstep, voffA);
        if (wr == 1) PG8_BAR;
        PG8_WAIT_V(2); PG8_BAR;
        PG8_STAGE(PG8_SB(1, 0), cB + kstep, voffB); PG8_STAGE(PG8_SA(1, 0), cA + kstep, voffA); PG8_STAGE(PG8_SB(1, 1), cB + hstep + kstep, voffB);
        PG8_WAIT_V(6); PG8_BAR;
    } else {
        PG8_STAGE(PG8_SB(0, 0), cB, voffB); PG8_STAGE(PG8_SA(0, 0), cA, voffA); PG8_STAGE(PG8_SB(0, 1), cB + hstep, voffB); PG8_STAGE(PG8_SA(0, 1), cA + hstep, voffA);
        if (wr == 1) PG8_BAR;
        PG8_WAIT_V(4); PG8_BAR;
        PG8_STAGE(PG8_SB(1, 0), cB + kstep, voffB); PG8_STAGE(PG8_SA(1, 0), cA + kstep, voffA); PG8_STAGE(PG8_SB(1, 1), cB + hstep + kstep, voffB);
        PG8_WAIT_V(6); PG8_BAR;
    }
    for (;;) {
        const bool has_next = S.next(ui + 1, nxt);
        const char* nA = has_next ? (const char*)g.A + (size_t)nxt.pm * tstep : cA; const char* nB = has_next ? (const char*)g.Bt + (size_t)nxt.pn * tstep : cB;
        for (int t = 0; t < nt; t += 2) {
            const bool last = (t == nt - 2);
            const char* a1 = cA + (size_t)(t + 1) * kstep;
            const char* a2 = last ? nA : cA + (size_t)(t + 2) * kstep; const char* b2 = last ? nB : cB + (size_t)(t + 2) * kstep;
            const char* a3 = a2 + kstep; const char* b3 = b2 + kstep;
            if (last && has_next) S.a_ready(nxt);
            if constexpr (SP2) {
            PG8_LDB(B0, 0, 0); PG8_LDB(B1, 0, 1); PG8_SCHED; PG8_LDA(At, 0, 0); PG8_STAGE(PG8_SA(1, 1), a1 + hstep, voffA);
            PG8_WAIT_V(8); PG8_WAIT_L(0); PG8_BAR; PG8_MMA(0, 0, At, B0); PG8_MMA(0, 1, At, B1); PG8_BAR; PG8_SCHED;
            PG8_LDA(At, 0, 1); PG8_STAGE(PG8_SB(0, 0), b2, voffB); PG8_STAGE(PG8_SB(0, 1), b2 + hstep, voffB); PG8_STAGE(PG8_SA(0, 0), a2, voffA);
            PG8_WAIT_V(8); PG8_WAIT_L(0); PG8_BAR; PG8_MMA(1, 0, At, B0); PG8_MMA(1, 1, At, B1); PG8_BAR; PG8_SCHED;
            PG8_LDB(B0, 1, 0); PG8_LDB(B1, 1, 1); PG8_SCHED; PG8_LDA(At, 1, 0); PG8_STAGE(PG8_SA(0, 1), a2 + hstep, voffA);
            PG8_WAIT_V(8); PG8_WAIT_L(0); PG8_BAR; PG8_MMA(0, 0, At, B0); PG8_MMA(0, 1, At, B1); PG8_BAR; PG8_SCHED;
            PG8_LDA(At, 1, 1); PG8_STAGE(PG8_SB(1, 0), b3, voffB); PG8_STAGE(PG8_SB(1, 1), b3 + hstep, voffB); PG8_STAGE(PG8_SA(1, 0), a3, voffA);
            PG8_WAIT_V(8); PG8_WAIT_L(0); PG8_BAR; PG8_MMA(1, 0, At, B0); PG8_MMA(1, 1, At, B1); PG8_BAR; PG8_SCHED;
            } else {
            PG8_LDB(B0, 0, 0); PG8_SCHED; PG8_LDA(At, 0, 0); PG8_STAGE(PG8_SA(1, 1), a1 + hstep, voffA);
            PG8_WAIT_L(8); PG8_BAR; PG8_WAIT_L(0); PG8_MMA(0, 0, At, B0); PG8_BAR; PG8_SCHED;
            PG8_LDB(B1, 0, 1); PG8_STAGE(PG8_SB(0, 0), b2, voffB);
            PG8_BAR; PG8_WAIT_L(0); PG8_MMA(0, 1, At, B1); PG8_BAR;
            PG8_LDA(At, 0, 1); PG8_STAGE(PG8_SA(0, 0), a2, voffA);
            PG8_BAR; PG8_WAIT_L(0); PG8_MMA(1, 0, At, B0); PG8_BAR; PG8_SCHED;
            PG8_STAGE(PG8_SB(0, 1), b2 + hstep, voffB);
            PG8_WAIT_V(6); PG8_BAR; PG8_MMA(1, 1, At, B1); PG8_BAR;
            PG8_LDB(B0, 1, 0); PG8_SCHED; PG8_LDA(At, 1, 0); PG8_STAGE(PG8_SA(0, 1), a2 + hstep, voffA);
            PG8_WAIT_L(8); PG8_BAR; PG8_WAIT_L(0); PG8_MMA(0, 0, At, B0); PG8_BAR; PG8_SCHED;
            PG8_LDB(B1, 1, 1); PG8_STAGE(PG8_SB(1, 0), b3, voffB);
            PG8_BAR; PG8_WAIT_L(0); PG8_MMA(0, 1, At, B1); PG8_BAR;
            PG8_LDA(At, 1, 1); PG8_STAGE(PG8_SA(1, 0), a3, voffA);
            PG8_BAR; PG8_WAIT_L(0); PG8_MMA(1, 0, At, B0); PG8_BAR; PG8_SCHED;
            PG8_STAGE(PG8_SB(1, 1), b3 + hstep, voffB);
            PG8_WAIT_V(6); PG8_BAR; PG8_MMA(1, 1, At, B1); PG8_BAR;
            }
        }
        if constexpr (ALIGN_EPI) { if (wr == 0) PG8_BAR; }
        if constexpr (!Epi::AFTER_DRAIN) { E(acc, cur, wr, wc, fr, fq); S.done(cur); }
        if (!has_next) break;
#pragma unroll
        for (int a = 0; a < 2; ++a)
#pragma unroll
            for (int b = 0; b < 2; ++b)
#pragma unroll
                for (int m = 0; m < 4; ++m)
#pragma unroll
                    for (int n = 0; n < 2; ++n) acc[a][b][m][n] = (f32x4){0.f, 0.f, 0.f, 0.f};
        cur = nxt; cA = nA; cB = nB; ++ui;
        if constexpr (ALIGN_EPI) { if (wr == 1) PG8_BAR; }
    }
    PG8_WAIT_V(0);
    if constexpr (!ALIGN_EPI) { if (wr == 0) PG8_BAR; }
    PG8_BAR;
    if constexpr (Epi::AFTER_DRAIN) { E.fused(acc, cur, wr, wc, fr, fq, lds, wid, lane); S.done(cur); }
#undef PG8_SA
#undef PG8_SB
#undef PG8_STAGE
#undef PG8_LDA
#undef PG8_LDB
#undef PG8_MMA
#undef PG8_WAIT_V
#undef PG8_WAIT_L
#undef PG8_BAR
#undef PG8_SCHED
}
}
#define XB_TMO      128
#define XB_XCNT(j)  (256  + 64 * (j))
#define XB_XSUB(j)  (1280 + 64 * (j))
#define XB_XGEN(j)  (2304 + 64 * (j))
#define XB_TOP      3328
#define XB_TOPGEN   3392
#define XCD_BAR_WORDS 3456
#define XB_SPIN_CAP (1u << 18)
#define LAS __attribute__((address_space(3)))

__device__ __forceinline__ unsigned xb_ld(unsigned* p)              { return __hip_atomic_load(p, __ATOMIC_RELAXED, __HIP_MEMORY_SCOPE_AGENT); }
__device__ __forceinline__ unsigned xb_add(unsigned* p, unsigned v) { return __hip_atomic_fetch_add(p, v, __ATOMIC_RELAXED, __HIP_MEMORY_SCOPE_AGENT); }
__device__ __forceinline__ unsigned xb_xcc_id() { return (unsigned)__builtin_amdgcn_s_getreg((3 << 11) | 20) & 0xFu; }
#define XB_SPIN(cond, bar) do { unsigned _sp = 0; while (cond) { __builtin_amdgcn_s_sleep(1); \
    if ((++_sp & 255u) == 0u) { if (xb_ld(&(bar)[XB_TMO])) break; if (_sp > XB_SPIN_CAP) { atomicAdd(&(bar)[XB_TMO], 1u); break; } } } } while (0)

struct XcdBarrier {
    unsigned* bar; unsigned x;
    volatile LAS unsigned* st;
};

__device__ __forceinline__ XcdBarrier xcd_barrier_post(unsigned* bar, volatile LAS unsigned* st) {
    XcdBarrier b; b.bar = bar; b.x = xb_xcc_id(); b.st = st;
    if (threadIdx.x == 0) (void)xb_add(&bar[XB_XCNT(b.x)], 1u);
    return b;
}
__device__ __forceinline__ void xcd_barrier_complete(unsigned* bar, unsigned x, unsigned& nloc, unsigned& nx) {
    const unsigned G = gridDim.x * gridDim.y * gridDim.z;
    unsigned sum, cnt, mine, sp = 0u;
    for (;;) {
        sum = 0u; cnt = 0u; mine = 0u;
#pragma unroll
        for (unsigned j = 0; j < 16; ++j) { const unsigned c = xb_ld(&bar[XB_XCNT(j)]); sum += c; cnt += (c > 0u) ? 1u : 0u; mine = (j == x) ? c : mine; }
        if (sum == G) break;
        __builtin_amdgcn_s_sleep(1);
        if ((++sp & 255u) == 0u) { if (xb_ld(&bar[XB_TMO])) break; if (sp > XB_SPIN_CAP) { atomicAdd(&bar[XB_TMO], 1u); break; } }
    }
    nloc = mine > 0u ? mine : 1u; nx = cnt > 0u ? cnt : 1u;
}

__device__ __forceinline__ void xcd_barrier(const XcdBarrier& b) {
    asm volatile("s_waitcnt vmcnt(0)" ::: "memory");
    __syncthreads();
    if (threadIdx.x == 0) {
        unsigned* bar = b.bar;
        __builtin_amdgcn_s_waitcnt(0);
        unsigned nloc = b.st[0], nx = b.st[1];
        if (nloc == 0u) { xcd_barrier_complete(bar, b.x, nloc, nx); b.st[0] = nloc; b.st[1] = nx; }
        const unsigned old = xb_add(&bar[XB_XSUB(b.x)], 1u);
        const unsigned gen = old / nloc;
        if (old + 1u == (gen + 1u) * nloc) {
            __builtin_amdgcn_fence(__ATOMIC_RELEASE, "agent");
            asm volatile("s_waitcnt vmcnt(0)" ::: "memory");
            const unsigned og = xb_add(&bar[XB_TOP], 1u);
            const unsigned tg = og / nx;
            if (og + 1u == (tg + 1u) * nx) xb_add(&bar[XB_TOPGEN], 1u);
            else XB_SPIN(xb_ld(&bar[XB_TOPGEN]) == tg, bar);
            __builtin_amdgcn_fence(__ATOMIC_ACQUIRE, "agent");
            xb_add(&bar[XB_XGEN(b.x)], 1u);
            asm volatile("s_waitcnt vmcnt(0)" ::: "memory");
        } else {
            XB_SPIN(xb_ld(&bar[XB_XGEN(b.x)]) == gen, bar);
            __builtin_amdgcn_fence(__ATOMIC_ACQUIRE, "agent");
            asm volatile("s_waitcnt vmcnt(0)" ::: "memory");
        }
    }
    __syncthreads();
}

#define GAS __attribute__((address_space(1)))
typedef unsigned short bf16;
typedef unsigned v4u __attribute__((ext_vector_type(4)));
typedef unsigned v2u __attribute__((ext_vector_type(2)));
typedef float f32x4 __attribute__((ext_vector_type(4)));
#define LDS_WAIT() asm volatile("s_waitcnt lgkmcnt(0)" ::: "memory")

constexpr int DM = 4096, NBATCH = 4, SEQ = 4096, NCTX = 256, LTOT = NCTX + SEQ, MROWS = NBATCH * LTOT;
constexpr int NIN = 13344, NP = 13568, NPG = 13312;
constexpr int CA_Q = 0, CA_FF = 1024, CA_FB = 2048, CA_I = 3072, CA_G = 4096;
constexpr int CB_Q = 5120, CB_K = 5632, CB_V = 6144, CB_G = 7168;
constexpr int CC_U = 8192, CC_G = 9216;
constexpr int CD_Q = 10240, CD_K = 10752, CD_V = 11264, CD_G = 12288;
constexpr int CB_LF = 13312, CB_LB = 13328;
constexpr float EPSN = 1e-6f;
constexpr size_t P_BLK_ELEMS = (size_t)NBATCH * (NCTX + SEQ) * 512;
constexpr size_t P_LRB_OFF = (size_t)26 * P_BLK_ELEMS;
__device__ __forceinline__ size_t p_off(size_t row, int col) { return (size_t)(col >> 9) * P_BLK_ELEMS + row * 512 + (col & 511); }

constexpr size_t WS_CTL = 0, CTL_BYTES = 1u << 20;
constexpr size_t WS_WIN = WS_CTL + CTL_BYTES;
constexpr size_t WS_WOUT = WS_WIN + (size_t)NP * DM * 2;
constexpr size_t WS_WGLU = WS_WOUT + (size_t)2 * DM * DM * 2;
constexpr size_t WS_WLR = WS_WGLU + (size_t)2 * 1024 * 1024 * 2;
constexpr size_t WS_MOD = WS_WLR + (size_t)32 * DM * 2;
constexpr size_t WS_HN = WS_MOD + (size_t)2 * 5 * 12288 * 4;
constexpr size_t WS_P = WS_HN + (size_t)MROWS * DM * 2;
constexpr size_t WS_HC = WS_P + (size_t)MROWS * NP * 2;
constexpr size_t WS_HL = WS_HC + (size_t)NBATCH * NCTX * DM * 4;
constexpr size_t WS_O = WS_HL + (size_t)NBATCH * SEQ * DM * 4;
constexpr size_t WS_Z = WS_O + (size_t)MROWS * DM * 2;
constexpr size_t WS_RAW = WS_Z + (size_t)MROWS * 1024 * 2;
constexpr size_t WS_CPART = WS_RAW + (size_t)2 * MROWS * DM * 2;
constexpr size_t WS_END = WS_CPART + (size_t)4 * NBATCH * NCTX * DM * 4;

constexpr int RING_BYTES = 131072, LDSCTL_OFF = 146944, MISC_OFF = LDSCTL_OFF + 320, LDS_BYTES = 147456;
constexpr int CW_BAR = 1024;

struct Args { const float* in[27]; float* out; unsigned char* ws; int ph_lo, ph_hi; };
typedef const __attribute__((address_space(4))) Args* KP;
#define KARGS() ({ KP _p = (KP)__builtin_amdgcn_kernarg_segment_ptr(); asm volatile("" : "+s"(_p)); _p; })

__device__ __forceinline__ float bf2f(bf16 v) { return __builtin_bit_cast(float, (unsigned)v << 16); }
__device__ __forceinline__ unsigned f2bf(float f) { unsigned u = __builtin_bit_cast(unsigned, f); return (u + 0x7fffu + ((u >> 16) & 1u)) >> 16; }
__device__ __forceinline__ unsigned pk2(float lo, float hi) { return f2bf(lo) | (f2bf(hi) << 16); }
typedef float f32x2_ __attribute__((ext_vector_type(2)));
typedef __bf16 bf16x2_ __attribute__((ext_vector_type(2)));
__device__ __forceinline__ unsigned cvtpk(float lo, float hi) { const f32x2_ v = {lo, hi}; return __builtin_bit_cast(unsigned, __builtin_convertvector(v, bf16x2_)); }
template <int CTRL, int ROW_MASK> __device__ __forceinline__ float dpp_f(float x) {
    return __builtin_bit_cast(float, __builtin_amdgcn_update_dpp(0, __builtin_bit_cast(int, x), CTRL, ROW_MASK, 0xf, true));
}
__device__ __forceinline__ float lane_scan(float x, int lane) {
    (void)lane;
    x += dpp_f<0x111, 0xf>(x);
    x += dpp_f<0x112, 0xf>(x);
    x += dpp_f<0x114, 0xf>(x);
    x += dpp_f<0x118, 0xf>(x);
    x += dpp_f<0x142, 0xa>(x);
    x += dpp_f<0x143, 0xc>(x);
    return x;
}

__device__ __forceinline__ float lo_bf(unsigned w) { return __builtin_bit_cast(float, w << 16); }
__device__ __forceinline__ float hi_bf(unsigned w) { return __builtin_bit_cast(float, w & 0xffff0000u); }
__device__ __forceinline__ void unpack8(const v4u w, float* f) {
    f[0] = lo_bf(w.x); f[1] = hi_bf(w.x); f[2] = lo_bf(w.y); f[3] = hi_bf(w.y); f[4] = lo_bf(w.z); f[5] = hi_bf(w.z); f[6] = lo_bf(w.w); f[7] = hi_bf(w.w);
}
__device__ __forceinline__ v4u pack8(const float* f) { v4u w; w.x = pk2(f[0], f[1]); w.y = pk2(f[2], f[3]); w.z = pk2(f[4], f[5]); w.w = pk2(f[6], f[7]); return w; }
__device__ __forceinline__ v4u pack8c(const float* f) { v4u w; w.x = cvtpk(f[0], f[1]); w.y = cvtpk(f[2], f[3]); w.z = cvtpk(f[4], f[5]); w.w = cvtpk(f[6], f[7]); return w; }
__device__ __forceinline__ float wave_sum(float v) {
    const float s = lane_scan(v, 0);
    return __builtin_bit_cast(float, __builtin_amdgcn_readlane(__builtin_bit_cast(int, s), 63));
}
__device__ __forceinline__ float sigmoidf_(float x) { return __builtin_amdgcn_rcpf(1.0f + __builtin_amdgcn_exp2f(-1.4426950408889634f * x)); }
__device__ __forceinline__ float siluf_(float x) { return x * __builtin_amdgcn_rcpf(1.0f + __builtin_amdgcn_exp2f(-1.4426950408889634f * x)); }
__device__ __forceinline__ float log_sigmoidf_(float x) { return fminf(x, 0.f) - log1pf(__expf(-fabsf(x))); }
__device__ __forceinline__ float gelu_tanhf_(float y) { const float t = 0.7978845608028654f * (y + 0.044715f * y * y * y); const float e = __expf(2.f * t); return 0.5f * y * (1.f + (1.f - 2.f / (e + 1.f))); }
__device__ __forceinline__ void sincos_acc(float x, float& s, float& c) {
    const float k = rintf(x * 0.63661977236758134f);
    float r = fmaf(-k, 1.57079637050628662109375f, x);
    r = fmaf(-k, -4.37113882867379e-8f, r);
    const int q = ((int)k) & 3;
    const float r2 = r * r;
    const float sp = r + r * r2 * (-1.6666654611e-1f + r2 * (8.3321608736e-3f + r2 * (-1.9515295891e-4f)));
    const float cp = 1.0f - 0.5f * r2 + r2 * r2 * (4.166664568298827e-2f + r2 * (-1.388731625493765e-3f + r2 * 2.443315711809948e-5f));
    s = (q == 0) ? sp : (q == 1) ? cp : (q == 2) ? -sp : -cp;
    c = (q == 0) ? cp : (q == 1) ? -sp : (q == 2) ? -cp : sp;
}
__device__ __forceinline__ int flip_pos(int p) { return p < NCTX ? (NCTX - 1 - p) : (LTOT + NCTX - 1 - p); }

struct EpiStoreBf16 {
    static constexpr bool PERM = true, AFTER_DRAIN = false;
    bf16* O; int ldc;
    __device__ __forceinline__ void operator()(const pg8::f32x4 (&acc)[2][2][4][2], const pg8::Unit& u, int wr, int wc, int fr, int fq) const {
        const int row0 = u.pm * 256 + wr * 64 + fr, col0 = u.pn * 256 + wc * 32 + 8 * fq;
#pragma unroll
        for (int ai = 0; ai < 2; ++ai)
#pragma unroll
            for (int m = 0; m < 4; ++m) { bf16* rowp = O + p_off((size_t)(row0 + ai * 128 + m * 16), col0);
#pragma unroll
                for (int bj = 0; bj < 2; ++bj) { const pg8::f32x4 v0 = acc[ai][bj][m][0], v1 = acc[ai][bj][m][1];
                    pg8::u32x4 w; w.x = pg8::cvt_pk_bf16(v0[0], v0[1]); w.y = pg8::cvt_pk_bf16(v0[2], v0[3]); w.z = pg8::cvt_pk_bf16(v1[0], v1[1]); w.w = pg8::cvt_pk_bf16(v1[2], v1[3]);
                    __builtin_nontemporal_store(w, (pg8::u32x4*)(rowp + bj * 128)); } }
    }
};
struct EpiGlu {
    static constexpr bool PERM = true, AFTER_DRAIN = false;
    const bf16* Z; const bf16* P; bf16* O; const float* bias;
    __device__ __forceinline__ void operator()(const pg8::f32x4 (&acc)[2][2][4][2], const pg8::Unit& u, int wr, int wc, int fr, int fq) const {
        const int row0 = u.pm * 256 + wr * 64 + fr, col0 = u.pn * 256 + wc * 32 + 8 * fq;
#pragma unroll
        for (int ai = 0; ai < 2; ++ai)
#pragma unroll
            for (int m = 0; m < 4; ++m) { const size_t row = (size_t)(row0 + ai * 128 + m * 16);
#pragma unroll
                for (int bj = 0; bj < 2; ++bj) { const int col = col0 + bj * 128;
                    const pg8::u32x4 z8 = *(const pg8::u32x4*)(Z + row * 1024 + col), g8 = *(const pg8::u32x4*)(P + p_off(row, CC_G + col));
                    const pg8::f32x4 b0 = *(const pg8::f32x4*)(bias + col), b1 = *(const pg8::f32x4*)(bias + col + 4);
                    const pg8::f32x4 v0 = acc[ai][bj][m][0] + b0, v1 = acc[ai][bj][m][1] + b1;
                    float o[8];
                    o[0] = lo_bf(z8.x) * sigmoidf_(v0[0]) * siluf_(lo_bf(g8.x)); o[1] = hi_bf(z8.x) * sigmoidf_(v0[1]) * siluf_(hi_bf(g8.x));
                    o[2] = lo_bf(z8.y) * sigmoidf_(v0[2]) * siluf_(lo_bf(g8.y)); o[3] = hi_bf(z8.y) * sigmoidf_(v0[3]) * siluf_(hi_bf(g8.y));
                    o[4] = lo_bf(z8.z) * sigmoidf_(v1[0]) * siluf_(lo_bf(g8.z)); o[5] = hi_bf(z8.z) * sigmoidf_(v1[1]) * siluf_(hi_bf(g8.z));
                    o[6] = lo_bf(z8.w) * sigmoidf_(v1[2]) * siluf_(lo_bf(g8.w)); o[7] = hi_bf(z8.w) * sigmoidf_(v1[3]) * siluf_(hi_bf(g8.w));
                    pg8::u32x4 w; w.x = pg8::cvt_pk_bf16(o[0], o[1]); w.y = pg8::cvt_pk_bf16(o[2], o[3]); w.z = pg8::cvt_pk_bf16(o[4], o[5]); w.w = pg8::cvt_pk_bf16(o[6], o[7]);
                    *(pg8::u32x4*)(O + row * DM + 2048 + col) = w; } }
    }
};
struct EpiOut {
    static constexpr bool PERM = false, AFTER_DRAIN = false;
    const float* src_ctx; const float* src_lat; float* dst_ctx; float* dst_lat; const float* modl;
    __device__ __forceinline__ void operator()(const pg8::f32x4 (&acc)[2][2][4][2], const pg8::Unit& u, int wr, int wc, int fr, int fq) const {
        const int b = u.pm / 17, t = u.pm % 17;
        const float* gt = modl + (size_t)(t == 0 ? 4 : b) * 12288 + 8192;
        const size_t rbase = (t == 0) ? (size_t)b * NCTX : (size_t)b * SEQ + (size_t)(t - 1) * 256;
        const float* src = (t == 0) ? src_ctx : src_lat; float* dst = (t == 0) ? dst_ctx : dst_lat;
        const int rr0 = wr * 64 + fr, col0 = u.pn * 256 + wc * 32 + 4 * fq;
        pg8::f32x4 gv[2][2];
#pragma unroll
        for (int bj = 0; bj < 2; ++bj)
#pragma unroll
            for (int n = 0; n < 2; ++n) gv[bj][n] = *(const pg8::f32x4*)(gt + col0 + bj * 128 + n * 16);
#pragma unroll
        for (int ai = 0; ai < 2; ++ai)
#pragma unroll
            for (int m = 0; m < 4; ++m) { const size_t off = (rbase + rr0 + ai * 128 + m * 16) * DM + col0;
#pragma unroll
                for (int bj = 0; bj < 2; ++bj)
#pragma unroll
                    for (int n = 0; n < 2; ++n) { const pg8::f32x4 s = *(const pg8::f32x4*)(src + off + bj * 128 + n * 16);
                        *(pg8::f32x4*)(dst + off + bj * 128 + n * 16) = s + gv[bj][n] * acc[ai][bj][m][n]; } }
    }
};
struct EpiDelta {
    static constexpr bool PERM = true, AFTER_DRAIN = false;
    bf16* dlat; bf16* dctx; const float* modl;
    __device__ __forceinline__ void operator()(const pg8::f32x4 (&acc)[2][2][4][2], const pg8::Unit& u, int wr, int wc, int fr, int fq) const {
        const int b = u.pm / 17, t = u.pm % 17;
        const float* gt = modl + (size_t)(t == 0 ? 4 : b) * 12288 + 8192;
        bf16* dst = (t == 0) ? dctx + (size_t)b * NCTX * DM : dlat + ((size_t)b * SEQ + (size_t)(t - 1) * 256) * DM;
        const int rr0 = wr * 64 + fr, col0 = u.pn * 256 + wc * 32 + 8 * fq;
        pg8::f32x4 gv[2][2];
#pragma unroll
        for (int bj = 0; bj < 2; ++bj)
#pragma unroll
            for (int n = 0; n < 2; ++n) gv[bj][n] = *(const pg8::f32x4*)(gt + col0 + bj * 128 + 4 * n);
#pragma unroll
        for (int ai = 0; ai < 2; ++ai)
#pragma unroll
            for (int m = 0; m < 4; ++m) { bf16* rowp = dst + (size_t)(rr0 + ai * 128 + m * 16) * DM + col0;
#pragma unroll
                for (int bj = 0; bj < 2; ++bj) { const pg8::f32x4 v0 = gv[bj][0] * acc[ai][bj][m][0], v1 = gv[bj][1] * acc[ai][bj][m][1];
                    pg8::u32x4 w; w.x = cvtpk(v0[0], v0[1]); w.y = cvtpk(v0[2], v0[3]); w.z = cvtpk(v1[0], v1[1]); w.w = cvtpk(v1[2], v1[3]);
                    *(pg8::u32x4*)(rowp + bj * 128) = w; } }
    }
};
struct EpiCtxPart {
    static constexpr bool PERM = false, AFTER_DRAIN = false;
    float* part;
    __device__ __forceinline__ void operator()(const pg8::f32x4 (&acc)[2][2][4][2], const pg8::Unit& u, int wr, int wc, int fr, int fq) const {
        const int b = u.pm / 17; const size_t rbase = (size_t)b * NCTX; const int rr0 = wr * 64 + fr, col0 = u.pn * 256 + wc * 32 + 4 * fq;
#pragma unroll
        for (int ai = 0; ai < 2; ++ai)
#pragma unroll
            for (int m = 0; m < 4; ++m) { float* rowp = part + (rbase + rr0 + ai * 128 + m * 16) * DM + col0;
#pragma unroll
                for (int bj = 0; bj < 2; ++bj)
#pragma unroll
                    for (int n = 0; n < 2; ++n) *(pg8::f32x4*)(rowp + bj * 128 + n * 16) = acc[ai][bj][m][n]; }
    }
};
struct CtxSplitOrder {
    int c;
    __device__ __forceinline__ bool next(int i, pg8::Unit& u) const { if (i > 0 || c >= 256) return false; u.pm = (c >> 6) * 17; u.pn = (c >> 2) & 15; return true; }
    __device__ __forceinline__ void a_ready(const pg8::Unit&) const {}
    __device__ __forceinline__ void done(const pg8::Unit&) const {}
};
struct RowOrder {
    pg8::StaticOrder S; int lat;
    __device__ __forceinline__ void init(int N, int G, int c, int lat_) { lat = lat_; S.init(lat_ ? 64 * 256 : MROWS, N, G, c); }
    __device__ __forceinline__ bool next(int i, pg8::Unit& u) const { if (!S.next(i, u)) return false; if (lat) u.pm = (u.pm >> 4) * 17 + 1 + (u.pm & 15); return true; }
    __device__ __forceinline__ void a_ready(const pg8::Unit&) const {}
    __device__ __forceinline__ void done(const pg8::Unit&) const {}
};

__device__ __forceinline__ void transpose_item(const float* W, int K, int Nsrc, int nsrc0, int k0, bf16* WT, int ndst0, LAS float* scr, int lane, float scale = 1.0f) {
    if (nsrc0 >= 0) {
#pragma unroll 8
        for (int i = 0; i < 32; ++i) { const int kk = 2 * i + (lane >> 5); scr[kk * 33 + (lane & 31)] = W[(size_t)(k0 + kk) * Nsrc + nsrc0 + (lane & 31)]; }
    } else {
#pragma unroll 8
        for (int i = 0; i < 32; ++i) { const int kk = 2 * i + (lane >> 5); scr[kk * 33 + (lane & 31)] = 0.f; }
    }
    LDS_WAIT(); asm volatile("" ::: "memory");
    const int c = lane & 7;
#pragma unroll
    for (int j = 0; j < 4; ++j) { const int n = (lane >> 3) + 8 * j; const LAS float* s = scr + (8 * c) * 33 + n;
        v4u o; o.x = pk2(s[0 * 33] * scale, s[1 * 33] * scale); o.y = pk2(s[2 * 33] * scale, s[3 * 33] * scale); o.z = pk2(s[4 * 33] * scale, s[5 * 33] * scale); o.w = pk2(s[6 * 33] * scale, s[7 * 33] * scale);
        *(v4u*)(WT + (size_t)(ndst0 + n) * K + k0 + 8 * c) = o; }
    LDS_WAIT(); asm volatile("" ::: "memory");
}

__device__ __forceinline__ void transpose_item64(const float* W, int K, int Nsrc, int nsrc0, int k0, bf16* WT, int ndst0, LAS float* scr, int lane, float scale, int nsrc1 = -1, float scale1 = 1.0f) {
    const int r4 = lane >> 4, c4 = lane & 15;
    f32x4 v[16];
    const int nsl = (nsrc1 >= 0 && c4 >= 8) ? nsrc1 + 4 * (c4 - 8) : nsrc0 + 4 * c4;
#pragma unroll
    for (int i = 0; i < 16; ++i) v[i] = *(const f32x4*)(W + (size_t)(k0 + 4 * i + r4) * Nsrc + nsl);
#pragma unroll
    for (int i = 0; i < 16; ++i) { const int k = 4 * i + r4; *(LAS f32x4*)(scr + k * 68 + 4 * (c4 ^ ((k >> 3) & 7))) = v[i]; }
    LDS_WAIT(); asm volatile("" ::: "memory");
    const int c = lane & 7;
#pragma unroll
    for (int j = 0; j < 8; ++j) { const int n = (lane >> 3) + 8 * j; const LAS float* p = scr + (8 * c) * 68 + (n ^ (4 * c)); if (nsrc1 >= 0 && j == 4) scale = scale1;
        v4u o; o.x = pk2(p[0 * 68] * scale, p[1 * 68] * scale); o.y = pk2(p[2 * 68] * scale, p[3 * 68] * scale); o.z = pk2(p[4 * 68] * scale, p[5 * 68] * scale); o.w = pk2(p[6 * 68] * scale, p[7 * 68] * scale);
        *(v4u*)(WT + (size_t)(ndst0 + n) * K + k0 + 8 * c) = o; }
    LDS_WAIT(); asm volatile("" ::: "memory");
}

__device__ __forceinline__ void phase_a(KP kp, int layer, LAS unsigned char* lds, int tid, int lane, int wave, int bid, int G) {
    unsigned char* ws = kp->ws;
    float* mod = (float*)(ws + WS_MOD);
    {
        LAS float* sc = (LAS float*)lds;
        LAS float* red = (LAS float*)(lds + 81920);
        const float* cin = kp->in[1]; const float* cctx = kp->in[3]; const float* wada = kp->in[5] + (size_t)layer * DM * 12288; const float* bada = kp->in[6] + (size_t)layer * 12288;
        bool have = false;
        for (int u = bid; u < 192; u += G) {
            if (!have) {
                for (int i = tid; i < 5 * DM; i += 512) { const int bi = i / DM, k = i % DM; const float v = bi < 4 ? cin[bi * DM + k] : cctx[k]; sc[i] = v / (1.0f + expf(-v)); }
                __syncthreads(); have = true;
            }
            const float* W = wada + u * 64 + lane;
            float acc0 = 0.f, acc1 = 0.f, acc2 = 0.f, acc3 = 0.f, acc4 = 0.f;
            const int k0 = wave * 512;
#pragma unroll 8
            for (int k = 0; k < 512; ++k) { const float w = W[(size_t)(k0 + k) * 12288];
                acc0 += sc[0 * DM + k0 + k] * w; acc1 += sc[1 * DM + k0 + k] * w; acc2 += sc[2 * DM + k0 + k] * w; acc3 += sc[3 * DM + k0 + k] * w; acc4 += sc[4 * DM + k0 + k] * w; }
            red[(wave * 5 + 0) * 64 + lane] = acc0; red[(wave * 5 + 1) * 64 + lane] = acc1; red[(wave * 5 + 2) * 64 + lane] = acc2; red[(wave * 5 + 3) * 64 + lane] = acc3; red[(wave * 5 + 4) * 64 + lane] = acc4;
            __syncthreads();
            if (tid < 320) { const int bi = tid / 64, cl = tid % 64; float s = 0.f;
#pragma unroll
                for (int w = 0; w < 8; ++w) s += red[(w * 5 + bi) * 64 + cl];
                mod[(size_t)(layer * 5 + bi) * 12288 + u * 64 + cl] = s + bada[u * 64 + cl]; }
            __syncthreads();
        }
        __syncthreads();
    }
    {
        LAS float* scr = (LAS float*)(lds + wave * 17408);
        const int gw = bid * 8 + wave, NGW = G * 8;
        const float* win = kp->in[7] + (size_t)layer * DM * NIN; const float* wout = kp->in[25] + (size_t)layer * DM * DM; const float* wglu = kp->in[21] + (size_t)layer * 1024 * 1024;
        bf16* WIN = (bf16*)(ws + WS_WIN); bf16* WOUT = (bf16*)(ws + WS_WOUT) + (size_t)layer * DM * DM; bf16* WGLU = (bf16*)(ws + WS_WGLU) + (size_t)layer * 1024 * 1024;
        constexpr int I_IN = 64 * (NPG / 64), I_LR = 64, I_OUT = 64 * (DM / 64), I_GLU = 16 * 16;
        for (int it = gw; it < I_IN + I_LR + I_OUT + I_GLU; it += NGW) {
            int r = it;
            if (r < I_IN) { const int kb = r / (NPG / 64), nb = r % (NPG / 64), nd = nb * 64;
                int ns;
                int ns1 = -1; float scl = 1.0f, scl1 = 1.0f;
                if (nd < 4096) { const int h = nd >> 9, r2 = nd & 511, pwi = r2 >> 7, sg = (r2 >> 5) & 3;
                    ns = sg * 1024 + h * 128 + 32 * pwi; ns1 = (sg + 1) * 1024 + h * 128 + 32 * pwi;
                    scl = (sg == 2) ? -1.4426950408889634f : 1.0f; scl1 = (sg == 0) ? -1.4426950408889634f : 1.0f; }
                else if (nd < 5120) ns = nd;
                else if (nd < 7168) { const int h = (nd - 5120) >> 9, r2 = (nd - 5120) & 511, pwi = r2 >> 7, sg = (r2 >> 5) & 3;
                    if (sg == 0) { ns = 5120 + h * 128 + 32 * pwi; ns1 = 5632 + h * 128 + 32 * pwi; scl = 0.08838834764831845f; }
                    else { ns = 6144 + h * 256 + 32 * pwi; ns1 = 6144 + h * 256 + 128 + 32 * pwi; } }
                else if (nd < 10240) ns = nd + 32;
                else if (nd < 12288) { const int h = (nd - 10240) >> 9, r2 = (nd - 10240) & 511; ns = r2 < 128 ? 10272 + h * 128 + r2 : r2 < 256 ? 10784 + h * 128 + (r2 - 128) : 11296 + h * 256 + (r2 - 256); }
                else ns = nd + 32;
                transpose_item64(win, DM, NIN, ns, kb * 64, WIN, nd, scr, lane, scl, ns1, scl1);
                continue; }
            r -= I_IN;
            if (r < I_LR) { transpose_item(win, DM, NIN, 7168, r * 64, (bf16*)(ws + WS_WLR), 0, scr, lane); continue; }
            r -= I_LR;
            if (r < I_OUT) { const int kb = r / (DM / 64), nb = r % (DM / 64); transpose_item64(wout, DM, DM, nb * 64, kb * 64, WOUT, nb * 64, scr, lane, 1.0f); continue; }
            r -= I_OUT;
            { const int kb = r / 16, nb = r % 16; transpose_item64(wglu, 1024, 1024, nb * 64, kb * 64, WGLU, nb * 64, scr, lane, 1.0f); }
        }
    }
}

__device__ __forceinline__ void phase_b(KP kp, int layer, LAS unsigned char* lds, int lane, int wave, int bid, int G) {
    typedef short bf16x8_ __attribute__((ext_vector_type(8)));
    unsigned char* ws = kp->ws;
    const float* src_ctx = kp->in[2];
    const float* src_lat = kp->in[0];
    const float* mod = (const float*)(ws + WS_MOD) + (size_t)layer * 5 * 12288;
    const float* ng = kp->in[4] + (size_t)layer * DM;
    bf16* HN = (bf16*)(ws + WS_HN); bf16* P = (bf16*)(ws + WS_P); const bf16* WLR = (const bf16*)(ws + WS_WLR);
    LAS unsigned char* T = lds;
    LAS f32x4* red = (LAS f32x4*)(lds + 131072);
    const int q = lane >> 4, ii = lane & 15;
    for (int grp = bid; grp < MROWS / 16; grp += G) {
#pragma unroll
        for (int rr = 0; rr < 2; ++rr) {
            const int rl = 2 * wave + rr, row = grp * 16 + rl;
            const int b = row / LTOT, l = row % LTOT;
            const float* hrow = l < NCTX ? src_ctx + ((size_t)b * NCTX + l) * DM : src_lat + ((size_t)b * SEQ + (l - NCTX)) * DM;
            const float* md = mod + (size_t)(l < NCTX ? 4 : b) * 12288;
            f32x4 v[16]; float s = 0.f;
            const bool asm_ctx = (layer == 1 && G == 256 && l < NCTX);
            if (asm_ctx) { const float* crow = kp->in[2] + ((size_t)b * NCTX + l) * DM; const float* prow = (const float*)(ws + WS_CPART) + ((size_t)b * NCTX + l) * DM;
                const float* gt0 = (const float*)(ws + WS_MOD) + (size_t)4 * 12288 + 8192; const size_t qs = (size_t)NBATCH * NCTX * DM;
#pragma unroll
                for (int j = 0; j < 16; ++j) { const int col = 4 * (lane + 64 * j);
                    const f32x4 p4 = (*(const f32x4*)(prow + col) + *(const f32x4*)(prow + qs + col)) + (*(const f32x4*)(prow + 2 * qs + col) + *(const f32x4*)(prow + 3 * qs + col));
                    v[j] = *(const f32x4*)(crow + col) + *(const f32x4*)(gt0 + col) * p4; s += (v[j].x * v[j].x + v[j].y * v[j].y) + (v[j].z * v[j].z + v[j].w * v[j].w); }
            } else if (layer == 1) {
                const bf16* drow = l < NCTX ? (const bf16*)(ws + WS_HC) + ((size_t)b * NCTX + l) * DM : (const bf16*)(ws + WS_HL) + ((size_t)b * SEQ + (l - NCTX)) * DM;
#pragma unroll
                for (int j = 0; j < 16; ++j) { const int col = 4 * (lane + 64 * j); const v2u d2 = *(const v2u*)(drow + col);
                    v[j] = *(const f32x4*)(hrow + col) + (f32x4){lo_bf(d2.x), hi_bf(d2.x), lo_bf(d2.y), hi_bf(d2.y)}; s += (v[j].x * v[j].x + v[j].y * v[j].y) + (v[j].z * v[j].z + v[j].w * v[j].w); }
                if (l >= NCTX) {
#pragma unroll
                    for (int j = 0; j < 16; ++j) { const int col = 4 * (lane + 64 * j); v2u o; o.x = cvtpk(v[j].x, v[j].y); o.y = cvtpk(v[j].z, v[j].w); *(v2u*)((bf16*)drow + col) = o; }
                }
            } else {
#pragma unroll
                for (int j = 0; j < 16; ++j) { v[j] = *(const f32x4*)(hrow + 4 * (lane + 64 * j)); s += (v[j].x * v[j].x + v[j].y * v[j].y) + (v[j].z * v[j].z + v[j].w * v[j].w); }
            }
            s = wave_sum(s);
            const float rstd = 1.0f / sqrtf(s * (1.0f / DM) + EPSN);
#pragma unroll
            for (int j = 0; j < 16; ++j) { const int col = 4 * (lane + 64 * j);
                const f32x4 g4 = *(const f32x4*)(ng + col), sh = *(const f32x4*)(md + col), sc = *(const f32x4*)(md + DM + col);
                const f32x4 y = v[j] * rstd * g4 * (sc + 1.0f) + sh;
                v2u o; o.x = cvtpk(y.x, y.y); o.y = cvtpk(y.z, y.w);
                *(v2u*)(HN + (size_t)row * DM + col) = o;
                *(LAS v2u*)(T + rl * 8192 + ((((col >> 3) ^ rl) & 511) << 4) + ((col & 7) << 1)) = o; }
        }
        __syncthreads();
        f32x4 acc0 = (f32x4){0.f, 0.f, 0.f, 0.f}, acc1 = (f32x4){0.f, 0.f, 0.f, 0.f};
#pragma unroll 8
        for (int ks = 0; ks < 16; ++ks) { const int k0 = 512 * wave + 32 * ks + 8 * q;
            const bf16x8_ a = *(const LAS bf16x8_*)(T + ii * 8192 + ((((k0 >> 3) ^ ii) & 511) << 4));
            const bf16x8_ b0 = *(const bf16x8_*)(WLR + (size_t)ii * DM + k0), b1 = *(const bf16x8_*)(WLR + (size_t)(16 + ii) * DM + k0);
            acc0 = __builtin_amdgcn_mfma_f32_16x16x32_bf16(a, b0, acc0, 0, 0, 0); acc1 = __builtin_amdgcn_mfma_f32_16x16x32_bf16(a, b1, acc1, 0, 0, 0); }
        if (wave > 0) { red[((wave - 1) * 2 + 0) * 64 + lane] = acc0; red[((wave - 1) * 2 + 1) * 64 + lane] = acc1; }
        __syncthreads();
        if (wave == 0) {
#pragma unroll
            for (int w2 = 0; w2 < 7; ++w2) { acc0 = acc0 + red[(w2 * 2 + 0) * 64 + lane]; acc1 = acc1 + red[(w2 * 2 + 1) * 64 + lane]; }
            bf16* pr = P + P_LRB_OFF + (size_t)(grp * 16 + 4 * q) * 32 + ii;
            pr[0] = (bf16)f2bf(acc0.x); pr[32] = (bf16)f2bf(acc0.y); pr[64] = (bf16)f2bf(acc0.z); pr[96] = (bf16)f2bf(acc0.w);
            pr[16] = (bf16)f2bf(acc1.x); pr[48] = (bf16)f2bf(acc1.y); pr[80] = (bf16)f2bf(acc1.z); pr[112] = (bf16)f2bf(acc1.w);
        }
    }
    __syncthreads();
}

template <int MODE>
__device__ __forceinline__ void naive_lin_unit(KP kp, int layer, int b, int hd, int dir, LAS unsigned char* lds, int tid) {
    constexpr int DV = MODE == 0 ? 128 : 256, NPART = 512 / DV, ND = 128 / NPART;
    LAS float* qs = (LAS float*)lds; LAS float* ks = qs + 256; LAS float* dsv = ks + 256; LAS float* po = dsv + 256;
    const int e = tid % DV, part = tid / DV, d0 = part * ND;
    const bf16* P = (const bf16*)(kp->ws + WS_P); bf16* RAW = (bf16*)(kp->ws + WS_RAW) + (size_t)dir * MROWS * DM;
    float s[ND];
#pragma unroll
    for (int i = 0; i < ND; ++i) s[i] = 0.f;
    const int qcol = (MODE == 0 ? CA_Q : MODE == 1 ? CB_Q : CD_Q) + hd * 128;
    const int kcol = (MODE == 0 ? (dir ? CA_FB : CA_FF) : MODE == 1 ? CB_K : CD_K) + hd * 128;
    const int vcol = (MODE == 0 ? CA_I : MODE == 1 ? CB_V : CD_V) + hd * DV;
    const int ocol = (MODE == 0 ? 0 : MODE == 1 ? 1024 : 3072) + hd * DV;
    const int d = tid & 127;
    float lbv = 0.f, bias = 0.f, gam = 0.f, frq = 0.f, wg[16];
#pragma unroll
    for (int r = 0; r < 16; ++r) wg[r] = 0.f;
    if (tid < 128) {
        if (MODE == 0) { if (layer == 1) { const float* lbl = kp->in[8]; lbv = 1.0f / (1.0f + expf(-(lbl[(2 + dir) * 1024 + hd * 128 + d] - lbl[dir * 1024 + hd * 128 + d]))); } }
        if (MODE == 1) { const float* w = kp->in[10] + (size_t)(layer * 2 + dir) * 16 * 512 + hd * 128 + d;
#pragma unroll
            for (int r = 0; r < 16; ++r) wg[r] = w[r * 512];
            bias = kp->in[11][(layer * 2 + dir) * 512 + hd * 128 + d]; }
        if (MODE == 2) { gam = 1.0f / (1.0f + expf(-kp->in[23][(layer * 2 + dir) * 4 + hd])); frq = exp2f(-(float)(d & 31) * (13.287712379549449f / 32.0f)); }
    }
    for (int p = 0; p < LTOT; ++p) {
        const int l = dir ? flip_pos(p) : p; const size_t row = (size_t)b * LTOT + l; const bf16* pr = P + row * NP; const int buf = (p & 1) * 128;
        if (tid < 128) {
            float q, key, dec;
            if (MODE == 0) { q = bf2f(pr[qcol + d]); const float z = bf2f(pr[kcol + d]); const float sg = 1.0f / (1.0f + __expf(-z)), sgn = 1.0f / (1.0f + __expf(z));
                dec = fmaxf(lbv + (1.0f - lbv) * sg, 1e-6f); key = (1.0f - lbv) * sgn; }
            if (MODE == 1) { q = bf2f(pr[qcol + d]) * 0.08838834764831845f; key = bf2f(pr[kcol + d]); float x = bias;
#pragma unroll
                for (int r = 0; r < 16; ++r) x += bf2f(pr[CB_LF + dir * 16 + r]) * wg[r];
                dec = __expf(log_sigmoidf_(x) * (1.0f / 16.0f)); }
            if (MODE == 2) { const int j = d & 63; const float q1 = bf2f(pr[qcol + j]), q2 = bf2f(pr[qcol + j + 64]), k1 = bf2f(pr[kcol + j]), k2 = bf2f(pr[kcol + j + 64]);
                float cs = 1.f, sn = 0.f;
                if (l >= NCTX) { const int t = l - NCTX; const float pos = (float)((j < 32) ? (t >> 6) : (t & 63)); sincos_acc(pos * frq, sn, cs); }
                q = ((d < 64) ? (q1 * cs - q2 * sn) : (q1 * sn + q2 * cs)) * 0.08838834764831845f; key = (d < 64) ? (k1 * cs - k2 * sn) : (k1 * sn + k2 * cs); dec = gam; }
            qs[buf + d] = q; ks[buf + d] = key; dsv[buf + d] = dec;
        }
        const float v = bf2f(pr[vcol + e]);
        __syncthreads();
        float acc = 0.f;
#pragma unroll
        for (int i = 0; i < ND; ++i) { s[i] = dsv[buf + d0 + i] * s[i] + ks[buf + d0 + i] * v; acc += s[i] * qs[buf + d0 + i]; }
        po[part * 256 + e] = acc;
        __syncthreads();
        if (part == 0) { float tot = 0.f;
#pragma unroll
            for (int pp = 0; pp < NPART; ++pp) tot += po[pp * 256 + e];
            RAW[row * DM + ocol + e] = (bf16)f2bf(tot); }
    }
    __syncthreads();
}
constexpr int S5_BUS = 132, S5_XS = 136, S5_WAVE_BYTES = 16 * S5_BUS * 4 + 16 * S5_XS * 2;
__device__ __forceinline__ void s5_coef(KP kp, int ld, int g, int p, float& lbr, float& lbi, float& cr, float& ci) {
    const float lre = fminf(kp->in[13][(ld * 64 + g) * 64 + p], -1e-4f), lim = kp->in[14][(ld * 64 + g) * 64 + p];
    const float dt = expf(kp->in[15][ld * 64 + g]);
    const float xr_ = lre * dt, ang = lim * dt;
    float sn, cs, snh, csh; sincos_acc(ang, sn, cs); sincos_acc(0.5f * ang, snh, csh);
    const float mag = expf(xr_), em1 = expm1f(xr_);
    lbr = mag * cs; lbi = mag * sn;
    const float nr = em1 * cs - 2.0f * snh * snh, ni = mag * sn;
    const float den = lre * lre + lim * lim;
    cr = (nr * lre + ni * lim) / den; ci = (ni * lre - nr * lim) / den;
}
__device__ __forceinline__ void s5_unit(KP kp, int layer, int b, int g, int dir, LAS unsigned char* wlds, int lane) {
    typedef short bf16x8_ __attribute__((ext_vector_type(8)));
    typedef float f32x2s __attribute__((ext_vector_type(2)));
    const int ld = layer * 2 + dir; const int ii = lane & 15, q = lane >> 4;
    LAS float* BU = (LAS float*)wlds; LAS bf16* X = (LAS bf16*)(wlds + 16 * S5_BUS * 4);
    float lbr, lbi;
    { float cr_, ci_; s5_coef(kp, ld, g, lane, lbr, lbi, cr_, ci_); }
    bf16x8_ bA[8];
    {
        const float* bre = kp->in[16] + (size_t)(ld * 64 + g) * 64 * 16; const float* bim = kp->in[17] + (size_t)(ld * 64 + g) * 64 * 16;
#pragma unroll
        for (int mt = 0; mt < 8; ++mt) { const int p = 8 * mt + (ii >> 1); float l0, l1, cr, ci; s5_coef(kp, ld, g, p, l0, l1, cr, ci);
#pragma unroll
            for (int j = 0; j < 8; ++j) { const int h = 8 * (q & 1) + j; const float br = bre[p * 16 + h], bi = bim[p * 16 + h];
                const float v = (ii & 1) ? (cr * bi + ci * br) : (cr * br - ci * bi);
                const unsigned hv = f2bf(v); const unsigned lv = f2bf(v - __builtin_bit_cast(float, hv << 16));
                bA[mt][j] = (short)(q < 2 ? hv : lv); } }
    }
    bf16x8_ cA[4];
    {
        const float* cre = kp->in[18] + (size_t)(ld * 64 + g) * 16 * 64 + ii * 64; const float* cim = kp->in[19] + (size_t)(ld * 64 + g) * 16 * 64 + ii * 64;
#pragma unroll
        for (int ks = 0; ks < 4; ++ks)
#pragma unroll
            for (int j = 0; j < 8; ++j) { const int p = 16 * ks + 4 * q + (j >> 1); const float v = (j & 1) ? -cim[p] : cre[p]; cA[ks][j] = (short)f2bf(v); }
    }
    const bf16* P = (const bf16*)(kp->ws + WS_P); bf16* RAW = (bf16*)(kp->ws + WS_RAW) + (size_t)dir * MROWS * DM;
    float xr = 0.f, xi = 0.f;
    v4u ua, un;
#define S5_LOADA(dst, ti_) do { const int ps_ = 16 * (ti_) + ii; const int l_ = dir ? flip_pos(ps_) : ps_; dst = *(const v4u*)(P + p_off((size_t)b * LTOT + l_, CC_U + g * 16 + 8 * (q & 1))); } while (0)
    v4u un2;
    S5_LOADA(ua, 0); S5_LOADA(un, 1); un2 = un;
    for (int ti = 0; ti < LTOT / 16; ++ti) {
        if (ti + 2 < LTOT / 16) S5_LOADA(un2, ti + 2);
        const bf16x8_ uf = __builtin_bit_cast(bf16x8_, ua);
#pragma unroll
        for (int mt = 0; mt < 8; ++mt) { const f32x4 c4 = __builtin_amdgcn_mfma_f32_16x16x32_bf16(bA[mt], uf, ((f32x4){0.f, 0.f, 0.f, 0.f}), 0, 0, 0);
            *(LAS f32x4*)(BU + ii * S5_BUS + 16 * mt + 4 * q) = c4; }
        asm volatile("s_waitcnt lgkmcnt(0)" ::: "memory");
        f32x2s bu[16];
#pragma unroll
        for (int t = 0; t < 16; ++t) bu[t] = *(const LAS f32x2s*)(BU + t * S5_BUS + 2 * lane);
#pragma unroll
        for (int t = 0; t < 16; ++t) { const float nxr = lbr * xr - lbi * xi + bu[t].x, nxi = lbr * xi + lbi * xr + bu[t].y; xr = nxr; xi = nxi;
            *(LAS unsigned*)(X + t * S5_XS + 2 * lane) = cvtpk(xr, xi); }
        asm volatile("s_waitcnt lgkmcnt(0)" ::: "memory");
        f32x4 y = (f32x4){0.f, 0.f, 0.f, 0.f};
#pragma unroll
        for (int ks = 0; ks < 4; ++ks) { const bf16x8_ xb_ = *(const LAS bf16x8_*)(X + ii * S5_XS + 32 * ks + 8 * q); y = __builtin_amdgcn_mfma_f32_16x16x32_bf16(cA[ks], xb_, y, 0, 0, 0); }
        {
            const int ps_ = 16 * ti + ii; const int l_ = dir ? flip_pos(ps_) : ps_;
            v2u ov; ov.x = cvtpk(y.x, y.y); ov.y = cvtpk(y.z, y.w);
            *(v2u*)(RAW + ((size_t)b * LTOT + l_) * DM + 2048 + g * 16 + 4 * q) = ov;
        }
        asm volatile("s_waitcnt lgkmcnt(0)" ::: "memory");
        ua = un; un = un2;
    }
#undef S5_LOADA
}
typedef short bf16x8 __attribute__((ext_vector_type(8)));
#define MFMA16(a, b, c) __builtin_amdgcn_mfma_f32_16x16x32_bf16((a), (b), (c), 0, 0, 0)
constexpr int LA_SQ = 136, LA_SJ = 72;
constexpr int LA_QT = 0, LA_KT = LA_QT + 64 * LA_SQ * 2, LA_VR = LA_KT + 64 * LA_SQ * 2, LA_SB = LA_VR + 64 * LA_SQ * 2,
              LA_STT = LA_SB + 64 * LA_SJ * 2, LA_VEC = LA_STT + 128 * LA_SQ * 2, LA_AUX = LA_VEC + 256 * 4, LA_END = LA_AUX + 2 * 64 * 33 * 4;
static_assert(LA_END <= LDSCTL_OFF, "LA LDS map");
typedef short s16x4 __attribute__((ext_vector_type(4)));

__device__ __forceinline__ bf16x8 trfrag(const LAS bf16* base, int stride, int k0, int c0, int lane) {
    const LAS bf16* a = base + (k0 + 8 * (lane >> 4) + ((lane & 15) >> 2)) * stride + c0 + 4 * (lane & 3);
    const s16x4 lo = __builtin_amdgcn_ds_read_tr16_b64_v4i16((LAS s16x4*)a), hi = __builtin_amdgcn_ds_read_tr16_b64_v4i16((LAS s16x4*)(a + 4 * stride));
    return __builtin_shufflevector(lo, hi, 0, 1, 2, 3, 4, 5, 6, 7);
}
__device__ __forceinline__ bf16x8 ldfrag(const LAS bf16* base, int stride, int row0, int k0, int lane) {
    return *(const LAS bf16x8*)(base + (row0 + (lane & 15)) * stride + k0 + 8 * (lane >> 4));
}
template <int MODE>
__device__ __forceinline__ void la_unit(KP kp, int layer, int b, int hd, int dir, int half, LAS unsigned char* lds, int tid, int lane, int w) {
    LAS bf16* QT = (LAS bf16*)(lds + LA_QT); LAS bf16* KT = (LAS bf16*)(lds + LA_KT); LAS bf16* Vr = (LAS bf16*)(lds + LA_VR);
    LAS bf16* Sb = (LAS bf16*)(lds + LA_SB); LAS bf16* Stt = (LAS bf16*)(lds + LA_STT);
    LAS float* eref = (LAS float*)(lds + LA_VEC); LAS float* elast = eref + 128;
    LAS float* aux = (LAS float*)(lds + LA_AUX);
    const bf16* P = (const bf16*)(kp->ws + WS_P); bf16* RAW = (bf16*)(kp->ws + WS_RAW) + (size_t)dir * MROWS * DM;
    const int qcol = (MODE == 0 ? CA_Q : MODE == 1 ? CB_Q : CD_Q) + hd * 128;
    const int kcol = (MODE == 0 ? (dir ? CA_FB : CA_FF) : MODE == 1 ? CB_K : CD_K) + hd * 128;
    const int vcol = (MODE == 0 ? CA_I + hd * 128 : (MODE == 1 ? CB_V : CD_V) + hd * 256 + half * 128) + 16 * w;
    const int ocol = (MODE == 0 ? hd * 128 : (MODE == 1 ? 1024 : 3072) + hd * 256 + half * 128);
    const int c0 = 16 * w;
    const int j0 = 16 * (w & 3);
    float lg = 0.f;
    bf16x8 wA = (bf16x8){0, 0, 0, 0, 0, 0, 0, 0}; f32x4 bias4 = (f32x4){0.f, 0.f, 0.f, 0.f};
    if (MODE == 0) { const float* lbl = kp->in[8];
        if (tid < 128) { float v = 0.f; if (layer == 1) v = 1.0f / (1.0f + expf(-(lbl[(2 + dir) * 1024 + hd * 128 + tid] - lbl[dir * 1024 + hd * 128 + tid]))); aux[tid] = v; aux[128 + tid] = 1.0f - v; } }
    if (MODE == 1) { const float* wg = kp->in[10] + (size_t)(layer * 2 + dir) * 16 * 512 + hd * 128 + c0 + (lane & 15); const float* bg = kp->in[11] + (layer * 2 + dir) * 512 + hd * 128 + c0 + 4 * (lane >> 4);
        const int q_ = lane >> 4;
#pragma unroll
        for (int j = 0; j < 8; ++j) { const float wf = wg[(8 * (q_ & 1) + j) * 512]; const unsigned hi = f2bf(wf); const unsigned lo = f2bf(wf - __builtin_bit_cast(float, hi << 16)); wA[j] = (short)(q_ < 2 ? hi : lo); }
        bias4 = (f32x4){bg[0], bg[1], bg[2], bg[3]}; }
    if (MODE == 2) { lg = log_sigmoidf_(kp->in[23][(layer * 2 + dir) * 4 + hd]);
        for (int i = tid; i < 64 * 32; i += 512) { const int pos = i >> 5, jj = i & 31; float sn, cs; sincos_acc((float)pos * exp2f(-(float)jj * (13.287712379549449f / 32.0f)), sn, cs); aux[pos * 33 + jj] = cs; aux[64 * 33 + pos * 33 + jj] = sn; }
        if (tid < 128) { eref[tid] = expf(32.f * lg); elast[tid] = expf(32.f * lg); } }
    f32x4 st[8];
#pragma unroll
    for (int e = 0; e < 8; ++e) st[e] = (f32x4){0.f, 0.f, 0.f, 0.f};
    v4u pa[2], pb[2], pg[4], pv[2];
    pg[0] = pg[1] = pg[2] = pg[3] = (v4u){0u, 0u, 0u, 0u};
#define LA_PREFETCH(n) do { const int p_ = 64 * (n) + lane; const int l_ = dir ? flip_pos(p_) : p_; const bf16* pr_ = P + ((size_t)b * LTOT + l_) * NP; \
        if (MODE == 2) { const int xc_ = (w < 4 ? qcol : kcol) + j0; pa[0] = *(const v4u*)(pr_ + xc_); pa[1] = *(const v4u*)(pr_ + xc_ + 8); pb[0] = *(const v4u*)(pr_ + xc_ + 64); pb[1] = *(const v4u*)(pr_ + xc_ + 72); } \
        else { pa[0] = *(const v4u*)(pr_ + qcol + c0); pa[1] = *(const v4u*)(pr_ + qcol + c0 + 8); pb[0] = *(const v4u*)(pr_ + kcol + c0); pb[1] = *(const v4u*)(pr_ + kcol + c0 + 8); } \
        if (MODE == 1) { _Pragma("unroll") for (int nt_ = 0; nt_ < 4; ++nt_) { const int p2_ = 64 * (n) + 16 * nt_ + (lane & 15); const int l2_ = dir ? flip_pos(p2_) : p2_; \
            pg[nt_] = *(const v4u*)(P + ((size_t)b * LTOT + l2_) * NP + CB_LF + dir * 16 + 8 * ((lane >> 4) & 1)); } } \
        pv[0] = *(const v4u*)(pr_ + vcol); pv[1] = *(const v4u*)(pr_ + vcol + 8); } while (0)
    LA_PREFETCH(0);
    __syncthreads();
    const int it = w >> 1;
    for (int n = 0; n < LTOT / 64; ++n) {
        {
            float xa[16], xb[16];
            unpack8(pa[0], xa); unpack8(pa[1], xa + 8); unpack8(pb[0], xb); unpack8(pb[1], xb + 8);
            if (MODE == 2) {
                const int p_ = 64 * n + lane; const int l_ = dir ? flip_pos(p_) : p_;
                const bool lat = l_ >= NCTX; const int t_ = l_ - NCTX; const int pos = (j0 < 32) ? (t_ >> 6) : (t_ & 63);
                const float dq = (w < 4) ? __expf((float)(lane - 31) * lg) * 0.08838834764831845f : __expf((float)(31 - lane) * lg);
                float o1[16], o2[16];
#pragma unroll
                for (int c = 0; c < 16; ++c) { float cs = 1.f, sn = 0.f; if (lat) { cs = aux[pos * 33 + ((j0 + c) & 31)]; sn = aux[64 * 33 + pos * 33 + ((j0 + c) & 31)]; }
                    o1[c] = (xa[c] * cs - xb[c] * sn) * dq; o2[c] = (xa[c] * sn + xb[c] * cs) * dq; }
                LAS bf16* T = (w < 4) ? QT : KT;
                *(LAS v4u*)(T + lane * LA_SQ + j0) = pack8c(o1); *(LAS v4u*)(T + lane * LA_SQ + j0 + 8) = pack8c(o1 + 8);
                *(LAS v4u*)(T + lane * LA_SQ + 64 + j0) = pack8c(o2); *(LAS v4u*)(T + lane * LA_SQ + 64 + j0 + 8) = pack8c(o2 + 8);
            } else {
                float g[16];
                if (MODE == 0) {
#pragma unroll
                    for (int c = 0; c < 16; ++c) { const float z = xb[c]; const float e = __expf(-fabsf(z)); const float r = __builtin_amdgcn_rcpf(1.0f + e);
                        const float sp = z >= 0.f ? r : e * r, sn = z >= 0.f ? e * r : r;
                        const float lb_ = aux[c0 + c], om_ = aux[128 + c0 + c];
                        g[c] = __logf(fmaxf(lb_ + om_ * sp, 1e-6f)); xb[c] = om_ * sn; }
                } else {
                    LAS float* XL = (LAS float*)(lds + LA_STT);
#pragma unroll
                    for (int nt = 0; nt < 4; ++nt) { f32x4 x = MFMA16(wA, __builtin_bit_cast(bf16x8, pg[nt]), ((f32x4){0.f, 0.f, 0.f, 0.f})); x = x + bias4;
                        f32x4 gg; gg.x = (fminf(x.x, 0.f) - __logf(1.0f + __expf(-fabsf(x.x)))) * (1.0f / 16.0f); gg.y = (fminf(x.y, 0.f) - __logf(1.0f + __expf(-fabsf(x.y)))) * (1.0f / 16.0f);
                        gg.z = (fminf(x.z, 0.f) - __logf(1.0f + __expf(-fabsf(x.z)))) * (1.0f / 16.0f); gg.w = (fminf(x.w, 0.f) - __logf(1.0f + __expf(-fabsf(x.w)))) * (1.0f / 16.0f);
                        *(LAS f32x4*)(XL + (16 * nt + (lane & 15)) * 132 + c0 + 4 * (lane >> 4)) = gg; }
                    asm volatile("s_waitcnt lgkmcnt(0)" ::: "memory");
#pragma unroll
                    for (int c4 = 0; c4 < 4; ++c4) { const f32x4 t = *(const LAS f32x4*)(XL + lane * 132 + c0 + 4 * c4); g[4 * c4] = t.x; g[4 * c4 + 1] = t.y; g[4 * c4 + 2] = t.z; g[4 * c4 + 3] = t.w; }
#pragma unroll
                    for (int c = 0; c < 16; ++c) xa[c] *= 0.08838834764831845f;
                }
#pragma unroll
                for (int c = 0; c < 16; ++c) { const float bc = lane_scan(g[c], lane); const float br = __shfl(bc, 31), bl = __shfl(bc, 63);
                    xa[c] = xa[c] * __expf(bc - br); xb[c] = xb[c] * __expf(br - bc);
                    if (lane == 0) { eref[c0 + c] = __expf(br); elast[c0 + c] = __expf(bl - br); } }
                *(LAS v4u*)(QT + lane * LA_SQ + c0) = pack8c(xa); *(LAS v4u*)(QT + lane * LA_SQ + c0 + 8) = pack8c(xa + 8);
                *(LAS v4u*)(KT + lane * LA_SQ + c0) = pack8c(xb); *(LAS v4u*)(KT + lane * LA_SQ + c0 + 8) = pack8c(xb + 8);
            }
            *(LAS v4u*)(Vr + lane * LA_SQ + 16 * w) = pv[0]; *(LAS v4u*)(Vr + lane * LA_SQ + 16 * w + 8) = pv[1];
        }
        __syncthreads();
        bf16x8 qa[4];
        {
            const f32x4 er = *(const LAS f32x4*)(eref + 16 * w + 4 * (lane >> 4));
#pragma unroll
            for (int e = 0; e < 8; ++e) { st[e] = st[e] * er;
                v2u o; o.x = cvtpk(st[e].x, st[e].y); o.y = cvtpk(st[e].z, st[e].w);
                *(LAS v2u*)(Stt + (16 * e + (lane & 15)) * LA_SQ + 16 * w + 4 * (lane >> 4)) = o; }
#pragma unroll
            for (int ks = 0; ks < 4; ++ks) qa[ks] = ldfrag(QT, LA_SQ, 16 * it, 32 * ks, lane);
#pragma unroll
            for (int t = 0; t < 2; ++t) { const int jt = 2 * (w & 1) + t; f32x4 s = (f32x4){0.f, 0.f, 0.f, 0.f};
                if (jt <= it) {
#pragma unroll
                    for (int ks = 0; ks < 4; ++ks) s = MFMA16(ldfrag(KT, LA_SQ, 16 * jt, 32 * ks, lane), qa[ks], s); }
                const int i = 16 * it + (lane & 15), jb = 16 * jt + 4 * (lane >> 4);
                v2u o; o.x = cvtpk(jb <= i ? s.x : 0.f, jb + 1 <= i ? s.y : 0.f); o.y = cvtpk(jb + 2 <= i ? s.z : 0.f, jb + 3 <= i ? s.w : 0.f);
                *(LAS v2u*)(Sb + i * LA_SJ + jb) = o; }
        }
        __syncthreads();
        if (n + 1 < LTOT / 64) LA_PREFETCH(n + 1);
        {
            const bf16x8 sb0 = ldfrag(Sb, LA_SJ, 16 * it, 0, lane), sb1 = ldfrag(Sb, LA_SJ, 16 * it, 32, lane);
            const int p_ = 64 * n + 16 * it + (lane & 15); const int l_ = dir ? flip_pos(p_) : p_;
            bf16* orow = RAW + ((size_t)b * LTOT + l_) * DM + ocol + 4 * (lane >> 4);
#pragma unroll
            for (int t = 0; t < 4; ++t) { const int et = 4 * (w & 1) + t; f32x4 o = (f32x4){0.f, 0.f, 0.f, 0.f};
                o = MFMA16(trfrag(Vr, LA_SQ, 0, 16 * et, lane), sb0, o);
                if (it >= 2) o = MFMA16(trfrag(Vr, LA_SQ, 32, 16 * et, lane), sb1, o);
#pragma unroll
                for (int ks = 0; ks < 4; ++ks) o = MFMA16(ldfrag(Stt, LA_SQ, 16 * et, 32 * ks, lane), qa[ks], o);
                v2u ov; ov.x = cvtpk(o.x, o.y); ov.y = cvtpk(o.z, o.w);
                *(v2u*)(orow + 16 * et) = ov; }
            const bf16x8 ka0 = trfrag(KT, LA_SQ, 0, 16 * w, lane), ka1 = trfrag(KT, LA_SQ, 32, 16 * w, lane);
            const f32x4 el = *(const LAS f32x4*)(elast + 16 * w + 4 * (lane >> 4));
#pragma unroll
            for (int e = 0; e < 8; ++e) { st[e] = MFMA16(ka0, trfrag(Vr, LA_SQ, 0, 16 * e, lane), st[e]); st[e] = MFMA16(ka1, trfrag(Vr, LA_SQ, 32, 16 * e, lane), st[e]); st[e] = st[e] * el; }
        }
        __syncthreads();
    }
#undef LA_PREFETCH
}
constexpr int L2_IMG = 64 * LA_SQ * 2;
constexpr int L2_BUF = 3 * L2_IMG;
constexpr int L2_SB = 2 * L2_BUF, L2_VEC = L2_SB + 64 * LA_SJ * 2, L2_AUX = L2_VEC + 2 * 256 * 4, L2_TMP = L2_AUX + 4 * 64 * 20 * 4, L2_END = L2_TMP + 4 * 32 * 4;
static_assert(L2_END <= LDSCTL_OFF && 2 * 64 * 33 * 4 <= 4 * 64 * 20 * 4, "LA2 LDS map");
constexpr float LOG2E_F = 1.4426950408889634f;
__device__ __forceinline__ float ex2(float x) { return __builtin_amdgcn_exp2f(x); }
__device__ __forceinline__ float lg2(float x) { return __builtin_amdgcn_logf(x); }
__device__ __forceinline__ float mulA(float a, float b) { return a * b; }
__device__ __forceinline__ float mulB(float a, float b) { return __builtin_fmaf(a, b, 0.0f); }
__device__ __forceinline__ f32x4 mulx4(f32x4 a, f32x4 b) { return (f32x4){mulA(a.x, b.x), mulB(a.y, b.y), mulA(a.z, b.z), mulB(a.w, b.w)}; }
__device__ __forceinline__ float rdlane(float x, int l) { return __builtin_bit_cast(float, __builtin_amdgcn_readlane(__builtin_bit_cast(int, x), l)); }
#define L2_DPP1(n) "v_add_f32_dpp %" #n ", %" #n ", %" #n " "
#define L2_DPP16(g, ctl) asm volatile("s_nop 1\n" L2_DPP1(0) ctl "\n" L2_DPP1(1) ctl "\n" L2_DPP1(2) ctl "\n" L2_DPP1(3) ctl "\n" L2_DPP1(4) ctl "\n" L2_DPP1(5) ctl "\n" L2_DPP1(6) ctl "\n" L2_DPP1(7) ctl "\n" \
        L2_DPP1(8) ctl "\n" L2_DPP1(9) ctl "\n" L2_DPP1(10) ctl "\n" L2_DPP1(11) ctl "\n" L2_DPP1(12) ctl "\n" L2_DPP1(13) ctl "\n" L2_DPP1(14) ctl "\n" L2_DPP1(15) ctl "\n s_nop 1" \
        : "+v"(g[0]), "+v"(g[1]), "+v"(g[2]), "+v"(g[3]), "+v"(g[4]), "+v"(g[5]), "+v"(g[6]), "+v"(g[7]), "+v"(g[8]), "+v"(g[9]), "+v"(g[10]), "+v"(g[11]), "+v"(g[12]), "+v"(g[13]), "+v"(g[14]), "+v"(g[15]))
#define L2_TRANSPOSE16(x) asm volatile("s_nop 1\n\tv_permlane32_swap_b32 %0, %8\n\tv_permlane32_swap_b32 %4, %12\n\tv_permlane32_swap_b32 %1, %9\n\tv_permlane32_swap_b32 %5, %13\n\tv_permlane32_swap_b32 %2, %10\n\tv_permlane32_swap_b32 %6, %14\n\tv_permlane32_swap_b32 %3, %11\n\tv_permlane32_swap_b32 %7, %15\n\tv_permlane16_swap_b32 %0, %4\n\tv_permlane16_swap_b32 %8, %12\n\tv_permlane16_swap_b32 %1, %5\n\tv_permlane16_swap_b32 %9, %13\n\tv_permlane16_swap_b32 %2, %6\n\tv_permlane16_swap_b32 %10, %14\n\tv_permlane16_swap_b32 %3, %7\n\tv_permlane16_swap_b32 %11, %15\n\ts_nop 1" : "+v"(x[0][0]), "+v"(x[0][1]), "+v"(x[0][2]), "+v"(x[0][3]), "+v"(x[1][0]), "+v"(x[1][1]), "+v"(x[1][2]), "+v"(x[1][3]), "+v"(x[2][0]), "+v"(x[2][1]), "+v"(x[2][2]), "+v"(x[2][3]), "+v"(x[3][0]), "+v"(x[3][1]), "+v"(x[3][2]), "+v"(x[3][3]))
#define L2_BAR() do { asm volatile("s_waitcnt lgkmcnt(0)" ::: "memory"); __builtin_amdgcn_s_barrier(); asm volatile("" ::: "memory"); } while (0)

template <int MODE>
__device__ __forceinline__ void la_unit2(KP kp, int layer, int b, int hd, int dir, int half, LAS unsigned char* lds, int tid, int lane, int w) {
    LAS bf16* Sb = (LAS bf16*)(lds + L2_SB);
    LAS float* vec = (LAS float*)(lds + L2_VEC);
    LAS float* aux = (LAS float*)(lds + L2_AUX);
    const bf16* P = (const bf16*)(kp->ws + WS_P); bf16* RAW = (bf16*)(kp->ws + WS_RAW) + (size_t)dir * MROWS * DM;
    const bf16* Pb = P + (size_t)((MODE == 0 ? 0 : MODE == 1 ? 10 : 20) + hd) * P_BLK_ELEMS;
    const int qcol = 0;
    const int kcol = (MODE == 0 ? (dir ? 256 : 128) : 128);
    const int vcol0 = (MODE == 0 ? 384 : 256 + half * 128);
    const int ocol = (MODE == 0 ? hd * 128 : (MODE == 1 ? 1024 : 3072) + hd * 256 + half * 128);
    const int NCH = LTOT / 64;
    float lg = 0.f;
    if (MODE == 0) { const float* lbl = kp->in[8];
        if (tid < 128) { float v = 0.f; if (layer == 1) v = 1.0f / (1.0f + expf(-(lbl[(2 + dir) * 1024 + hd * 128 + tid] - lbl[dir * 1024 + hd * 128 + tid]))); aux[tid] = v; aux[128 + tid] = 1.0f - v; } }
    if (MODE == 2) { lg = log_sigmoidf_(kp->in[23][(layer * 2 + dir) * 4 + hd]) * LOG2E_F;
        for (int i = tid; i < 64 * 32; i += 512) { const int pos = i >> 5, jj = i & 31; float sn, cs; sincos_acc((float)pos * exp2f(-(float)jj * (13.287712379549449f / 32.0f)), sn, cs); aux[pos * 33 + jj] = cs; aux[64 * 33 + pos * 33 + jj] = sn; }
        if (tid < 256) { vec[tid] = exp2f(32.f * lg); vec[256 + tid] = exp2f(32.f * lg); } }
    __syncthreads();
    if (w < 4) {
        const int pw = w;
        const int cbase = 32 * pw;
        const int isk = pw >> 1, jb = 32 * (pw & 1);
        bf16x8 wA[2]; f32x4 bias4[2];
        wA[0] = wA[1] = (bf16x8){0, 0, 0, 0, 0, 0, 0, 0}; bias4[0] = bias4[1] = (f32x4){0.f, 0.f, 0.f, 0.f};
        if (MODE == 1) {
#pragma unroll
            for (int grp = 0; grp < 2; ++grp) { const int c0 = cbase + 16 * grp;
                const float* wg = kp->in[10] + (size_t)(layer * 2 + dir) * 16 * 512 + hd * 128 + c0 + (lane & 15); const float* bg = kp->in[11] + (layer * 2 + dir) * 512 + hd * 128 + c0 + 4 * (lane >> 4);
                const int q_ = lane >> 4;
#pragma unroll
                for (int j = 0; j < 8; ++j) { const float wf = wg[(8 * (q_ & 1) + j) * 512] * LOG2E_F;        const unsigned hi = f2bf(wf); const unsigned lo = f2bf(wf - __builtin_bit_cast(float, hi << 16)); wA[grp][j] = (short)(q_ < 2 ? hi : lo); }
                bias4[grp] = (f32x4){bg[0] * LOG2E_F, bg[1] * LOG2E_F, bg[2] * LOG2E_F, bg[3] * LOG2E_F}; }
        }
        v4u pa[4], pb[4], pv[4], pg[4], na[4], nb_[4], nv[4], ng[4];
        pg[0] = pg[1] = pg[2] = pg[3] = (v4u){0u, 0u, 0u, 0u}; ng[0] = ng[1] = ng[2] = ng[3] = (v4u){0u, 0u, 0u, 0u};
#define L2_PREFETCH(n, pa, pb, pv, pg) do { const int p_ = 64 * (n) + lane; const int l_ = dir ? flip_pos(p_) : p_; const bf16* pr_ = Pb + ((size_t)b * LTOT + l_) * 512; \
            const int ac_ = (MODE == 2) ? ((isk ? kcol : qcol) + jb) : 128 * pw; const int bc_ = (MODE == 2) ? ac_ + 64 : 128 * pw + (MODE == 0 ? (dir ? 64 : 32) : 32); \
            const int vc_ = (MODE == 2) ? vcol0 + 32 * pw : 128 * pw + (MODE == 0 ? 96 : 64 + 32 * half);     \
            _Pragma("unroll") for (int k_ = 0; k_ < 4; ++k_) { pa[k_] = *(const v4u*)(pr_ + ac_ + 8 * k_); pb[k_] = *(const v4u*)(pr_ + bc_ + 8 * k_); pv[k_] = *(const v4u*)(pr_ + vc_ + 8 * k_); } \
            if (MODE == 1) { const int p2_ = 64 * (n) + (lane & 15); const int l2_ = dir ? flip_pos(p2_) : p2_;        \
                const bf16* lr_ = P + P_LRB_OFF + ((size_t)b * LTOT + l2_) * 32 + dir * 16 + 8 * ((lane >> 4) & 1); \
                _Pragma("unroll") for (int nt_ = 0; nt_ < 4; ++nt_) pg[nt_] = *(const v4u*)(lr_ + (dir ? -512 * nt_ : 512 * nt_)); } } while (0)
#define L2_GROUP(n, bi, grp) do { \
            LAS bf16* QT_ = (LAS bf16*)(lds + (bi) * L2_BUF); LAS bf16* KT_ = QT_ + 64 * LA_SQ; LAS float* ev_ = vec + (bi) * 256; \
            float xa[16], xb[16]; unpack8(pa[2 * (grp)], xa); unpack8(pa[2 * (grp) + 1], xa + 8); unpack8(pb[2 * (grp)], xb); unpack8(pb[2 * (grp) + 1], xb + 8); \
            if (MODE == 2) { \
                const int p_ = 64 * (n) + lane; const int l_ = dir ? flip_pos(p_) : p_; const bool lat = l_ >= NCTX; const int t_ = l_ - NCTX; const int pos = (jb < 32) ? (t_ >> 6) : (t_ & 63); \
                const float dq = isk ? ex2((float)(31 - lane) * lg) : ex2((float)(lane - 31) * lg) * 0.08838834764831845f; \
                const int j0_ = jb + 16 * (grp); float o1[16], o2[16]; \
                _Pragma("unroll") for (int c = 0; c < 16; ++c) { float cs = 1.f, sn = 0.f; if (lat) { cs = aux[pos * 33 + ((j0_ + c) & 31)]; sn = aux[64 * 33 + pos * 33 + ((j0_ + c) & 31)]; } \
                    o1[c] = (xa[c] * cs - xb[c] * sn) * dq; o2[c] = (xa[c] * sn + xb[c] * cs) * dq; } \
                LAS bf16* T_ = isk ? KT_ : QT_; \
                *(LAS v4u*)(T_ + lane * LA_SQ + j0_) = pack8c(o1); *(LAS v4u*)(T_ + lane * LA_SQ + j0_ + 8) = pack8c(o1 + 8); \
                *(LAS v4u*)(T_ + lane * LA_SQ + 64 + j0_) = pack8c(o2); *(LAS v4u*)(T_ + lane * LA_SQ + 64 + j0_ + 8) = pack8c(o2 + 8); \
            } else { \
                const int c0_ = cbase + 16 * (grp); float g[16]; \
                if (MODE == 0) { \
                    _Pragma("unroll") for (int c = 0; c < 16; ++c) { const float r = __builtin_amdgcn_rcpf(1.0f + ex2(xb[c]));        \
                        const float lb_ = aux[c0_ + c], om_ = aux[128 + c0_ + c]; \
                        g[c] = lg2(fmaxf(fmaf(om_, r, lb_), 1e-6f)); xb[c] = (c & 1) ? mulA(om_, 1.0f - r) : fmaf(-om_, r, om_); }                                          \
                } else { \
                    float gx[4][4];                                      \
                    _Pragma("unroll") for (int nt = 0; nt < 4; ++nt) { const f32x4 x = MFMA16(wA[grp], __builtin_bit_cast(bf16x8, pg[nt]), bias4[grp]);       \
                        gx[nt][0] = mulA(lg2(1.0f + ex2(-fmaxf(x.x, -100.0f))), -1.0f / 16.0f); gx[nt][1] = mulB(lg2(__builtin_fmaf(ex2(-fmaxf(x.y, -100.0f)), 1.0f, 1.0f)), -1.0f / 16.0f); \
                        gx[nt][2] = mulA(lg2(1.0f + ex2(-fmaxf(x.z, -100.0f))), -1.0f / 16.0f); gx[nt][3] = mulB(lg2(__builtin_fmaf(ex2(-fmaxf(x.w, -100.0f)), 1.0f, 1.0f)), -1.0f / 16.0f); } \
                      \
                    L2_TRANSPOSE16(gx); \
                    _Pragma("unroll") for (int c4 = 0; c4 < 4; ++c4) { g[4 * c4] = gx[c4][0]; g[4 * c4 + 1] = gx[c4][1]; g[4 * c4 + 2] = gx[c4][2]; g[4 * c4 + 3] = gx[c4][3]; } \
                } \
                _Pragma("unroll") for (int c = 0; c < 16; ++c) g[c] += dpp_f<0x111, 0xf>(g[c]);        \
                _Pragma("unroll") for (int c = 0; c < 16; ++c) g[c] += dpp_f<0x112, 0xf>(g[c]); \
                _Pragma("unroll") for (int c = 0; c < 16; ++c) g[c] += dpp_f<0x114, 0xf>(g[c]); \
                _Pragma("unroll") for (int c = 0; c < 16; ++c) g[c] += dpp_f<0x118, 0xf>(g[c]); \
                L2_DPP16(g, "row_bcast:15 row_mask:0xa bank_mask:0xf"); L2_DPP16(g, "row_bcast:31 row_mask:0xc bank_mask:0xf");     \
                LAS float* tp_ = (LAS float*)(lds + L2_TMP) + pw * 32;      \
                if ((lane & 31) == 31) { LAS float* t2_ = tp_ + (lane >> 5) * 16; \
                    *(LAS f32x4*)(t2_) = (f32x4){g[0], g[1], g[2], g[3]}; *(LAS f32x4*)(t2_ + 4) = (f32x4){g[4], g[5], g[6], g[7]}; *(LAS f32x4*)(t2_ + 8) = (f32x4){g[8], g[9], g[10], g[11]}; *(LAS f32x4*)(t2_ + 12) = (f32x4){g[12], g[13], g[14], g[15]}; } \
                _Pragma("unroll") for (int c = 0; c < 16; ++c) { const float d_ = g[c] - rdlane(g[c], 31); if (c & 1) { xa[c] = mulB(xa[c], ex2(d_)); xb[c] = mulB(xb[c], ex2(-d_)); } else { xa[c] = mulA(xa[c], ex2(d_)); xb[c] = mulA(xb[c], ex2(-d_)); } } \
                *(LAS v4u*)(QT_ + lane * LA_SQ + c0_) = pack8c(xa); *(LAS v4u*)(QT_ + lane * LA_SQ + c0_ + 8) = pack8c(xa + 8); \
                *(LAS v4u*)(KT_ + lane * LA_SQ + c0_) = pack8c(xb); *(LAS v4u*)(KT_ + lane * LA_SQ + c0_ + 8) = pack8c(xb + 8); \
                if (lane < 16) { const float br_ = tp_[lane], bl_ = tp_[16 + lane]; ev_[c0_ + lane] = ex2(br_); ev_[128 + c0_ + lane] = ex2(bl_ - br_); } \
            } } while (0)
#define L2_VALUES(bi) do { LAS bf16* VR_ = (LAS bf16*)(lds + (bi) * L2_BUF) + 2 * 64 * LA_SQ; \
            _Pragma("unroll") for (int k_ = 0; k_ < 4; ++k_) *(LAS v4u*)(VR_ + lane * LA_SQ + 32 * pw + 8 * k_) = pv[k_]; } while (0)
        L2_PREFETCH(0, pa, pb, pv, pg);
        L2_PREFETCH(1, na, nb_, nv, ng);
        L2_GROUP(0, 0, 0); L2_GROUP(0, 0, 1); L2_VALUES(0);
#define L2_ROTATE() do { _Pragma("unroll") for (int k_ = 0; k_ < 4; ++k_) { pa[k_] = na[k_]; pb[k_] = nb_[k_]; pv[k_] = nv[k_]; pg[k_] = ng[k_]; } } while (0)
        L2_ROTATE();
        L2_PREFETCH(2, na, nb_, nv, ng);
        L2_BAR();
        for (int n = 0; n < NCH; ++n) {
            const int nb = (n + 1) & 1;
            if (n + 1 < NCH) { L2_GROUP(n + 1, nb, 0); }
            L2_BAR();
            if (n + 1 < NCH) { L2_GROUP(n + 1, nb, 1); L2_VALUES(nb); }
            L2_ROTATE();
            if (n + 3 < NCH) L2_PREFETCH(n + 3, na, nb_, nv, ng);
            L2_BAR();
        }
#undef L2_ROTATE
#undef L2_PREFETCH
#undef L2_GROUP
#undef L2_VALUES
    } else {
        const int cw = w - 4; const int q = lane >> 4, ii = lane & 15;
        f32x4 st[2][8];
#pragma unroll
        for (int et = 0; et < 2; ++et)
#pragma unroll
            for (int dt = 0; dt < 8; ++dt) st[et][dt] = (f32x4){0.f, 0.f, 0.f, 0.f};
        v2u ovb[8]; bf16* oaddr[4];
#pragma unroll
        for (int t = 0; t < 8; ++t) ovb[t] = (v2u){0u, 0u};
#pragma unroll
        for (int t = 0; t < 4; ++t) oaddr[t] = RAW;
        L2_BAR();
        for (int n = 0; n < NCH; ++n) {
            const int bi = n & 1;
            const LAS bf16* QT = (const LAS bf16*)(lds + bi * L2_BUF); const LAS bf16* KT = QT + 64 * LA_SQ; const LAS bf16* Vr = KT + 64 * LA_SQ; const LAS float* ev = vec + bi * 256;
            {
                bf16x8 qa[4];
#pragma unroll
                for (int ks = 0; ks < 4; ++ks) qa[ks] = ldfrag(QT, LA_SQ, 16 * cw, 32 * ks, lane);
#pragma unroll
                for (int jt = 0; jt < 4; ++jt) { f32x4 s = (f32x4){0.f, 0.f, 0.f, 0.f};
                    if (jt <= cw) {
#pragma unroll
                        for (int ks = 0; ks < 4; ++ks) s = MFMA16(ldfrag(KT, LA_SQ, 16 * jt, 32 * ks, lane), qa[ks], s); }
                    const int i = 16 * cw + ii, jbb = 16 * jt + 4 * q;
                    v2u o; o.x = cvtpk(jbb <= i ? s.x : 0.f, jbb + 1 <= i ? s.y : 0.f); o.y = cvtpk(jbb + 2 <= i ? s.z : 0.f, jbb + 3 <= i ? s.w : 0.f);
                    *(LAS v2u*)(Sb + i * LA_SJ + jbb) = o; }
            }
            f32x4 o[2][4];
#pragma unroll
            for (int et = 0; et < 2; ++et)
#pragma unroll
                for (int t = 0; t < 4; ++t) o[et][t] = (f32x4){0.f, 0.f, 0.f, 0.f};
#pragma unroll
            for (int ks = 0; ks < 4; ++ks) {
                const f32x4 e0 = *(const LAS f32x4*)(ev + 32 * ks + 4 * q), e1 = *(const LAS f32x4*)(ev + 32 * ks + 16 + 4 * q);
                bf16x8 sa[2];
#pragma unroll
                for (int et = 0; et < 2; ++et) { st[et][2 * ks] = mulx4(st[et][2 * ks], e0); st[et][2 * ks + 1] = mulx4(st[et][2 * ks + 1], e1);
                    v4u pk_; pk_.x = cvtpk(st[et][2 * ks].x, st[et][2 * ks].y); pk_.y = cvtpk(st[et][2 * ks].z, st[et][2 * ks].w); pk_.z = cvtpk(st[et][2 * ks + 1].x, st[et][2 * ks + 1].y); pk_.w = cvtpk(st[et][2 * ks + 1].z, st[et][2 * ks + 1].w);
                    sa[et] = __builtin_bit_cast(bf16x8, pk_); }
#pragma unroll
                for (int t = 0; t < 4; ++t) { const LAS bf16* qp = QT + (16 * t + ii) * LA_SQ + 32 * ks + 4 * q;
                    const v2u lo = *(const LAS v2u*)qp, hi = *(const LAS v2u*)(qp + 16);
                    v4u bq; bq.x = lo.x; bq.y = lo.y; bq.z = hi.x; bq.w = hi.y;
                    const bf16x8 qb = __builtin_bit_cast(bf16x8, bq);
                    o[0][t] = MFMA16(sa[0], qb, o[0][t]); o[1][t] = MFMA16(sa[1], qb, o[1][t]); }
            }
            L2_BAR();
            bf16x8 va[2][2];
#pragma unroll
            for (int et = 0; et < 2; ++et)
#pragma unroll
                for (int ks = 0; ks < 2; ++ks) {
                    const LAS bf16* a_ = Vr + (32 * ks + 8 * (lane >> 4) + ((lane & 15) >> 2)) * LA_SQ + 32 * cw + 8 * (lane & 3) + 4 * et;
                    const s16x4 lo_ = __builtin_amdgcn_ds_read_tr16_b64_v4i16((LAS s16x4*)a_), hi_ = __builtin_amdgcn_ds_read_tr16_b64_v4i16((LAS s16x4*)(a_ + 4 * LA_SQ));
                    va[et][ks] = __builtin_shufflevector(lo_, hi_, 0, 1, 2, 3, 4, 5, 6, 7); }
#pragma unroll
            for (int t = 0; t < 4; ++t) {
                const bf16x8 s0 = ldfrag(Sb, LA_SJ, 16 * t, 0, lane);
                o[0][t] = MFMA16(va[0][0], s0, o[0][t]); o[1][t] = MFMA16(va[1][0], s0, o[1][t]);
                if (t >= 2) { const bf16x8 s1 = ldfrag(Sb, LA_SJ, 16 * t, 32, lane); o[0][t] = MFMA16(va[0][1], s1, o[0][t]); o[1][t] = MFMA16(va[1][1], s1, o[1][t]); }
            }
#pragma unroll
            for (int t = 0; t < 4; ++t) { asm volatile("" :: "v"(ovb[2 * t]), "v"(ovb[2 * t + 1]), "v"(oaddr[t])); }
            const int p0_ = 64 * n + ii; const int l0_ = dir ? flip_pos(p0_) : p0_;
            bf16* obase_ = RAW + ((size_t)b * LTOT + l0_) * DM + ocol + 32 * cw + 8 * q;
#pragma unroll
            for (int t = 0; t < 4; ++t) {
                oaddr[t] = obase_ + (dir ? -(ptrdiff_t)16 * DM * t : (ptrdiff_t)16 * DM * t);
                ovb[2 * t].x = cvtpk(o[0][t].x, o[0][t].y); ovb[2 * t].y = cvtpk(o[0][t].z, o[0][t].w);
                ovb[2 * t + 1].x = cvtpk(o[1][t].x, o[1][t].y); ovb[2 * t + 1].y = cvtpk(o[1][t].z, o[1][t].w);
                { v4u w4; w4.x = ovb[2 * t].x; w4.y = ovb[2 * t].y; w4.z = ovb[2 * t + 1].x; w4.w = ovb[2 * t + 1].y; *(v4u*)oaddr[t] = w4; }
            }
#pragma unroll
            for (int dt = 0; dt < 8; ++dt) {
                const bf16x8 k0 = trfrag(KT, LA_SQ, 0, 16 * dt, lane), k1 = trfrag(KT, LA_SQ, 32, 16 * dt, lane);
                const f32x4 el = *(const LAS f32x4*)(ev + 128 + 16 * dt + 4 * q);
#pragma unroll
                for (int et = 0; et < 2; ++et) { st[et][dt] = MFMA16(k0, va[et][0], st[et][dt]); st[et][dt] = MFMA16(k1, va[et][1], st[et][dt]); st[et][dt] = mulx4(st[et][dt], el); }
            }
            L2_BAR();
        }
    }
    __syncthreads();
}

#define LA_TIDS() int t2 = threadIdx.x; asm volatile("" : "+v"(t2)); const int ln2 = t2 & 63, wv2 = __builtin_amdgcn_readfirstlane(t2 >> 6)
__device__ __forceinline__ void phase_d(int layer, LAS unsigned char* lds, int bid, int G) {
    for (int u0 = bid; u0 < 256; u0 += G) {
        int u = u0; asm volatile("" : "+s"(u));
        if (u < 64) { LA_TIDS(); la_unit2<0>(KARGS(), layer, u >> 4, (u >> 1) & 7, u & 1, 0, lds, t2, ln2, wv2); }
        else if (u < 128) { LA_TIDS(); const int v = u - 64; la_unit2<1>(KARGS(), layer, v >> 4, (v >> 2) & 3, (v >> 1) & 1, v & 1, lds, t2, ln2, wv2); }
        else if (u < 192) { LA_TIDS(); const int v = u - 128; la_unit2<2>(KARGS(), layer, v >> 4, (v >> 2) & 3, (v >> 1) & 1, v & 1, lds, t2, ln2, wv2); }
        else { LA_TIDS(); const int wu = (u - 192) * 8 + wv2; s5_unit(KARGS(), layer, wu >> 7, (wu >> 1) & 63, wu & 1, lds + wv2 * S5_WAVE_BYTES, ln2); }
    }
}

__device__ __forceinline__ float row16_sum(float x) {
    x += dpp_f<0xB1, 0xf>(x); x += dpp_f<0x4E, 0xf>(x); x += dpp_f<0x141, 0xf>(x); x += dpp_f<0x140, 0xf>(x); return x;
}
__device__ __forceinline__ float row32_sum(float x) { x = row16_sum(x); return x + __shfl_xor(x, 16); }
__device__ __forceinline__ void phase_e(KP kp, int layer, int lane, int wave, int bid, int G) {
    unsigned char* ws = kp->ws;
    const bf16* P = (const bf16*)(ws + WS_P); const bf16* RF = (const bf16*)(ws + WS_RAW); const bf16* RB = RF + (size_t)MROWS * DM;
    bf16* O = (bf16*)(ws + WS_O); bf16* Z = (bf16*)(ws + WS_Z);
    float ga[8], gb[8], gd[8], sd0[8], sd1[8];
    {
        const float* pa_ = kp->in[9] + layer * 128 + 8 * (lane & 15); const float* pb_ = kp->in[12] + layer * 256 + 8 * (lane & 31); const float* pd_ = kp->in[24] + layer * 256 + 8 * (lane & 31);
        const float* ps_ = kp->in[20] + layer * 1024 + 8 * lane;
#pragma unroll
        for (int e = 0; e < 8; ++e) { ga[e] = pa_[e]; gb[e] = pb_[e]; gd[e] = pd_[e]; sd0[e] = ps_[e]; sd1[e] = ps_[512 + e]; }
    }
    const int gw = bid * 8 + wave, NGW = G * 8;
    for (int row = gw; row < MROWS; row += NGW) {
        if (layer == 1 && (row % LTOT) < NCTX) continue;
        const bf16* pr = P + (size_t)row * 512 + 8 * lane; const bf16* rf = RF + (size_t)row * DM + 8 * lane; const bf16* rb = RB + (size_t)row * DM + 8 * lane;
        bf16* orow = O + (size_t)row * DM + 8 * lane; bf16* zrow = Z + (size_t)row * 1024 + 8 * lane;
        v4u f_[8], b_[8], g_[8];
#pragma unroll
        for (int pt = 0; pt < 4; ++pt)
#pragma unroll
            for (int h = 0; h < 2; ++h) { f_[2 * pt + h] = *(const v4u*)(rf + 1024 * pt + 512 * h); b_[2 * pt + h] = *(const v4u*)(rb + 1024 * pt + 512 * h); }
#pragma unroll
        for (int h = 0; h < 2; ++h) { g_[h] = *(const v4u*)(pr + ((CA_G >> 9) + h) * P_BLK_ELEMS); g_[2 + h] = *(const v4u*)(pr + ((CB_G >> 9) + h) * P_BLK_ELEMS); g_[4 + h] = *(const v4u*)(pr + ((CC_U >> 9) + h) * P_BLK_ELEMS); g_[6 + h] = *(const v4u*)(pr + ((CD_G >> 9) + h) * P_BLK_ELEMS); }
#pragma unroll
        for (int h = 0; h < 2; ++h) {
            float x[8], y[8], gt[8];
            unpack8(f_[h], x); unpack8(b_[h], y); unpack8(g_[h], gt);
            float s = 0.f;
#pragma unroll
            for (int e = 0; e < 8; ++e) { x[e] += y[e]; s += x[e] * x[e]; }
            float r = 1.0f / sqrtf(row16_sum(s) * (1.0f / 128.0f) + EPSN);
#pragma unroll
            for (int e = 0; e < 8; ++e) x[e] = x[e] * r * ga[e] * siluf_(gt[e]);
            *(v4u*)(orow + 512 * h) = pack8c(x);
            unpack8(f_[2 + h], x); unpack8(b_[2 + h], y); unpack8(g_[2 + h], gt);
            s = 0.f;
#pragma unroll
            for (int e = 0; e < 8; ++e) { x[e] += y[e]; s += x[e] * x[e]; }
            r = 1.0f / sqrtf(row32_sum(s) * (1.0f / 256.0f) + EPSN);
#pragma unroll
            for (int e = 0; e < 8; ++e) x[e] = x[e] * r * gb[e] * siluf_(gt[e]);
            *(v4u*)(orow + 1024 + 512 * h) = pack8c(x);
            unpack8(f_[6 + h], x); unpack8(b_[6 + h], y); unpack8(g_[6 + h], gt);
            s = 0.f;
#pragma unroll
            for (int e = 0; e < 8; ++e) { x[e] += y[e]; s += x[e]; }
            const float mu = row32_sum(s) * (1.0f / 256.0f);
            s = 0.f;
#pragma unroll
            for (int e = 0; e < 8; ++e) { x[e] -= mu; s += x[e] * x[e]; }
            r = 1.0f / sqrtf(row32_sum(s) * (1.0f / 256.0f) + EPSN);
#pragma unroll
            for (int e = 0; e < 8; ++e) x[e] = x[e] * r * gd[e] * siluf_(gt[e]);
            *(v4u*)(orow + 3072 + 512 * h) = pack8c(x);
            unpack8(f_[4 + h], x); unpack8(b_[4 + h], y); unpack8(g_[4 + h], gt);
#pragma unroll
            for (int e = 0; e < 8; ++e) x[e] = gelu_tanhf_(x[e] + y[e] + (h ? sd1[e] : sd0[e]) * gt[e]);
            *(v4u*)(zrow + 512 * h) = pack8c(x);
        }
    }
}

__device__ __forceinline__ void phase_h(KP kp, int lane, int wave, int bid, int G) {
    const float* fg = kp->in[26]; float* out = kp->out; const float* x = kp->in[0];
    const bf16* D0 = (const bf16*)(kp->ws + WS_HL); const bf16* D1 = D0 + (size_t)NBATCH * SEQ * DM;
    const int gw = bid * 8 + wave, NGW = G * 8;
    for (int row = gw; row < NBATCH * SEQ; row += NGW) {
        const float* xrow = x + (size_t)row * DM; const bf16* d0 = D0 + (size_t)row * DM; const bf16* d1 = D1 + (size_t)row * DM; float* orow = out + (size_t)row * DM;
        f32x4 v[16]; float s = 0.f;
#pragma unroll
        for (int j = 0; j < 16; ++j) { const int col = 4 * (lane + 64 * j); const v2u a2 = *(const v2u*)(d0 + col), b2 = *(const v2u*)(d1 + col);
            v[j] = (f32x4){lo_bf(a2.x), hi_bf(a2.x), lo_bf(a2.y), hi_bf(a2.y)} + (f32x4){lo_bf(b2.x), hi_bf(b2.x), lo_bf(b2.y), hi_bf(b2.y)};
            s += (v[j].x * v[j].x + v[j].y * v[j].y) + (v[j].z * v[j].z + v[j].w * v[j].w); }
        s = wave_sum(s);
        const float rstd = 1.0f / sqrtf(s * (1.0f / DM) + EPSN);
#pragma unroll
        for (int j = 0; j < 16; ++j) { const int col = 4 * (lane + 64 * j); const f32x4 g4 = *(const f32x4*)(fg + col); *(f32x4*)(orow + col) = v[j] * rstd * g4; }
    }
}

constexpr int N_PHASES = 15;
__global__ void __launch_bounds__(512, 2) fwd(Args a) {
    extern __shared__ __attribute__((aligned(16))) unsigned char lds_raw[];
    LAS unsigned char* lds = (LAS unsigned char*)lds_raw;
    const int bid = blockIdx.x, G = gridDim.x;
#define TIDS() int tid = threadIdx.x; asm volatile("" : "+v"(tid)); const int lane = tid & 63, wave = __builtin_amdgcn_readfirstlane(tid >> 6); (void)lane; (void)wave
    volatile LAS unsigned* MISC = (volatile LAS unsigned*)(lds + MISC_OFF);
    for (int u = threadIdx.x; u < (LDS_BYTES - LDSCTL_OFF) / 4; u += 512) ((LAS unsigned*)(lds + LDSCTL_OFF))[u] = 0u;
    __syncthreads();
    unsigned* ctl = (unsigned*)(a.ws + WS_CTL);
    const int lo = a.ph_lo, hi = a.ph_hi;
    XcdBarrier bar; bar.bar = ctl + CW_BAR; bar.x = 0; bar.st = nullptr;
    if (hi - lo > 1) bar = xcd_barrier_post(ctl + CW_BAR, MISC + 8);
#define IN(k) (lo <= (k) && (k) < hi)
#define SEAM(k) do { if (IN(k) && IN((k) + 1)) xcd_barrier(bar); } while (0)
    for (int layer = 0; layer < 2; ++layer) {
        const int pb = layer * 7;
        if (IN(pb + 0)) { TIDS(); phase_a(KARGS(), layer, lds, tid, lane, wave, bid, G); }
        SEAM(pb + 0);
        if (IN(pb + 1)) { TIDS(); phase_b(KARGS(), layer, lds, lane, wave, bid, G); }
        SEAM(pb + 1);
        if (IN(pb + 2)) { KP kp = KARGS(); unsigned char* ws = kp->ws;
            pg8::Gemm g{(const bf16*)(ws + WS_HN), (const bf16*)(ws + WS_WIN), DM, NPG, DM};
            RowOrder S; S.init(NPG, G, bid, 0);
            EpiStoreBf16 E{(bf16*)(ws + WS_P), NP};
            pg8::gemm_phase<EpiStoreBf16, RowOrder, true, true>(lds, g, S, E);
        }
        SEAM(pb + 2);
        if (IN(pb + 3)) { phase_d(layer, lds, bid, G); }
        SEAM(pb + 3);
        if (IN(pb + 4)) { TIDS(); phase_e(KARGS(), layer, lane, wave, bid, G); }
        SEAM(pb + 4);
        if (IN(pb + 5)) { KP kp = KARGS(); unsigned char* ws = kp->ws;
            pg8::Gemm g{(const bf16*)(ws + WS_Z), (const bf16*)(ws + WS_WGLU) + (size_t)layer * 1024 * 1024, 1024, 1024, 1024};
            RowOrder S; S.init(1024, G, bid, layer == 1 ? 1 : 0);
            EpiGlu E{(const bf16*)(ws + WS_Z), (const bf16*)(ws + WS_P), (bf16*)(ws + WS_O), kp->in[22] + layer * 1024};
            pg8::gemm_phase<EpiGlu, RowOrder, true, true>(lds, g, S, E);
        }
        SEAM(pb + 5);
        if (IN(pb + 6)) { KP kp = KARGS(); unsigned char* ws = kp->ws;
            pg8::Gemm g{(const bf16*)(ws + WS_O), (const bf16*)(ws + WS_WOUT) + (size_t)layer * DM * DM, DM, DM, DM};
            const bool split = (layer == 0 && G == 256);
            RowOrder S; S.init(DM, G, bid, (layer == 1 || split) ? 1 : 0);
            EpiDelta E{(bf16*)(ws + WS_HL) + (size_t)layer * NBATCH * SEQ * DM, (bf16*)(ws + WS_HC), (const float*)(ws + WS_MOD) + (size_t)layer * 5 * 12288};
            pg8::gemm_phase<EpiDelta, RowOrder, true, true>(lds, g, S, E);
            if (split) {
                const int kq = bid & 3;
                pg8::Gemm g2{(const bf16*)(ws + WS_O) + kq * 1024, (const bf16*)(ws + WS_WOUT) + kq * 1024, DM, DM, 1024};
                CtxSplitOrder S2{bid};
                EpiCtxPart E2{(float*)(ws + WS_CPART) + (size_t)kq * NBATCH * NCTX * DM};
                pg8::gemm_phase<EpiCtxPart, CtxSplitOrder, false, true>(lds, g2, S2, E2);
            }
        }
        SEAM(pb + 6);
    }
    if (IN(14)) { TIDS(); phase_h(KARGS(), lane, wave, bid, G); }
#undef IN
#undef SEAM
#undef TIDS
}

extern "C" void kernel_launch(void* const* d_in, const int* in_sizes, int n_in, void* d_out, int out_size, void* d_ws, size_t ws_size, hipStream_t stream) {
    static int grid = 0;
    if (grid == 0) {
        if (n_in != 27 || out_size != NBATCH * SEQ * DM || ws_size < WS_END) { fprintf(stderr, "kernel_launch: unexpected problem (n_in %d out %d ws %zu need %zu); nothing launched\n", n_in, out_size, ws_size, (size_t)WS_END); grid = -1; return; }
        int dev = 0, cus = 0;
        if (hipGetDevice(&dev) != hipSuccess || hipDeviceGetAttribute(&cus, hipDeviceAttributeMultiprocessorCount, dev) != hipSuccess) { grid = -1; return; }
        if (hipFuncSetAttribute((const void*)fwd, hipFuncAttributeMaxDynamicSharedMemorySize, LDS_BYTES) != hipSuccess) { fprintf(stderr, "kernel_launch: hipFuncSetAttribute failed\n"); grid = -1; return; }
        (void)hipGetLastError();
        grid = cus;
    }
    if (grid < 0) return;
    (void)hipMemsetAsync((char*)d_ws + WS_CTL, 0, CTL_BYTES, stream);
    Args a{};
    for (int i = 0; i < 27; ++i) a.in[i] = (const float*)d_in[i];
    a.out = (float*)d_out; a.ws = (unsigned char*)d_ws;
#ifndef ONE_LAUNCH
    for (int ph = 0; ph < N_PHASES; ++ph) { a.ph_lo = ph; a.ph_hi = ph + 1; hipLaunchKernelGGL(fwd, dim3(grid), dim3(512), LDS_BYTES, stream, a); }
#else
    a.ph_lo = 0; a.ph_hi = N_PHASES; hipLaunchKernelGGL(fwd, dim3(grid), dim3(512), LDS_BYTES, stream, a);
#endif
}
```
